# Optimizing an MI355X kernel written in HIP

```python
import math
import jax
import jax.numpy as jnp
from jax import lax
import numpy as np

D_MODEL = 2048
BATCH = 8
SEQ = 2048
DEPTH = 2

GRID_W = 64
CTX_LEN = 256
EPS = 1e-6
ROPE_THETA = 10000.0
N_MOD = 9
FFN_RESIDUAL = 0.5
D_FF = 256 * ((8 * D_MODEL // 3 + 255) // 256)
N_BRANCH = 3
BRANCH_WIDTH = D_MODEL // 2
Q_BLOCK = 128

MLA_NOPE = 128
MLA_ROPE = 64
MLA_V = 128
MLA_QK_DIM = MLA_NOPE + MLA_ROPE
MLA_HEADS = BRANCH_WIDTH // MLA_V
MLA_KV_RANK = 512

SSD_HEADDIM = 64
SSD_INNER = BRANCH_WIDTH
SSD_HEADS = SSD_INNER // SSD_HEADDIM
SSD_GROUPS = 4
SSD_STATE = 128
SSD_CONV = 5
SSD_CHUNK = 128
SSD_XBC = SSD_INNER + 2 * SSD_GROUPS * SSD_STATE

NA_HEADDIM = 128
NA_HEADS = BRANCH_WIDTH // NA_HEADDIM
NA_WIN_ROWS = 8
NA_WIN_COLS = 16
NA_QBLOCK_COLS = 16
NA_BAND_COLS = NA_QBLOCK_COLS + NA_WIN_COLS

IN_SIZES = (MLA_HEADS * MLA_QK_DIM, MLA_KV_RANK, MLA_ROPE, SSD_INNER, SSD_XBC, 2 * SSD_HEADS, 3 * NA_HEADS * NA_HEADDIM, N_BRANCH * D_MODEL)
D_IN = sum(IN_SIZES)

kernel_name = 'hybrid_dit_mla_ssd_natten'


def rmsnorm(x, g):
    xf = x.astype(jnp.float32)
    y = xf * lax.rsqrt(jnp.mean(xf * xf, axis=-1, keepdims=True) + EPS)
    return (y * g.astype(jnp.float32)).astype(x.dtype)


def adaln(cond, w, b):
    return (jax.nn.silu(cond) @ w + b).reshape(cond.shape[0], N_MOD, D_MODEL)


def modulate(y, m, base):
    return y * (1.0 + m[:, base + 1][:, None]) + m[:, base][:, None]


def swiglu(u, w_gate, w_up, w_down):
    return (jax.nn.silu(u @ w_gate) * (u @ w_up)) @ w_down


def ffn_sublayer(h, m, base, g, w_gate, w_up, w_down):
    u = modulate(rmsnorm(h, g), m, base)
    return h + FFN_RESIDUAL * m[:, base + 2][:, None] * swiglu(u, w_gate, w_up, w_down)


def axial_rope_tables(n_tokens):
    t = jnp.arange(n_tokens)
    pos = jnp.stack([t // GRID_W, t % GRID_W], axis=-1).astype(jnp.float32)
    n_freq = MLA_ROPE // 4
    inv_freq = ROPE_THETA ** (-jnp.arange(n_freq, dtype=jnp.float32) / n_freq)
    ang = pos[:, :, None] * inv_freq
    return jnp.cos(ang), jnp.sin(ang)


def apply_axial_rope(x, cos, sin):
    shp = x.shape
    xr = x.reshape(shp[:-1] + (2, 2, shp[-1] // 4))
    x1, x2 = xr[..., 0, :], xr[..., 1, :]
    c = cos[:, None].astype(x.dtype)
    s = sin[:, None].astype(x.dtype)
    out = jnp.stack([x1 * c - x2 * s, x2 * c + x1 * s], axis=-2)
    return out.reshape(shp)


def blocked_attention(q, k, v):
    bsz, t, h, dq = q.shape
    scale = dq ** -0.5
    q_blocks = jnp.moveaxis(q.reshape(bsz, t // Q_BLOCK, Q_BLOCK, h, dq), 1, 0)

    def one_block(qb):
        logits = jnp.einsum('bqhd,bkhd->bhqk', qb, k).astype(jnp.float32) * scale
        p = jax.nn.softmax(logits, axis=-1).astype(v.dtype)
        return jnp.einsum('bhqk,bkhd->bqhd', p, v)

    o = lax.map(one_block, q_blocks)
    return jnp.moveaxis(o, 0, 1).reshape(bsz, t, h * v.shape[-1])


def mla_qkv(q_raw, ckv_raw, kr_raw, kv_norm_g, w_uk, w_uv, q_norm_g, k_norm_g, rope):
    bsz, t, _ = q_raw.shape
    q = rmsnorm(q_raw.reshape(bsz, t, MLA_HEADS, MLA_QK_DIM), q_norm_g)
    ckv = rmsnorm(ckv_raw, kv_norm_g)
    k_nope = (ckv @ w_uk).reshape(bsz, t, MLA_HEADS, MLA_NOPE)
    v = (ckv @ w_uv).reshape(bsz, t, MLA_HEADS, MLA_V)
    k_rope = jnp.broadcast_to(kr_raw[:, :, None, :], (bsz, t, MLA_HEADS, MLA_ROPE))
    k = rmsnorm(jnp.concatenate([k_nope, k_rope], axis=-1), k_norm_g)
    if rope is not None:
        cos, sin = rope
        q = jnp.concatenate([q[..., :MLA_NOPE], apply_axial_rope(q[..., MLA_NOPE:], cos, sin)], axis=-1)
        k = jnp.concatenate([k[..., :MLA_NOPE], apply_axial_rope(k[..., MLA_NOPE:], cos, sin)], axis=-1)
    return q, k, v


def mla_mixer(lat, ctx, kv_norm_g, w_uk, w_uv, q_norm_g, k_norm_g, cos, sin, need_ctx):
    q_l, k_l, v_l = mla_qkv(*lat, kv_norm_g, w_uk, w_uv, q_norm_g, k_norm_g, (cos, sin))
    q_c, k_c, v_c = mla_qkv(*ctx, kv_norm_g, w_uk, w_uv, q_norm_g, k_norm_g, None)
    out_l = blocked_attention(q_l, jnp.concatenate([k_c, k_l], axis=1), jnp.concatenate([v_c, v_l], axis=1))
    out_c = blocked_attention(q_c, k_c, v_c) if need_ctx else None
    return out_l, out_c


def centred_depthwise_conv(x, w, b):
    pad = SSD_CONV // 2
    y = lax.conv_general_dilated(x, w[:, None, :], window_strides=(1,), padding=((pad, pad),),
                                 dimension_numbers=('NWC', 'WIO', 'NWC'), feature_group_count=x.shape[-1])
    return y + b


def ssd_chunked(x, dt_a, b_mat, c_mat, init_state):
    bsz, t, h, p = x.shape
    g, n = b_mat.shape[2], b_mat.shape[3]
    r = h // g
    q = SSD_CHUNK
    nc = t // q
    xc = x.astype(jnp.float32).reshape(bsz, nc, q, g, r, p)
    ac = dt_a.astype(jnp.float32).reshape(bsz, nc, q, g, r)
    bc = b_mat.astype(jnp.float32).reshape(bsz, nc, q, g, n)
    cc = c_mat.astype(jnp.float32).reshape(bsz, nc, q, g, n)
    a_cum = jnp.cumsum(ac, axis=2)
    causal = jnp.tril(jnp.ones((q, q), dtype=bool))
    seg = a_cum[:, :, :, None] - a_cum[:, :, None, :]
    decay_in = jnp.exp(jnp.where(causal[None, None, :, :, None, None], seg, -jnp.inf))
    cb = jnp.einsum('bclgn,bcsgn->bclsg', cc, bc)
    y_diag = jnp.einsum('bclsgr,bcsgrp->bclgrp', cb[..., None] * decay_in, xc)
    decay_to_end = jnp.exp(a_cum[:, :, -1:] - a_cum)
    chunk_states = jnp.einsum('bclgn,bclgrp->bcgrpn', bc, xc * decay_to_end[..., None])
    chunk_decay = jnp.exp(a_cum[:, :, -1])

    def step(state, inp):
        dec, st = inp
        return state * dec[..., None, None] + st, state

    final, entering = lax.scan(step, init_state.astype(jnp.float32),
                               (jnp.moveaxis(chunk_decay, 1, 0), jnp.moveaxis(chunk_states, 1, 0)))
    entering = jnp.moveaxis(entering, 0, 1)
    y_off = jnp.einsum('bclgn,bcgrpn->bclgrp', cc, entering) * jnp.exp(a_cum)[..., None]
    return (y_diag + y_off).reshape(bsz, t, h, p), final


def ssd_inputs(xbc, dt_raw, conv_w, conv_b, dt_bias):
    bsz, t, _ = xbc.shape
    xbc = jax.nn.silu(centred_depthwise_conv(xbc, conv_w, conv_b))
    xs, bm, cm = jnp.split(xbc, [SSD_INNER, SSD_INNER + SSD_GROUPS * SSD_STATE], axis=-1)
    xs = xs.reshape(bsz, t, SSD_HEADS, SSD_HEADDIM)
    bm = bm.reshape(bsz, t, SSD_GROUPS, SSD_STATE)
    cm = cm.reshape(bsz, t, SSD_GROUPS, SSD_STATE)
    dt = jax.nn.softplus(dt_raw.astype(jnp.float32).reshape(bsz, t, 2, SSD_HEADS) + dt_bias.astype(jnp.float32))
    return xs, bm, cm, dt


def ssd_direction(xs, bm, cm, dt, a, d, init, reverse):
    xdt = xs.astype(jnp.float32) * dt[:, :, d, :, None]
    dta = dt[:, :, d] * a[d]
    if reverse:
        xdt, dta, bm, cm = (jnp.flip(v, axis=1) for v in (xdt, dta, bm, cm))
    y, final = ssd_chunked(xdt, dta, bm, cm, init)
    if reverse:
        y = jnp.flip(y, axis=1)
    return y, final


def ssd_output(y, xs, z, d_skip, norm_g):
    bsz, t = z.shape[:2]
    y = y + d_skip.astype(jnp.float32)[:, None] * xs.astype(jnp.float32)
    v = y.reshape(bsz, t, SSD_INNER) * jax.nn.silu(z.astype(jnp.float32))
    v = v.reshape(bsz, t, SSD_GROUPS, SSD_INNER // SSD_GROUPS)
    v = v * lax.rsqrt(jnp.mean(v * v, axis=-1, keepdims=True) + EPS)
    return (v.reshape(bsz, t, SSD_INNER) * norm_g.astype(jnp.float32)).astype(z.dtype)


def ssd_mixer(lat, ctx, conv_w, conv_b, a_log, dt_bias, d_skip, norm_g, need_ctx):
    z_l, xbc_l, dtr_l = lat
    z_c, xbc_c, dtr_c = ctx
    xs_l, b_l, c_l, dt_l = ssd_inputs(xbc_l, dtr_l, conv_w, conv_b, dt_bias)
    xs_c, b_c, c_c, dt_c = ssd_inputs(xbc_c, dtr_c, conv_w, conv_b, dt_bias)
    a = -jnp.exp(a_log.astype(jnp.float32))
    zero = jnp.zeros((xs_c.shape[0], SSD_GROUPS, SSD_HEADS // SSD_GROUPS, SSD_HEADDIM, SSD_STATE), jnp.float32)
    y_cf, s_f = ssd_direction(xs_c, b_c, c_c, dt_c, a, 0, zero, False)
    y_cb, s_b = ssd_direction(xs_c, b_c, c_c, dt_c, a, 1, zero, True)
    y_lf, _ = ssd_direction(xs_l, b_l, c_l, dt_l, a, 0, s_f, False)
    y_lb, _ = ssd_direction(xs_l, b_l, c_l, dt_l, a, 1, s_b, True)
    out_l = ssd_output(y_lf + y_lb, xs_l, z_l, d_skip, norm_g)
    out_c = ssd_output(y_cf + y_cb, xs_c, z_c, d_skip, norm_g) if need_ctx else None
    return out_l, out_c


def na_heads(qkv, q_norm_g, k_norm_g):
    bsz, t, _ = qkv.shape
    qkv = qkv.reshape(bsz, t, 3, NA_HEADS, NA_HEADDIM)
    return rmsnorm(qkv[:, :, 0], q_norm_g), rmsnorm(qkv[:, :, 1], k_norm_g), qkv[:, :, 2]


def na_mixer(qkv_l, qkv_c, q_norm_g, k_norm_g, rpb, need_ctx):
    q_l, k_l, v_l = na_heads(qkv_l, q_norm_g, k_norm_g)
    q_c, k_c, v_c = na_heads(qkv_c, q_norm_g, k_norm_g)
    bsz, seq = q_l.shape[:2]
    rows = seq // GRID_W
    kr = min(NA_WIN_ROWS, rows)
    scale = NA_HEADDIM ** -0.5
    r = np.arange(rows)
    row_idx = np.clip(r - kr // 2, 0, rows - kr)[:, None] + np.arange(kr)
    row_off = row_idx - r[:, None] + (NA_WIN_ROWS - 1)
    n_cb = GRID_W // NA_QBLOCK_COLS
    q_cols = np.arange(GRID_W).reshape(n_cb, NA_QBLOCK_COLS)
    band_cols = np.clip(q_cols[:, 0] - NA_WIN_COLS // 2, 0, GRID_W - NA_BAND_COLS)[:, None] + np.arange(NA_BAND_COLS)
    win_start = np.clip(q_cols - NA_WIN_COLS // 2, 0, GRID_W - NA_WIN_COLS)
    kc = band_cols[:, None, :]
    col_mask = (kc >= win_start[:, :, None]) & (kc < win_start[:, :, None] + NA_WIN_COLS)
    col_off = np.clip(kc - q_cols[:, :, None] + NA_WIN_COLS - 1, 0, 2 * NA_WIN_COLS - 2)
    rpb_cols = rpb[:, :, col_off]
    kg = k_l.reshape(bsz, rows, GRID_W, NA_HEADS, NA_HEADDIM)
    vg = v_l.reshape(bsz, rows, GRID_W, NA_HEADS, NA_HEADDIM)
    q_rows = jnp.moveaxis(q_l.reshape(bsz, rows, n_cb, NA_QBLOCK_COLS, NA_HEADS, NA_HEADDIM), 1, 0)
    n_win = kr * NA_BAND_COLS

    def one_row(args):
        qb, r_idx, r_off = args
        k_band = jnp.take(kg, r_idx, axis=1)[:, :, band_cols]
        v_band = jnp.take(vg, r_idx, axis=1)[:, :, band_cols]
        s_win = jnp.einsum('bnqhd,brnkhd->bnhqrk', qb, k_band).astype(jnp.float32) * scale
        bias = jnp.transpose(rpb_cols[:, r_off], (2, 0, 3, 1, 4))
        s_win = jnp.where(col_mask[:, None, :, None, :], s_win + bias, -jnp.inf)
        s_ctx = jnp.einsum('bnqhd,bchd->bnhqc', qb, k_c).astype(jnp.float32) * scale
        logits = jnp.concatenate([s_win.reshape(s_win.shape[:4] + (-1,)), s_ctx], axis=-1)
        p = jax.nn.softmax(logits, axis=-1).astype(v_l.dtype)
        p_win = p[..., :n_win].reshape(s_win.shape)
        return (jnp.einsum('bnhqrk,brnkhd->bnqhd', p_win, v_band)
                + jnp.einsum('bnhqc,bchd->bnqhd', p[..., n_win:], v_c))

    o = lax.map(one_row, (q_rows, jnp.asarray(row_idx), jnp.asarray(row_off)))
    out_l = jnp.moveaxis(o, 0, 1).reshape(bsz, seq, NA_HEADS * NA_HEADDIM)
    out_c = blocked_attention(q_c, k_c, v_c) if need_ctx else None
    return out_l, out_c


def merge_branches(branches, gate_cols, w_branch, w_out):
    bsz, t, _ = gate_cols.shape
    gates = jax.nn.sigmoid(gate_cols.reshape(bsz, t, N_BRANCH, D_MODEL))
    merged = gates[:, :, 0] * (branches[0] @ w_branch[0])
    for i in range(1, N_BRANCH):
        merged = merged + gates[:, :, i] * (branches[i] @ w_branch[i])
    return merged @ w_out


def token_mixers(u, uc, w_in, mla_kv_norm_g, mla_w_uk, mla_w_uv, mla_q_norm_g, mla_k_norm_g,
                 ssd_conv_w, ssd_conv_b, ssd_a_log, ssd_dt_bias, ssd_d, ssd_norm_g,
                 na_q_norm_g, na_k_norm_g, na_rpb, w_branch, w_out, cos, sin, need_ctx):
    split_at = np.cumsum(IN_SIZES)[:-1].tolist()
    pl = jnp.split(u @ w_in, split_at, axis=-1)
    pc = jnp.split(uc @ w_in, split_at, axis=-1)
    mla_l, mla_c = mla_mixer(pl[0:3], pc[0:3], mla_kv_norm_g, mla_w_uk, mla_w_uv, mla_q_norm_g, mla_k_norm_g, cos, sin, need_ctx)
    ssd_l, ssd_c = ssd_mixer(pl[3:6], pc[3:6], ssd_conv_w, ssd_conv_b, ssd_a_log, ssd_dt_bias, ssd_d, ssd_norm_g, need_ctx)
    na_l, na_c = na_mixer(pl[6], pc[6], na_q_norm_g, na_k_norm_g, na_rpb, need_ctx)
    out_l = merge_branches((mla_l, ssd_l, na_l), pl[7], w_branch, w_out)
    out_c = merge_branches((mla_c, ssd_c, na_c), pc[7], w_branch, w_out) if need_ctx else None
    return out_l, out_c


def setup_inputs(seed: int = 0) -> dict:
    key = jax.random.key(seed)
    keys = iter(jax.random.split(key, 40))

    def normal(shape, scale):
        return jax.random.normal(next(keys), shape, jnp.float32) * scale

    def gain(shape):
        return 1.0 + normal(shape, 0.02)

    L = DEPTH
    dt0 = jnp.exp(jax.random.uniform(next(keys), (L, 2, SSD_HEADS), jnp.float32, math.log(1e-3), math.log(1e-1)))
    a_init = jax.random.uniform(next(keys), (L, 2, SSD_HEADS), jnp.float32, 1.0, 16.0)
    return {
        'x': normal((BATCH, SEQ, D_MODEL), 1.0),
        'c': normal((BATCH, D_MODEL), 1.0),
        'ctx': normal((BATCH, CTX_LEN, D_MODEL), 1.0),
        'c_ctx': normal((D_MODEL,), 1.0),
        'w_ada': normal((L, D_MODEL, N_MOD * D_MODEL), 0.5 * D_MODEL ** -0.5),
        'b_ada': normal((L, N_MOD * D_MODEL), 0.02),
        'norm_g': gain((L, 3, D_MODEL)),
        'ffn1_w_gate': normal((L, D_MODEL, D_FF), D_MODEL ** -0.5),
        'ffn1_w_up': normal((L, D_MODEL, D_FF), D_MODEL ** -0.5),
        'ffn1_w_down': normal((L, D_FF, D_MODEL), D_FF ** -0.5),
        'ffn2_w_gate': normal((L, D_MODEL, D_FF), D_MODEL ** -0.5),
        'ffn2_w_up': normal((L, D_MODEL, D_FF), D_MODEL ** -0.5),
        'ffn2_w_down': normal((L, D_FF, D_MODEL), D_FF ** -0.5),
        'w_in': normal((L, D_MODEL, D_IN), D_MODEL ** -0.5),
        'mla_kv_norm_g': gain((L, MLA_KV_RANK)),
        'mla_w_uk': normal((L, MLA_KV_RANK, MLA_HEADS * MLA_NOPE), MLA_KV_RANK ** -0.5),
        'mla_w_uv': normal((L, MLA_KV_RANK, MLA_HEADS * MLA_V), MLA_KV_RANK ** -0.5),
        'mla_q_norm_g': gain((L, MLA_QK_DIM)),
        'mla_k_norm_g': gain((L, MLA_QK_DIM)),
        'ssd_conv_w': normal((L, SSD_CONV, SSD_XBC), SSD_CONV ** -0.5),
        'ssd_conv_b': normal((L, SSD_XBC), 0.02),
        'ssd_a_log': jnp.log(a_init),
        'ssd_dt_bias': dt0 + jnp.log(-jnp.expm1(-dt0)),
        'ssd_d': 1.0 + normal((L, SSD_HEADS), 0.1),
        'ssd_norm_g': gain((L, SSD_INNER)),
        'na_q_norm_g': gain((L, NA_HEADDIM)),
        'na_k_norm_g': gain((L, NA_HEADDIM)),
        'na_rpb': normal((L, NA_HEADS, 2 * NA_WIN_ROWS - 1, 2 * NA_WIN_COLS - 1), 0.1),
        'w_branch': normal((L, N_BRANCH, BRANCH_WIDTH, D_MODEL), BRANCH_WIDTH ** -0.5),
        'w_out': normal((L, D_MODEL, D_MODEL), D_MODEL ** -0.5),
    }


def reference(x, c, ctx, c_ctx, w_ada, b_ada, norm_g, ffn1_w_gate, ffn1_w_up, ffn1_w_down,
              ffn2_w_gate, ffn2_w_up, ffn2_w_down, w_in, mla_kv_norm_g, mla_w_uk, mla_w_uv,
              mla_q_norm_g, mla_k_norm_g, ssd_conv_w, ssd_conv_b, ssd_a_log, ssd_dt_bias, ssd_d,
              ssd_norm_g, na_q_norm_g, na_k_norm_g, na_rpb, w_branch, w_out):
    cos, sin = axial_rope_tables(x.shape[1])
    h, hc = x, ctx
    for l in range(DEPTH):
        need_ctx = l < DEPTH - 1
        m = adaln(c, w_ada[l], b_ada[l])
        mc = adaln(c_ctx[None], w_ada[l], b_ada[l])
        h = ffn_sublayer(h, m, 0, norm_g[l, 0], ffn1_w_gate[l], ffn1_w_up[l], ffn1_w_down[l])
        hc = ffn_sublayer(hc, mc, 0, norm_g[l, 0], ffn1_w_gate[l], ffn1_w_up[l], ffn1_w_down[l])
        u = modulate(rmsnorm(h, norm_g[l, 1]), m, 3)
        uc = modulate(rmsnorm(hc, norm_g[l, 1]), mc, 3)
        mix, mix_c = token_mixers(u, uc, w_in[l], mla_kv_norm_g[l], mla_w_uk[l], mla_w_uv[l],
                                  mla_q_norm_g[l], mla_k_norm_g[l], ssd_conv_w[l], ssd_conv_b[l],
                                  ssd_a_log[l], ssd_dt_bias[l], ssd_d[l], ssd_norm_g[l],
                                  na_q_norm_g[l], na_k_norm_g[l], na_rpb[l], w_branch[l], w_out[l],
                                  cos, sin, need_ctx)
        h = h + m[:, 5][:, None] * mix
        h = ffn_sublayer(h, m, 6, norm_g[l, 2], ffn2_w_gate[l], ffn2_w_up[l], ffn2_w_down[l])
        if need_ctx:
            hc = hc + mc[:, 5][:, None] * mix_c
            hc = ffn_sublayer(hc, mc, 6, norm_g[l, 2], ffn2_w_gate[l], ffn2_w_up[l], ffn2_w_down[l])
    return h
```

```cpp
#include <hip/hip_runtime.h>
#include <cstdio>
#include <cstdint>

#ifndef MK_PER_STEP
#define MK_PER_STEP 0
#endif

#ifndef MK_I8GATE
#define MK_I8GATE 1
#endif
#ifndef MK_I8GU
#define MK_I8GU 1
#endif
#define LAS __attribute__((address_space(3)))
#define GAS __attribute__((address_space(1)))
typedef unsigned short bf16_t;
typedef short bf16x8 __attribute__((ext_vector_type(8)));
typedef short s16x4 __attribute__((ext_vector_type(4)));
typedef float f32x2 __attribute__((ext_vector_type(2)));
typedef float f32x4 __attribute__((ext_vector_type(4)));
typedef float f32x16 __attribute__((ext_vector_type(16)));
typedef unsigned u32x2 __attribute__((ext_vector_type(2)));
typedef unsigned u32x4 __attribute__((ext_vector_type(4)));
typedef int i32x4 __attribute__((ext_vector_type(4)));
typedef GAS unsigned gu32;

constexpr int DM = 2048, NB = 8, SEQ = 2048, CTX = 256, NLAT = NB * SEQ, NCTXR = NB * CTX, NROW = NLAT + NCTXR;
constexpr int DFF = 5632, NMOD = 9, DIN = 14432, DINP = 8448, NWIN = 14592;
constexpr int PC_Q = 0, PC_CKV = 1536, PC_Z = 2048, PC_XBC = 3072, PC_NAQ = 5120, PC_NAK = 6144, PC_NAV = 7168, PC_KR = 8192, PC_DT = 8256;
constexpr int GT0 = 33;
constexpr int KVROWS = CTX + SEQ;
constexpr int NCHUNK = 18;
constexpr float EPS = 1e-6f;
constexpr float LOG2E = 1.4426950408889634f;

constexpr size_t MiB = 1u << 20;
constexpr size_t WS_CTL = 0, CTL_ZERO_BYTES = 4 * MiB;
constexpr size_t WS_MOD = 1 * MiB;
constexpr size_t WS_ROPE = 4 * MiB;
constexpr size_t WS_CDEC = 4 * MiB + 65536;
constexpr size_t WS_DT = 5 * MiB;
constexpr size_t WS_HC = 8 * MiB;
constexpr size_t WS_WGU1 = 24 * MiB, WS_WDN1 = 68 * MiB, WS_WGU2 = 90 * MiB, WS_WDN2 = 134 * MiB, WS_WIN = 156 * MiB, WS_WUKV = 213 * MiB, WS_WBR = 215 * MiB, WS_WOUT = 227 * MiB;
constexpr size_t WS_U = 236 * MiB;
constexpr size_t WS_P = 308 * MiB;
constexpr size_t WS_GATE = 605 * MiB;
constexpr size_t WS_K = 821 * MiB;
constexpr size_t WS_V = 875 * MiB;
constexpr size_t WS_XBC = 911 * MiB;
constexpr size_t WS_SST = 983 * MiB;
constexpr size_t WS_BR = 1127 * MiB;
constexpr size_t WS_END = 1235 * MiB;
constexpr int CW_TMO = 0, CW_BAR = 4096, CW_Q = 16384;
constexpr size_t WS_GSS = 3 * MiB;
constexpr size_t WS_CMAX = 3 * MiB + 640 * 1024;
constexpr size_t WS_RSC = 4 * MiB + 131072;
constexpr size_t WS_U8M = WS_XBC;
constexpr int NQCOL = 28672;
constexpr size_t WS_SENT = WS_U;

constexpr int LDS_SCRATCH = 155648, MISC_OFF = LDS_SCRATCH, LDS_BYTES = 159744;

__device__ __forceinline__ float bf2f(unsigned short b) { return __uint_as_float(((unsigned)b) << 16); }
__device__ __forceinline__ unsigned pk2(float lo, float hi) { unsigned r; asm("v_cvt_pk_bf16_f32 %0, %1, %2" : "=v"(r) : "v"(lo), "v"(hi)); return r; }
__device__ __forceinline__ float lo16(unsigned w) { return __uint_as_float(w << 16); }
__device__ __forceinline__ float hi16(unsigned w) { return __uint_as_float(w & 0xffff0000u); }
__device__ __forceinline__ float fast_exp2(float x) { return __builtin_amdgcn_exp2f(x); }
__device__ __forceinline__ float fast_rcp(float x) { return __builtin_amdgcn_rcpf(x); }
__device__ __forceinline__ float sigmoidf_(float x) { return fast_rcp(1.0f + fast_exp2(-x * LOG2E)); }
__device__ __forceinline__ float siluf_(float x) { return x * sigmoidf_(x); }
__device__ __forceinline__ float wave_sum(float v) {
#pragma unroll
    for (int o = 1; o < 64; o <<= 1) v += __shfl_xor(v, o);
    return v;
}
#define LDS_WAIT() asm volatile("s_waitcnt lgkmcnt(0)" ::: "memory")
#define VM_WAIT() asm volatile("s_waitcnt vmcnt(0)" ::: "memory")

namespace pg8 {
constexpr int BM = 256, BK = 64, HALF = 128, HTB = HALF * BK * 2, STAGE_BYTES = 8 * HTB, NXCD = 8, WGM = 4;
__host__ __device__ __forceinline__ int lds_byte(int r, int c) { const int st = (r >> 4) * 2 + (c >> 5), rr = r & 15, cc = c & 31, ob = rr * 64 + cc * 2; return st * 1024 + (ob ^ (((ob >> 9) & 1) << 5)); }
__host__ __device__ __forceinline__ void stage_rc(int b, int& R, int& C) { const int st = b / 1024, sb = b % 1024, swz = sb ^ (((sb >> 9) & 1) << 5); R = (st >> 1) * 16 + swz / 64; C = (st & 1) * 32 + (swz % 64) / 2; }
__host__ __device__ __forceinline__ int perm32(int rho) { const int n = rho >> 4, i = rho & 15; return 8 * (i >> 2) + 4 * n + (i & 3); }
struct Unit { int pm, pn, sub; };
__device__ __forceinline__ unsigned cvt_pk_bf16(float lo, float hi) { unsigned r; asm volatile("v_cvt_pk_bf16_f32 %0, %1, %2" : "=v"(r) : "v"(lo), "v"(hi)); return r; }

__device__ __forceinline__ bool tile_of(long L, int nM, int nN, Unit& u) {
    const int nwg = nM * nN; if (L >= nwg) return false;
    int wgid = (int)L; { const int q = nwg / NXCD, r = nwg % NXCD, xcd = wgid % NXCD, off = wgid / NXCD; wgid = (xcd < r ? xcd * (q + 1) : r * (q + 1) + (xcd - r) * q) + off; }
    const int nig = WGM * nN, gid = wgid / nig, fm = gid * WGM, gsz = (nM - fm) < WGM ? (nM - fm) : WGM;
    u.pm = fm + ((wgid % nig) % gsz); u.pn = (wgid % nig) / gsz; u.sub = 0; return true;
}
struct ProbStd {
    const bf16_t* A; const bf16_t* Bt; int lda, ldb, K, nM, nN, G, c;
    __device__ __forceinline__ bool next(int i, Unit& u) const { return tile_of((long)i * G + c, nM, nN, u); }
    __device__ __forceinline__ const char* a_base(const Unit& u) const { return (const char*)(A + (size_t)u.pm * BM * lda); }
    __device__ __forceinline__ const char* b_base(const Unit& u) const { return (const char*)(Bt + (size_t)u.pn * BM * ldb); }
    __device__ __forceinline__ bool is_i8(const Unit&) const { return false; }
    __device__ __forceinline__ bool keep_acc(const Unit&) const { return false; }
    __device__ __forceinline__ int nt(const Unit&) const { return K / BK; }
};
struct ProbSplit {
    const bf16_t* A; const bf16_t* Bt; int lda, ldb, K, nM, G, c;
    __device__ __forceinline__ bool next(int i, Unit& u) const {
        if (i < 2) { const bool ok = tile_of((long)i * G + c, 64, 8, u); u.pm = 63 - u.pm; return ok; }
        if (i > 2 || nM == 64) return false;
        const int q = c >> 2; u.pm = 64 + (q >> 3); u.pn = q & 7; u.sub = 1 + (c & 3); return true; }
    __device__ __forceinline__ int nt(const Unit& u) const { return u.sub ? K / (4 * BK) : K / BK; }
    __device__ __forceinline__ const char* a_base(const Unit& u) const { return (const char*)(A + (size_t)u.pm * BM * lda + (u.sub ? (u.sub - 1) * (K / 4) : 0)); }
    __device__ __forceinline__ const char* b_base(const Unit& u) const { return (const char*)(Bt + (size_t)u.pn * BM * ldb + (u.sub ? (u.sub - 1) * (K / 4) : 0)); }
    __device__ __forceinline__ bool is_i8(const Unit&) const { return false; }
    __device__ __forceinline__ bool keep_acc(const Unit&) const { return false; }
};
struct ProbWin {
    const bf16_t* A; const bf16_t* Bt; int lda, ldb, K, full, G, c;
    __device__ __forceinline__ bool next(int i, Unit& u) const {
        const int L = i * G + c, per = full ? 33 : 19;
        Unit t; const bool lat = tile_of(L < 64 * 33 ? L : 0, 64, 33, t);
        const int r = L - 64 * 33, rr = r < 0 ? 0 : r, j = rr % per;
        const int cpn = full ? j : j + 6 + (j >= 2 ? 4 : 0) + (j >= 10 ? 4 : 0);
        const bool isl = L < 64 * 33;
        u.pm = isl ? t.pm : 64 + rr / per; u.pn = isl ? t.pn : cpn; u.sub = 0;
        return isl ? lat : (r < 8 * per); }
    __device__ __forceinline__ bool is_i8(const Unit&) const { return false; }
    __device__ __forceinline__ const char* a_base(const Unit& u) const { return (const char*)(A + (size_t)u.pm * BM * lda); }
    __device__ __forceinline__ const char* b_base(const Unit& u) const { return (const char*)(Bt + (size_t)u.pn * BM * ldb); }
    __device__ __forceinline__ bool keep_acc(const Unit&) const { return false; }
    __device__ __forceinline__ size_t a_kstep() const { return (size_t)BK * 2; }
    __device__ __forceinline__ int nt(const Unit&) const { return K / BK; }
};
struct ProbGate {
    const bf16_t* A8; const bf16_t* Bt; int lda, ldb, K, nM, G, c;
    __device__ __forceinline__ bool next(int i, Unit& u) const { const bool ok = tile_of((long)i * G + c, nM, 24, u); u.pn += GT0; return ok; }
    __device__ __forceinline__ bool is_i8(const Unit&) const { return true; }
    __device__ __forceinline__ const char* a_base(const Unit& u) const { return (const char*)(A8 + (size_t)u.pm * BM * lda); }
    __device__ __forceinline__ const char* b_base(const Unit& u) const { return (const char*)(Bt + (size_t)u.pn * BM * ldb); }
    __device__ __forceinline__ bool keep_acc(const Unit&) const { return false; }
    __device__ __forceinline__ size_t a_kstep() const { return (size_t)BK * 2; }
    __device__ __forceinline__ int nt(const Unit&) const { return K / BK; }
};
struct ProbWin57 {
    const bf16_t* A; const bf16_t* A8; const bf16_t* Bt; int lda, ldb, K, full, G, c;
    __device__ __forceinline__ bool next(int i, Unit& u) const {
        const int L = i * G + c, per = full ? 57 : 19;
        Unit t; const bool lat = tile_of(L < 64 * 57 ? L : 0, 64, 57, t);
        const int r = L - 64 * 57, rr = r < 0 ? 0 : r, j = rr % per;
        const int cpn = full ? j : j + 6 + (j >= 2 ? 4 : 0) + (j >= 10 ? 4 : 0);
        const bool isl = L < 64 * 57;
        u.pm = isl ? t.pm : 64 + rr / per; u.pn = isl ? t.pn : cpn; u.sub = 0;
        return isl ? lat : (r < 8 * per); }
    __device__ __forceinline__ const char* a_base(const Unit& u) const { return (const char*)((MK_I8GATE && u.pn >= GT0 ? A8 : A) + (size_t)u.pm * BM * lda); }
    __device__ __forceinline__ const char* b_base(const Unit& u) const { return (const char*)(Bt + (size_t)u.pn * BM * ldb); }
    __device__ __forceinline__ bool is_i8(const Unit& u) const { return MK_I8GATE && u.pn >= GT0; }
    __device__ __forceinline__ bool keep_acc(const Unit&) const { return false; }
    __device__ __forceinline__ int nt(const Unit& u) const { return (MK_I8GATE && u.pn >= GT0) ? K / (2 * BK) : K / BK; }
};
struct ProbMerge {
    const bf16_t* A; const bf16_t* Bt; int lda, ldb, K, nM, nN, G, c;
    __device__ __forceinline__ bool next(int i, Unit& u) const { const int t = i / 3; const bool ok = tile_of((long)t * G + c, nM, nN, u); u.sub = i - 3 * t; return ok; }
    __device__ __forceinline__ const char* a_base(const Unit& u) const { return (const char*)(A + (size_t)u.pm * BM * lda + u.sub * 1024); }
    __device__ __forceinline__ const char* b_base(const Unit& u) const { return (const char*)(Bt + (size_t)u.sub * DM * 1024 + (size_t)u.pn * BM * ldb); }
    __device__ __forceinline__ bool is_i8(const Unit&) const { return false; }
    __device__ __forceinline__ bool keep_acc(const Unit& u) const { return u.sub != 2; }
    __device__ __forceinline__ int nt(const Unit&) const { return K / BK; }
};

template <class Epi, class Prob, int MODE = 0>
__device__ __forceinline__ void gemm_phase(LAS unsigned char* lds, const Prob& S, const Epi& E, const int tid) {
    const int wid = __builtin_amdgcn_readfirstlane(tid >> 6), lane = tid & 63, wr = wid >> 2, wc = wid & 3, fr = lane & 15, fq = lane >> 4;
    unsigned voffA[2], voffB[2];
#pragma unroll
    for (int i = 0; i < 2; ++i) { int R, C; stage_rc(tid * 16 + i * 8192, R, C); const int Rb = Epi::PERM ? ((R & ~31) + perm32(R & 31)) : R;
        voffA[i] = (unsigned)(R * S.lda + C) * 2u; voffB[i] = (unsigned)(Rb * S.ldb + C) * 2u; }
    const size_t kstep = (size_t)(BK * 2);
    const size_t hstepA = (size_t)HALF * S.lda * 2, hstepB = (size_t)HALF * S.ldb * 2;
    const unsigned ldsw = (unsigned)wid * 1024u;
    constexpr unsigned STAGE_BYTES_ = 8u * HTB;
    const int aoff = lds_byte(wr * 64 + fr, fq * 8), boff = lds_byte(wc * 32 + fr, fq * 8);
#define PG8_SA(b, h) (((b) * 2 + (h)) * HTB)
#define PG8_SB(b, h) ((4 + (b) * 2 + (h)) * HTB)
#define PG8_STAGE(bufoff, gbase, voff) do { _Pragma("unroll") for (int _i = 0; _i < 2; ++_i) \
        __builtin_amdgcn_global_load_lds((const unsigned*)((const char*)(gbase) + (voff)[_i]), (LAS unsigned*)(lds + (bufoff) + ldsw + _i * 8192), 16, 0, 0); } while (0)
#define PG8_LDA(dst, b, h) do { _Pragma("unroll") for (int m = 0; m < 4; ++m) _Pragma("unroll") for (int k = 0; k < 2; ++k) dst[m][k] = *(const LAS bf16x8*)(lds + PG8_SA(b, h) + aoff + m * 2048 + k * 1024); } while (0)
#define PG8_LDB(dst, b, h) do { _Pragma("unroll") for (int n = 0; n < 2; ++n) _Pragma("unroll") for (int k = 0; k < 2; ++k) dst[n][k] = *(const LAS bf16x8*)(lds + PG8_SB(b, h) + boff + n * 2048 + k * 1024); } while (0)
#define PG8_MMA_I8(ai, bj, At, Bt) do { __builtin_amdgcn_s_setprio(1); _Pragma("unroll") for (int m = 0; m < 4; ++m) _Pragma("unroll") for (int n = 0; n < 2; ++n) _Pragma("unroll") for (int k = 0; k < 2; ++k) \
        acc[ai][bj][m][n] = __builtin_bit_cast(f32x4, __builtin_amdgcn_mfma_i32_16x16x64_i8(__builtin_bit_cast(i32x4, Bt[n][k]), __builtin_bit_cast(i32x4, At[m][k]), __builtin_bit_cast(i32x4, acc[ai][bj][m][n]), 0, 0, 0)); \
        __builtin_amdgcn_s_setprio(0); } while (0)
#define PG8_MMA_BF(ai, bj, At, Bt) do { __builtin_amdgcn_s_setprio(1); _Pragma("unroll") for (int m = 0; m < 4; ++m) _Pragma("unroll") for (int n = 0; n < 2; ++n) _Pragma("unroll") for (int k = 0; k < 2; ++k) \
        acc[ai][bj][m][n] = __builtin_amdgcn_mfma_f32_16x16x32_bf16(Bt[n][k], At[m][k], acc[ai][bj][m][n], 0, 0, 0); __builtin_amdgcn_s_setprio(0); } while (0)
#define PG8_WAIT_V(n) asm volatile("s_waitcnt vmcnt(" #n ")" ::: "memory")
#define PG8_WAIT_L(n) asm volatile("s_waitcnt lgkmcnt(" #n ")" ::: "memory")
#define PG8_BAR __builtin_amdgcn_s_barrier()
#define PG8_SCHED __builtin_amdgcn_sched_barrier(0)
#define PG8_KLOOP(MMAX) \
        for (int t = 0; t < nt; t += 2) { \
            const bool last = (t == nt - 2); \
            if (Epi::LDSSC && last) E.issue_scales(cur, lds + STAGE_BYTES_ + ldsw - (unsigned)wid * 256u, wr, wc, lane); \
            const char* a1 = cA + (size_t)(t + 1) * kstep; \
            const char* a2 = last ? nA : cA + (size_t)(t + 2) * kstep; const char* b2 = last ? nB : cB + (size_t)(t + 2) * kstep; \
            const char* a3 = a2 + kstep; const char* b3 = b2 + kstep; \
            PG8_LDB(B0, 0, 0); PG8_LDB(B1, 0, 1); PG8_SCHED; PG8_LDA(At, 0, 0); PG8_STAGE(PG8_SA(1, 1), a1 + hstepA, voffA); \
            PG8_WAIT_V(8); PG8_WAIT_L(0); PG8_BAR; MMAX(0, 0, At, B0); MMAX(0, 1, At, B1); PG8_BAR; PG8_SCHED; \
            PG8_LDA(At, 0, 1); PG8_STAGE(PG8_SB(0, 0), b2, voffB); PG8_STAGE(PG8_SB(0, 1), b2 + hstepB, voffB); PG8_STAGE(PG8_SA(0, 0), a2, voffA); \
            PG8_WAIT_V(8); PG8_WAIT_L(0); PG8_BAR; MMAX(1, 0, At, B0); MMAX(1, 1, At, B1); PG8_BAR; PG8_SCHED; \
            PG8_LDB(B0, 1, 0); PG8_LDB(B1, 1, 1); PG8_SCHED; PG8_LDA(At, 1, 0); PG8_STAGE(PG8_SA(0, 1), a2 + hstepA, voffA); \
            PG8_WAIT_V(8); PG8_WAIT_L(0); PG8_BAR; MMAX(0, 0, At, B0); MMAX(0, 1, At, B1); PG8_BAR; PG8_SCHED; \
            PG8_LDA(At, 1, 1); PG8_STAGE(PG8_SB(1, 0), b3, voffB); PG8_STAGE(PG8_SB(1, 1), b3 + hstepB, voffB); PG8_STAGE(PG8_SA(1, 0), a3, voffA); \
            PG8_WAIT_V(8); PG8_WAIT_L(0); PG8_BAR; MMAX(1, 0, At, B0); MMAX(1, 1, At, B1); PG8_BAR; PG8_SCHED; \
        }
    Unit cur, nxt; int ui = 0;
    if (!S.next(0, cur)) return;
    int nt = S.nt(cur); bool i8u = S.is_i8(cur); (void)i8u;
    f32x4 acc[2][2][4][2];
#pragma unroll
    for (int a = 0; a < 2; ++a)
#pragma unroll
        for (int b = 0; b < 2; ++b)
#pragma unroll
            for (int m = 0; m < 4; ++m)
#pragma unroll
                for (int n = 0; n < 2; ++n) acc[a][b][m][n] = (f32x4){0.f, 0.f, 0.f, 0.f};
    bf16x8 At[4][2], B0[2][2], B1[2][2];
    const char* cA = S.a_base(cur); const char* cB = S.b_base(cur);
    PG8_STAGE(PG8_SB(0, 0), cB, voffB); PG8_STAGE(PG8_SB(0, 1), cB + hstepB, voffB); PG8_STAGE(PG8_SA(0, 0), cA, voffA); PG8_STAGE(PG8_SA(0, 1), cA + hstepA, voffA);
    if (wr == 1) PG8_BAR;
    PG8_WAIT_V(2); PG8_BAR;
    PG8_STAGE(PG8_SB(1, 0), cB + kstep, voffB); PG8_STAGE(PG8_SA(1, 0), cA + kstep, voffA); PG8_STAGE(PG8_SB(1, 1), cB + hstepB + kstep, voffB);
    PG8_WAIT_V(6); PG8_BAR;
    for (;;) {
        const bool has_next = S.next(ui + 1, nxt);
        const char* nA = has_next ? S.a_base(nxt) : cA; const char* nB = has_next ? S.b_base(nxt) : cB;
        if (MODE == 1 || (MODE == 2 && i8u)) { PG8_KLOOP(PG8_MMA_I8) } else { PG8_KLOOP(PG8_MMA_BF) }
        if (wr == 0) PG8_BAR;
        E(acc, cur, wr, wc, fr, fq);
        if (!has_next) break;
        if (!S.keep_acc(cur)) {
#pragma unroll
            for (int a = 0; a < 2; ++a)
#pragma unroll
                for (int b = 0; b < 2; ++b)
#pragma unroll
                    for (int m = 0; m < 4; ++m)
#pragma unroll
                        for (int n = 0; n < 2; ++n) acc[a][b][m][n] = (f32x4){0.f, 0.f, 0.f, 0.f};
        }
        cur = nxt; cA = nA; cB = nB; ++ui; nt = S.nt(cur); i8u = S.is_i8(cur);
        if (wr == 1) PG8_BAR;
    }
    PG8_WAIT_V(0);
    PG8_BAR;
#undef PG8_SA
#undef PG8_SB
#undef PG8_STAGE
#undef PG8_LDA
#undef PG8_LDB
#undef PG8_MMA_I8
#undef PG8_MMA_BF
#undef PG8_KLOOP
#undef PG8_WAIT_V
#undef PG8_WAIT_L
#undef PG8_BAR
#undef PG8_SCHED
}

struct RowMap { float* lat; float* ctx;
    __device__ __forceinline__ float* tile(int pm) const { return pm < 64 ? lat + (size_t)pm * 256 * DM : ctx + (size_t)(pm - 64) * 256 * DM; } };

template <bool I8> struct EpiSwiglu {
    static constexpr bool PERM = true;
    static constexpr bool LDSSC = I8;
    bf16_t* O;
    const float* rsc; const float* cmax;
    LAS unsigned char* ldsb;
    __device__ __forceinline__ void issue_scales(const Unit& u, LAS unsigned char* slot, int wr, int wc, int lane) const {
        const float* rp = rsc + u.pm * BM + wr * 64 + lane;
        __builtin_amdgcn_global_load_lds((const unsigned*)rp, (LAS unsigned*)slot, 4, 0, 0);
        __builtin_amdgcn_global_load_lds((const unsigned*)(rp + HALF), (LAS unsigned*)(slot + 256), 4, 0, 0);
        __builtin_amdgcn_global_load_lds((const unsigned*)(cmax + u.pn * BM + (lane >> 5) * HALF + wc * 32 + (lane & 31)), (LAS unsigned*)(slot + 512), 4, 0, 0);
    }
    __device__ __forceinline__ void operator()(f32x4 (&acc)[2][2][4][2], const Unit& u, int wr, int wc, int fr, int fq) const {
        const int row0 = u.pm * BM + wr * 64 + fr, col0 = u.pn * 128 + wc * 32 + 8 * fq;
        const LAS float* sl = (const LAS float*)(ldsb + 8 * HTB + (wr * 4 + wc) * 768);
        f32x4 cs[2][2];
        if (I8) {
#pragma unroll
            for (int bj = 0; bj < 2; ++bj)
#pragma unroll
                for (int n = 0; n < 2; ++n) cs[bj][n] = *(const LAS f32x4*)(sl + 128 + bj * 32 + 8 * fq + 4 * n) * (1.0f / 127.0f);
        }
#pragma unroll
        for (int ai = 0; ai < 2; ++ai)
#pragma unroll
            for (int m = 0; m < 4; ++m) {
                f32x4 g0 = acc[ai][0][m][0], g1 = acc[ai][0][m][1], u0 = acc[ai][1][m][0], u1 = acc[ai][1][m][1], v0, v1;
                if (I8) { const float rs = sl[ai * 64 + 16 * m + fr];
                    const i32x4 ig0 = __builtin_bit_cast(i32x4, g0), ig1 = __builtin_bit_cast(i32x4, g1), iu0 = __builtin_bit_cast(i32x4, u0), iu1 = __builtin_bit_cast(i32x4, u1);
#pragma unroll
                    for (int j = 0; j < 4; ++j) { g0[j] = (float)ig0[j] * rs * cs[0][0][j]; g1[j] = (float)ig1[j] * rs * cs[0][1][j]; u0[j] = (float)iu0[j] * rs * cs[1][0][j]; u1[j] = (float)iu1[j] * rs * cs[1][1][j]; } }
#pragma unroll
                for (int j = 0; j < 4; ++j) { v0[j] = siluf_(g0[j]) * u0[j]; v1[j] = siluf_(g1[j]) * u1[j]; }
                u32x4 w; w.x = cvt_pk_bf16(v0[0], v0[1]); w.y = cvt_pk_bf16(v0[2], v0[3]); w.z = cvt_pk_bf16(v1[0], v1[1]); w.w = cvt_pk_bf16(v1[2], v1[3]);
                *(GAS u32x4*)((GAS bf16_t*)O + (size_t)(row0 + ai * HALF + m * 16) * DFF + col0) = w; }
    }
};
struct EpiResid {
    static constexpr bool LDSSC = false; __device__ __forceinline__ void issue_scales(const Unit&, LAS unsigned char*, int, int, int) const {}
    static constexpr bool PERM = false;
    RowMap base, out; const float* mod; int modidx; float mul; float* slab;
    __device__ __forceinline__ void operator()(f32x4 (&acc)[2][2][4][2], const Unit& u, int wr, int wc, int fr, int fq) const {
        const int r9 = u.pm < 64 ? (u.pm >> 3) : 8;
        const float* sc = mod + (size_t)r9 * (NMOD * DM) + modidx * DM;
        const int rloc = wr * 64 + fr, col0 = u.pn * BM + wc * 32 + 4 * fq;
        const float* bp = base.tile(u.pm); float* op = out.tile(u.pm);
        f32x4 sv[2][2];
#pragma unroll
        for (int bj = 0; bj < 2; ++bj)
#pragma unroll
            for (int n = 0; n < 2; ++n) sv[bj][n] = *(const f32x4*)(sc + col0 + bj * HALF + n * 16) * mul;
        const bool split = u.sub != 0;
        if (split) { op = slab + ((size_t)(u.sub - 1) * NCTXR + (size_t)(u.pm - 64) * 256) * DM; bp = op; }
        const GAS float* bpg = (const GAS float*)bp; GAS float* opg = (GAS float*)op;
#pragma unroll
        for (int ai = 0; ai < 2; ++ai)
#pragma unroll
            for (int mp = 0; mp < 2; ++mp) {
                f32x4 b[2][2][2];
#pragma unroll
                for (int mm = 0; mm < 2; ++mm) { const size_t off = (size_t)(rloc + ai * HALF + (2 * mp + mm) * 16) * DM + col0;
#pragma unroll
                    for (int bj = 0; bj < 2; ++bj)
#pragma unroll
                        for (int n = 0; n < 2; ++n) b[mm][bj][n] = split ? (f32x4){0.f, 0.f, 0.f, 0.f} : *(const GAS f32x4*)(bpg + off + bj * HALF + n * 16); }
#pragma unroll
                for (int mm = 0; mm < 2; ++mm) { const size_t off = (size_t)(rloc + ai * HALF + (2 * mp + mm) * 16) * DM + col0;
#pragma unroll
                    for (int bj = 0; bj < 2; ++bj)
#pragma unroll
                        for (int n = 0; n < 2; ++n) *(GAS f32x4*)(opg + off + bj * HALF + n * 16) = b[mm][bj][n] + sv[bj][n] * acc[ai][bj][2 * mp + mm][n]; }
            }
    }
};
struct EpiP {
    static constexpr bool LDSSC = false; __device__ __forceinline__ void issue_scales(const Unit&, LAS unsigned char*, int, int, int) const {}
    static constexpr bool PERM = true;
    bf16_t* O; int ldc;
    __device__ __forceinline__ void operator()(f32x4 (&acc)[2][2][4][2], const Unit& u, int wr, int wc, int fr, int fq) const {
        char* bu = (char*)(O + (size_t)(u.pm * BM + wr * 64) * ldc + u.pn * BM + wc * 32);
        const unsigned lo = (unsigned)(fr * ldc + 8 * fq) * 2u, s_m = (unsigned)(16 * ldc) * 2u, s_ai = (unsigned)(HALF * ldc) * 2u, s_bj = (unsigned)HALF * 2u;
#pragma unroll
        for (int ai = 0; ai < 2; ++ai)
#pragma unroll
            for (int m = 0; m < 4; ++m)
#pragma unroll
                for (int bj = 0; bj < 2; ++bj) { const f32x4 v0 = acc[ai][bj][m][0], v1 = acc[ai][bj][m][1];
                    u32x4 w; w.x = cvt_pk_bf16(v0[0], v0[1]); w.y = cvt_pk_bf16(v0[2], v0[3]); w.z = cvt_pk_bf16(v1[0], v1[1]); w.w = cvt_pk_bf16(v1[2], v1[3]);
                    *(u32x4*)(bu + (size_t)(ai * s_ai + m * s_m + bj * s_bj) + lo) = w; }
    }
};
struct EpiGate {
    static constexpr bool LDSSC = false; __device__ __forceinline__ void issue_scales(const Unit&, LAS unsigned char*, int, int, int) const {}
    static constexpr bool PERM = true;
    bf16_t* G; const float* rsc; const float* cmax;
    __device__ __forceinline__ void operator()(f32x4 (&acc)[2][2][4][2], const Unit& u, int wr, int wc, int fr, int fq) const {
        char* bu = (char*)(G + ((size_t)((u.pm * 24 + (u.pn - GT0)) * 8 + wr * 4 + wc) * 16) * 512);
        const unsigned lo = (unsigned)(fq * 16 + fr) * 16u;
        const float* cm = cmax + (u.pn - GT0) * BM + wc * 32 + 8 * fq;
        const float* rp = rsc + u.pm * BM + wr * 64 + fr;
        f32x4 cs[2][2];
#pragma unroll
        for (int bj = 0; bj < 2; ++bj) { cs[bj][0] = *(const f32x4*)(cm + bj * HALF) * (1.0f / 127.0f); cs[bj][1] = *(const f32x4*)(cm + bj * HALF + 4) * (1.0f / 127.0f); }
#pragma unroll
        for (int ai = 0; ai < 2; ++ai)
#pragma unroll
            for (int m = 0; m < 4; ++m) { const float rs = rp[ai * HALF + m * 16];
#pragma unroll
                for (int bj = 0; bj < 2; ++bj) { const i32x4 i0 = __builtin_bit_cast(i32x4, acc[ai][bj][m][0]), i1 = __builtin_bit_cast(i32x4, acc[ai][bj][m][1]); f32x4 v0, v1;
#pragma unroll
                    for (int j = 0; j < 4; ++j) { if (MK_I8GATE) { v0[j] = sigmoidf_((float)i0[j] * rs * cs[bj][0][j]); v1[j] = sigmoidf_((float)i1[j] * rs * cs[bj][1][j]); } else { v0[j] = sigmoidf_(acc[ai][bj][m][0][j]); v1[j] = sigmoidf_(acc[ai][bj][m][1][j]); } }
                    u32x4 w; w.x = cvt_pk_bf16(v0[0], v0[1]); w.y = cvt_pk_bf16(v0[2], v0[3]); w.z = cvt_pk_bf16(v1[0], v1[1]); w.w = cvt_pk_bf16(v1[2], v1[3]);
                    *(u32x4*)(bu + (size_t)(ai * 8 + m * 2 + bj) * 1024 + lo) = w; } }
    }
};
struct EpiP57 {
    static constexpr bool LDSSC = false; __device__ __forceinline__ void issue_scales(const Unit&, LAS unsigned char*, int, int, int) const {}
    static constexpr bool PERM = true;
    bf16_t* O; int ldc; bf16_t* G; const float* rsc; const float* cmax;
    __device__ __forceinline__ void operator()(f32x4 (&acc)[2][2][4][2], const Unit& u, int wr, int wc, int fr, int fq) const {
        const bool gate = u.pn >= GT0;
        char* bu = gate ? (char*)(G + ((size_t)((u.pm * 24 + (u.pn - GT0)) * 8 + wr * 4 + wc) * 16) * 512)
                        : (char*)(O + (size_t)(u.pm * BM + wr * 64) * ldc + u.pn * BM + wc * 32);
        const unsigned lo = gate ? (unsigned)(fq * 16 + fr) * 16u : (unsigned)(fr * ldc + 8 * fq) * 2u;
        const unsigned s_m = gate ? 2u * 1024u : (unsigned)(16 * ldc) * 2u, s_ai = gate ? 8u * 1024u : (unsigned)(HALF * ldc) * 2u, s_bj = gate ? 1024u : (unsigned)HALF * 2u;
        f32x4 cs[2][2];
        if (MK_I8GATE && gate) { const float* cm = cmax + (u.pn - GT0) * BM + wc * 32 + 8 * fq;
#pragma unroll
            for (int bj = 0; bj < 2; ++bj) { cs[bj][0] = *(const f32x4*)(cm + bj * HALF) * (1.0f / 127.0f); cs[bj][1] = *(const f32x4*)(cm + bj * HALF + 4) * (1.0f / 127.0f); } }
        const float* rp = rsc + u.pm * BM + wr * 64 + fr;
#pragma unroll
        for (int ai = 0; ai < 2; ++ai)
#pragma unroll
            for (int m = 0; m < 4; ++m) { float rs = 1.0f; if (MK_I8GATE && gate) rs = rp[ai * HALF + m * 16];
#pragma unroll
                for (int bj = 0; bj < 2; ++bj) { f32x4 v0 = acc[ai][bj][m][0], v1 = acc[ai][bj][m][1];
                    if (gate) {
                        if (MK_I8GATE) { const i32x4 i0 = __builtin_bit_cast(i32x4, v0), i1 = __builtin_bit_cast(i32x4, v1);
#pragma unroll
                            for (int j = 0; j < 4; ++j) { v0[j] = (float)i0[j] * rs * cs[bj][0][j]; v1[j] = (float)i1[j] * rs * cs[bj][1][j]; } }
#pragma unroll
                        for (int j = 0; j < 4; ++j) { v0[j] = sigmoidf_(v0[j]); v1[j] = sigmoidf_(v1[j]); } }
                    u32x4 w; w.x = cvt_pk_bf16(v0[0], v0[1]); w.y = cvt_pk_bf16(v0[2], v0[3]); w.z = cvt_pk_bf16(v1[0], v1[1]); w.w = cvt_pk_bf16(v1[2], v1[3]);
                    *(u32x4*)(bu + (size_t)(ai * s_ai + m * s_m + bj * s_bj) + lo) = w; } }
    }
};
struct EpiKV {
    static constexpr bool LDSSC = false; __device__ __forceinline__ void issue_scales(const Unit&, LAS unsigned char*, int, int, int) const {}
    static constexpr bool PERM = true;
    bf16_t* Kb; bf16_t* Vb;
    __device__ __forceinline__ void operator()(f32x4 (&acc)[2][2][4][2], const Unit& u, int wr, int wc, int fr, int fq) const {
        const int kv0 = u.pm < 64 ? (u.pm >> 3) * KVROWS + CTX + (u.pm & 7) * 256 : (u.pm - 64) * KVROWS;
        const bool isk = u.pn < 4;
        const int ld = isk ? 1536 : 1024, bjs = isk ? 192 : 128;
        bf16_t* dst = (isk ? Kb + u.pn * 384 : Vb + (u.pn - 4) * 256) + (size_t)(kv0 + wr * 64 + fr) * ld + wc * 32 + 8 * fq;
#pragma unroll
        for (int ai = 0; ai < 2; ++ai)
#pragma unroll
            for (int m = 0; m < 4; ++m)
#pragma unroll
                for (int bj = 0; bj < 2; ++bj) { const f32x4 v0 = acc[ai][bj][m][0], v1 = acc[ai][bj][m][1];
                    u32x4 w; w.x = cvt_pk_bf16(v0[0], v0[1]); w.y = cvt_pk_bf16(v0[2], v0[3]); w.z = cvt_pk_bf16(v1[0], v1[1]); w.w = cvt_pk_bf16(v1[2], v1[3]);
                    *(u32x4*)(dst + (size_t)(ai * HALF + m * 16) * ld + bj * bjs) = w; }
    }
};
struct EpiMerge {
    static constexpr bool LDSSC = false; __device__ __forceinline__ void issue_scales(const Unit&, LAS unsigned char*, int, int, int) const {}
    static constexpr bool PERM = true;
    const bf16_t* G; bf16_t* O;
    __device__ __forceinline__ void operator()(f32x4 (&acc)[2][2][4][2], const Unit& u, int wr, int wc, int fr, int fq) const {
        const int row0 = u.pm * BM + wr * 64 + fr, col0 = u.pn * BM + wc * 32 + 8 * fq;
        const bf16_t* gp = G + ((size_t)((u.pm * 24 + u.sub * 8 + u.pn) * 8 + wr * 4 + wc) * 16) * 512 + (fq * 16 + fr) * 8;
        constexpr size_t NEXTB = (size_t)8 * 8 * 16 * 512;
#pragma unroll
        for (int ai = 0; ai < 2; ++ai)
#pragma unroll
            for (int m = 0; m < 4; ++m) { const size_t row = (size_t)(row0 + ai * HALF + m * 16);
#pragma unroll
                for (int bj = 0; bj < 2; ++bj) {
                    const bf16_t* gq = gp + ((ai * 4 + m) * 2 + bj) * 512;
                    const u32x4 ga = *(const u32x4*)gq;
                    float f[8] = {lo16(ga.x), hi16(ga.x), lo16(ga.y), hi16(ga.y), lo16(ga.z), hi16(ga.z), lo16(ga.w), hi16(ga.w)};
                    if (u.sub != 2) { const u32x4 gb = *(const u32x4*)(gq + NEXTB);
                        const float d[8] = {lo16(gb.x), hi16(gb.x), lo16(gb.y), hi16(gb.y), lo16(gb.z), hi16(gb.z), lo16(gb.w), hi16(gb.w)};
#pragma unroll
                        for (int j = 0; j < 8; ++j) f[j] = f[j] * fast_rcp(fmaxf(d[j], 1e-20f)); }
                    f32x4 v0 = acc[ai][bj][m][0], v1 = acc[ai][bj][m][1];
#pragma unroll
                    for (int j = 0; j < 4; ++j) { v0[j] *= f[j]; v1[j] *= f[4 + j]; }
                    acc[ai][bj][m][0] = v0; acc[ai][bj][m][1] = v1;
                    if (u.sub == 2) { u32x4 w; w.x = cvt_pk_bf16(v0[0], v0[1]); w.y = cvt_pk_bf16(v0[2], v0[3]); w.z = cvt_pk_bf16(v1[0], v1[1]); w.w = cvt_pk_bf16(v1[2], v1[3]);
                        *(u32x4*)(O + row * DM + col0 + bj * HALF) = w; } } }
    }
};
}

#define XB_TMO      128
#define XB_XCNT(j)  (256  + 64 * (j))
#define XB_XSUB(j)  (1280 + 64 * (j))
#define XB_XGEN(j)  (2304 + 64 * (j))
#define XB_TOP      3328
#define XB_TOPGEN   3392
#define XCD_BAR_WORDS 3456
#define XB_SPIN_CAP (1u << 22)
__device__ __forceinline__ unsigned xb_ld(unsigned* p)              { return __hip_atomic_load(p, __ATOMIC_RELAXED, __HIP_MEMORY_SCOPE_AGENT); }
__device__ __forceinline__ unsigned xb_add(unsigned* p, unsigned v) { return __hip_atomic_fetch_add(p, v, __ATOMIC_RELAXED, __HIP_MEMORY_SCOPE_AGENT); }
__device__ __forceinline__ unsigned xb_xcc_id() { return (unsigned)__builtin_amdgcn_s_getreg((3 << 11) | 20) & 0xFu; }
#define XB_SPIN(cond, bar) do { unsigned _sp = 0; while (cond) { __builtin_amdgcn_s_sleep(1); \
    if ((++_sp & 255u) == 0u) { if (xb_ld(&(bar)[XB_TMO])) break; if (_sp > XB_SPIN_CAP) { atomicAdd(&(bar)[XB_TMO], 1u); break; } } } } while (0)
struct XcdBarrier { unsigned* bar; unsigned x; volatile LAS unsigned* st; };
__device__ __forceinline__ XcdBarrier xcd_barrier_post(unsigned* bar, volatile LAS unsigned* st) {
    XcdBarrier b; b.bar = bar; b.x = xb_xcc_id(); b.st = st;
    if (threadIdx.x == 0) (void)xb_add(&bar[XB_XCNT(b.x)], 1u);
    return b;
}
__device__ __forceinline__ void xcd_barrier_complete(unsigned* bar, unsigned x, unsigned& nloc, unsigned& nx) {
    const unsigned G = gridDim.x * gridDim.y * gridDim.z;
    unsigned sum, cnt, mine, sp = 0u;
    for (;;) {
        sum = 0u; cnt = 0u; mine = 0u;
#pragma unroll
        for (unsigned j = 0; j < 16; ++j) { const unsigned c = xb_ld(&bar[XB_XCNT(j)]); sum += c; cnt += (c > 0u) ? 1u : 0u; mine = (j == x) ? c : mine; }
        if (sum == G) break;
        __builtin_amdgcn_s_sleep(1);
        if ((++sp & 255u) == 0u) { if (xb_ld(&bar[XB_TMO])) break; if (sp > XB_SPIN_CAP) { atomicAdd(&bar[XB_TMO], 1u); break; } }
    }
    nloc = mine > 0u ? mine : 1u; nx = cnt > 0u ? cnt : 1u;
}
__device__ __forceinline__ void xcd_barrier(const XcdBarrier& b) {
    asm volatile("s_waitcnt vmcnt(0)" ::: "memory");
    __syncthreads();
    if (threadIdx.x == 0) {
        unsigned* bar = b.bar;
        __builtin_amdgcn_s_waitcnt(0);
        unsigned nloc = b.st[0], nx = b.st[1];
        if (nloc == 0u) { xcd_barrier_complete(bar, b.x, nloc, nx); b.st[0] = nloc; b.st[1] = nx; }
        const unsigned old = xb_add(&bar[XB_XSUB(b.x)], 1u);
        const unsigned gen = old / nloc;
        if (old + 1u == (gen + 1u) * nloc) {
            __builtin_amdgcn_fence(__ATOMIC_RELEASE, "agent");
            asm volatile("s_waitcnt vmcnt(0)" ::: "memory");
            const unsigned og = xb_add(&bar[XB_TOP], 1u);
            const unsigned tg = og / nx;
            if (og + 1u == (tg + 1u) * nx) xb_add(&bar[XB_TOPGEN], 1u);
            else XB_SPIN(xb_ld(&bar[XB_TOPGEN]) == tg, bar);
            __builtin_amdgcn_fence(__ATOMIC_ACQUIRE, "agent");
            xb_add(&bar[XB_XGEN(b.x)], 1u);
            asm volatile("s_waitcnt vmcnt(0)" ::: "memory");
        } else {
            XB_SPIN(xb_ld(&bar[XB_XGEN(b.x)]) == gen, bar);
            __builtin_amdgcn_fence(__ATOMIC_ACQUIRE, "agent");
            asm volatile("s_waitcnt vmcnt(0)" ::: "memory");
        }
    }
    __syncthreads();
}

struct Args { const float* in[30]; float* out; unsigned char* ws; int st_lo, st_hi; };
enum { I_X = 0, I_C, I_CTX, I_CCTX, I_WADA, I_BADA, I_NORMG, I_F1G, I_F1U, I_F1D, I_F2G, I_F2U, I_F2D, I_WIN, I_KVG, I_WUK, I_WUV, I_QG, I_KG, I_CONVW, I_CONVB, I_ALOG, I_DTB, I_SSDD, I_SSDG, I_NAQG, I_NAKG, I_RPB, I_WBR, I_WOUT };

constexpr int GRID = 256;
struct Frame {
    LAS unsigned char* lds; int tid, lane, wave, bid; static constexpr int G = GRID;
    const float* const* in; float* out; unsigned char* ws;
    __device__ __forceinline__ bf16_t* wsb(size_t off) const { return (bf16_t*)(ws + off); }
    __device__ __forceinline__ float* wsf(size_t off) const { return (float*)(ws + off); }
};

__device__ __forceinline__ int row_r9(int row) { return row < NLAT ? (row >> 11) : 8; }
__device__ __forceinline__ int row_kv(int row) { return row < NLAT ? (row >> 11) * KVROWS + CTX + (row & 2047) : ((row - NLAT) >> 8) * KVROWS + ((row - NLAT) & 255); }

__device__ __forceinline__ void transpose_item(const float* W, int N, int src_n0, bf16_t* WT, int ldt, int dst_n0, int k0, LAS float* scr, int lane) {
    if (src_n0 >= 0) {
        const GAS float* src = (const GAS float*)W + (size_t)(k0 + (lane >> 3)) * N + src_n0 + 4 * (lane & 7);
        f32x4 v[8];
#pragma unroll
        for (int i = 0; i < 8; ++i) v[i] = *(const GAS f32x4*)(src + (size_t)(8 * i) * N);
#pragma unroll
        for (int i = 0; i < 8; ++i) { LAS float* d = scr + (8 * i + (lane >> 3)) * 33 + 4 * (lane & 7); d[0] = v[i].x; d[1] = v[i].y; d[2] = v[i].z; d[3] = v[i].w; }
    } else {
#pragma unroll 8
        for (int i = 0; i < 32; ++i) { const int kk = 2 * i + (lane >> 5); scr[kk * 33 + (lane & 31)] = 0.f; }
    }
    LDS_WAIT(); asm volatile("" ::: "memory");
    const int c = lane & 7;
#pragma unroll
    for (int j = 0; j < 4; ++j) { const int n = (lane >> 3) + 8 * j; const LAS float* s = scr + (8 * c) * 33 + n;
        u32x4 o; o.x = pk2(s[0 * 33], s[1 * 33]); o.y = pk2(s[2 * 33], s[3 * 33]); o.z = pk2(s[4 * 33], s[5 * 33]); o.w = pk2(s[6 * 33], s[7 * 33]);
        *(GAS u32x4*)(WT + (size_t)(dst_n0 + n) * ldt + k0 + 8 * c) = o; }
    LDS_WAIT(); asm volatile("" ::: "memory");
}
__device__ __forceinline__ int win_src_col(int n) {
    if (n < 2048) return n;
    if (n < 5120) return n + 64;
    if (n < 8192) return n + 96;
    if (n < 8256) return n - 6144;
    if (n < 8288) return n - 3072;
    if (n < 8448) return -1;
    return n - 160;
}
__device__ __forceinline__ void absmax_item(const float* W, int N, int src_n0, unsigned* cmax, int k0, int lane) {
    float m = 0.f;
#pragma unroll 8
    for (int i = 0; i < 32; ++i) { const int kk = 2 * i + (lane >> 5); m = fmaxf(m, fabsf(W[(size_t)(k0 + kk) * N + src_n0 + (lane & 31)])); }
    m = fmaxf(m, __shfl_xor(m, 32));
    if (lane < 32) atomicMax(cmax + lane, __float_as_uint(m));
}
__device__ __forceinline__ void quant_item(const float* W, int N, int src_n0, unsigned char* WT8, int dst_n0, int k0, const unsigned* cmax, LAS float* scr, int lane) {
#pragma unroll 8
    for (int i = 0; i < 32; ++i) { const int kk = 2 * i + (lane >> 5); scr[kk * 33 + (lane & 31)] = W[(size_t)(k0 + kk) * N + src_n0 + (lane & 31)]; }
    LDS_WAIT(); asm volatile("" ::: "memory");
    const int c = lane & 3;
#pragma unroll
    for (int j = 0; j < 2; ++j) { const int n = (lane >> 2) + 16 * j; const float mx = __uint_as_float(cmax[n]), inv = mx > 0.f ? 127.0f / mx : 0.f;
        const LAS float* sp = scr + (16 * c) * 33 + n; unsigned w[4];
#pragma unroll
        for (int d = 0; d < 4; ++d) { unsigned x = 0;
#pragma unroll
            for (int e = 0; e < 4; ++e) { int q = __float2int_rn(sp[(4 * d + e) * 33] * inv); q = q > 127 ? 127 : (q < -127 ? -127 : q); x |= ((unsigned)q & 255u) << (8 * e); }
            w[d] = x; }
        *(GAS u32x4*)(WT8 + (size_t)(dst_n0 + n) * 4096 + k0 + 16 * c) = (u32x4){w[0], w[1], w[2], w[3]}; }
    LDS_WAIT(); asm volatile("" ::: "memory");
}
__device__ __forceinline__ void quant_block(const Frame& F, const float* W, int N, int src_n0, unsigned char* WT8, int dst_n0, float* cmax_out) {
    constexpr int QP = 4104;
    LAS unsigned char* LT = F.lds; LAS float* red = (LAS float*)(F.lds + 32 * QP); LAS float* cml = red + 256;
    int tq = F.tid; asm volatile("" : "+v"(tq));
    const int lane = tq & 63, n = lane & 31, kp = lane >> 5;
    __syncthreads();
    {
        (void)n; (void)kp;
        const int c4 = lane & 7, kr = lane >> 3;
        const GAS float* src = (const GAS float*)W + (size_t)(F.wave * 256 + kr) * N + src_n0 + 4 * c4;
        LAS unsigned char* lcol = LT + (4 * c4) * QP + (F.wave * 256 + kr) * 2;
        float m0 = 0.f, m1 = 0.f, m2 = 0.f, m3 = 0.f;
#pragma unroll 1
        for (int i0 = 0; i0 < 32; i0 += 16) { f32x4 v[16];
#pragma unroll
            for (int j = 0; j < 16; ++j) v[j] = *(const GAS f32x4*)(src + (size_t)(8 * (i0 + j)) * N);
#pragma unroll
            for (int j = 0; j < 16; ++j) { m0 = fmaxf(m0, fabsf(v[j].x)); m1 = fmaxf(m1, fabsf(v[j].y)); m2 = fmaxf(m2, fabsf(v[j].z)); m3 = fmaxf(m3, fabsf(v[j].w));
                LAS unsigned char* d = lcol + 16 * (i0 + j);
                *(LAS bf16_t*)(d) = (bf16_t)(pk2(v[j].x, v[j].x) & 0xffffu); *(LAS bf16_t*)(d + QP) = (bf16_t)(pk2(v[j].y, v[j].y) & 0xffffu);
                *(LAS bf16_t*)(d + 2 * QP) = (bf16_t)(pk2(v[j].z, v[j].z) & 0xffffu); *(LAS bf16_t*)(d + 3 * QP) = (bf16_t)(pk2(v[j].w, v[j].w) & 0xffffu); } }
#pragma unroll
        for (int o = 8; o < 64; o <<= 1) { m0 = fmaxf(m0, __shfl_xor(m0, o)); m1 = fmaxf(m1, __shfl_xor(m1, o)); m2 = fmaxf(m2, __shfl_xor(m2, o)); m3 = fmaxf(m3, __shfl_xor(m3, o)); }
        if (lane < 8) { LAS float* r = red + F.wave * 32 + 4 * lane; r[0] = m0; r[1] = m1; r[2] = m2; r[3] = m3; }
    }
    __syncthreads();
    if (tq < 32) { float mx = red[tq];
#pragma unroll
        for (int w = 1; w < 8; ++w) mx = fmaxf(mx, red[w * 32 + tq]);
        cml[tq] = mx; cmax_out[tq] = mx; }
    __syncthreads();
    {   const int nn = tq >> 4, c = tq & 15; const float mx = cml[nn], inv = mx > 0.f ? 127.0f / mx : 0.f;
        const LAS unsigned char* lr = LT + nn * QP; unsigned char* orow = WT8 + (size_t)(dst_n0 + nn) * 4096;
#pragma unroll
        for (int j = 0; j < 8; ++j) { const int k0 = (c + 16 * j) * 16; unsigned w4[4];
#pragma unroll
            for (int d = 0; d < 4; ++d) { const u32x2 pr = *(const LAS u32x2*)(lr + k0 * 2 + d * 8);
                int q0 = __float2int_rn(lo16(pr.x) * inv), q1 = __float2int_rn(hi16(pr.x) * inv), q2 = __float2int_rn(lo16(pr.y) * inv), q3 = __float2int_rn(hi16(pr.y) * inv);
                w4[d] = ((unsigned)q0 & 255u) | (((unsigned)q1 & 255u) << 8) | (((unsigned)q2 & 255u) << 16) | ((unsigned)q3 << 24); }
            *(GAS u32x4*)(orow + k0) = (u32x4){w4[0], w4[1], w4[2], w4[3]}; }
    }
}
__device__ __forceinline__ void phase_convert(const Frame& F, int l) {
    const int gw = F.bid * 8 + F.wave, NGW = F.G * 8;
    constexpr int I_GU = 32 * 352, I_DN = 88 * 64, I_IN = 32 * 456, I_UKV = 8 * 64, I_BR = 16 * 64, I_OUT = 32 * 64;
    constexpr int NITEMS = 2 * I_GU + 2 * I_DN + I_IN + I_UKV + 3 * I_BR + I_OUT;
    const size_t ffo = (size_t)l * DM * DFF;
    float* CM = (float*)(F.ws + WS_CMAX) + (size_t)l * NQCOL;
    {   constexpr int QB = (MK_I8GU ? 704 : 0) + (MK_I8GATE ? 192 : 0);
        for (int qi = F.bid; qi < QB; qi += F.G) { int r = qi;
            if (MK_I8GU && r < 704) { const int s = r >= 352 ? 1 : 0, nb = r - s * 352, pn = nb >> 3, jb = nb & 7;
                const float* W = F.in[(s ? I_F2G : I_F1G) + (jb >= 4 ? 1 : 0)] + ffo;
                quant_block(F, W, DFF, pn * 128 + (jb & 3) * 32, F.ws + (s ? WS_WGU2 : WS_WGU1), nb * 32, CM + s * 11264 + nb * 32); continue; }
            if (MK_I8GU) r -= 704;
            { const int nb = 264 + r;
              quant_block(F, F.in[I_WIN] + (size_t)l * DM * DIN, DIN, win_src_col(nb * 32), F.ws + WS_WIN, nb * 32, CM + 22528 + (nb - 264) * 32); } }
        __syncthreads();
    }
    LAS float* scr = (LAS float*)(F.lds + F.wave * 16384);
    for (int it = gw; it < NITEMS; it += NGW) {
        int r = it;
        if (r < 2 * I_GU) { if (MK_I8GU) continue; const int s = r >= I_GU; r -= s * I_GU; const int kb = r / 352, nb = r % 352, pn = nb >> 3, jb = nb & 7;
            const float* W = F.in[(s ? I_F2G : I_F1G) + (jb >= 4 ? 1 : 0)] + ffo;
            transpose_item(W, DFF, pn * 128 + (jb & 3) * 32, F.wsb(s ? WS_WGU2 : WS_WGU1), DM, nb * 32, kb * 64, scr, F.lane);
            continue; }
        r -= 2 * I_GU;
        if (r < 2 * I_DN) { const int s = r >= I_DN; r -= s * I_DN; const int kb = r / 64, nb = r % 64;
            transpose_item(F.in[s ? I_F2D : I_F1D] + ffo, DM, nb * 32, F.wsb(s ? WS_WDN2 : WS_WDN1), DFF, nb * 32, kb * 64, scr, F.lane); continue; }
        r -= 2 * I_DN;
        if (r < I_IN) { const int kb = r / 456, nb = r % 456;
            if (MK_I8GATE && nb >= 264) continue;
            transpose_item(F.in[I_WIN] + (size_t)l * DM * DIN, DIN, win_src_col(nb * 32), F.wsb(WS_WIN), DM, nb * 32, kb * 64, scr, F.lane);
            continue; }
        r -= I_IN;
        if (r < I_UKV) { const int kb = r / 64, nb = r % 64;
            transpose_item(F.in[nb < 32 ? I_WUK : I_WUV] + (size_t)l * 512 * 1024, 1024, (nb & 31) * 32, F.wsb(WS_WUKV), 512, nb * 32, kb * 64, scr, F.lane); continue; }
        r -= I_UKV;
        if (r < 3 * I_BR) { const int i = r / I_BR; r -= i * I_BR; const int kb = r / 64, nb = r % 64;
            transpose_item(F.in[I_WBR] + ((size_t)l * 3 + i) * 1024 * DM, DM, nb * 32, F.wsb(WS_WBR) + (size_t)i * DM * 1024, 1024, nb * 32, kb * 64, scr, F.lane); continue; }
        r -= 3 * I_BR;
        { const int kb = r / 64, nb = r % 64;
            transpose_item(F.in[I_WOUT] + (size_t)l * DM * DM, DM, nb * 32, F.wsb(WS_WOUT), DM, nb * 32, kb * 64, scr, F.lane); }
    }
}

__device__ __forceinline__ void phase_adaln(const Frame& F) {
    LAS float* sc = (LAS float*)F.lds;
    LAS float* red = (LAS float*)(F.lds + 16384);
    float* MOD = F.wsf(WS_MOD);
    if (F.bid == 0) {
        for (int i = F.tid; i < 1024; i += 512) { const int pos = i >> 4, f = i & 15;
            const float inv = fast_exp2(-(float)f * (13.287712379549449f / 16.0f)); const float ang = (float)pos * inv;
            ((f32x2*)F.wsf(WS_ROPE))[i] = (f32x2){cosf(ang), sinf(ang)}; }
    }
    for (int it = F.bid; it < 2 * 72 * 8; it += F.G) {
        const int l = it / 576, r0 = it % 576, cb = r0 >> 3, ks = r0 & 7, k0 = ks * 256, col0 = cb * 256;
        __syncthreads();
        for (int i = F.tid; i < 9 * 256; i += 512) { const int r = i >> 8, k = i & 255;
            const float c = r < 8 ? F.in[I_C][r * DM + k0 + k] : F.in[I_CCTX][k0 + k]; sc[i] = siluf_(c) ; }
        __syncthreads();
        const float* W = F.in[I_WADA] + ((size_t)l * DM + k0 + F.wave * 32) * (NMOD * DM) + col0 + 4 * F.lane;
        f32x4 acc[9];
#pragma unroll
        for (int r = 0; r < 9; ++r) acc[r] = (f32x4){0.f, 0.f, 0.f, 0.f};
#pragma unroll 4
        for (int kk = 0; kk < 32; ++kk) { const f32x4 w = *(const f32x4*)(W + (size_t)kk * (NMOD * DM));
#pragma unroll
            for (int r = 0; r < 9; ++r) acc[r] += w * sc[r * 256 + F.wave * 32 + kk]; }
#pragma unroll
        for (int r = 0; r < 9; ++r) *(LAS f32x4*)(red + (F.wave * 9 + r) * 256 + 4 * F.lane) = acc[r];
        __syncthreads();
        for (int i = F.tid; i < 9 * 256; i += 512) { float s = 0.f;
#pragma unroll
            for (int w = 0; w < 8; ++w) s += red[w * 2304 + i];
            const int r = i >> 8, j = col0 + (i & 255);
            if (ks == 0) s += F.in[I_BADA][(size_t)l * (NMOD * DM) + j];
            atomicAdd(MOD + ((size_t)l * 9 + r) * (NMOD * DM) + j, s); }
    }
}

__device__ __forceinline__ void phase_norm(const Frame& F, const float* lat, const float* ctx, const float* g, const float* mod, int base, bf16_t* U, int nrows, float* hcw, const float* slab, unsigned char* U8, float* rsc) {
    const int gw = F.bid * 8 + F.wave, NGW = F.G * 8;
    static_assert(NLAT == 8 * GRID * 8 && NCTXR == GRID * 8, "row deal of phase_norm");
    const int per = nrows > NLAT ? 9 : 8; (void)NGW;
    f32x4 ga[8], sh[8]; int cur = -1;
    for (int i = 0; i < per; ++i) {
        const int row = i < 8 ? gw * 8 + i : NLAT + gw;
        const int r9 = row_r9(row);
        if (r9 != cur) { cur = r9; const float* ms = mod + (size_t)r9 * (NMOD * DM) + base * DM;
#pragma unroll
            for (int j = 0; j < 8; ++j) { const int c = 4 * F.lane + 256 * j; const f32x4 gg = *(const f32x4*)(g + c), scl = *(const f32x4*)(ms + DM + c); sh[j] = *(const f32x4*)(ms + c); ga[j] = gg * (scl + 1.0f); } }
        const float* xr = row < NLAT ? lat + (size_t)row * DM : ctx + (size_t)(row - NLAT) * DM;
        f32x4 v[8]; float s = 0.f;
#pragma unroll
        for (int j = 0; j < 8; ++j) v[j] = *(const f32x4*)(xr + 4 * F.lane + 256 * j);
        if (row >= NLAT && hcw) {
            if (slab) {
#pragma unroll
                for (int q = 0; q < 4; ++q) { const float* sp = slab + ((size_t)q * NCTXR + (row - NLAT)) * DM + 4 * F.lane;
#pragma unroll
                    for (int j = 0; j < 8; ++j) v[j] += *(const f32x4*)(sp + 256 * j); } }
            float* hw = hcw + (size_t)(row - NLAT) * DM + 4 * F.lane;
#pragma unroll
            for (int j = 0; j < 8; ++j) *(f32x4*)(hw + 256 * j) = v[j];
        }
#pragma unroll
        for (int j = 0; j < 8; ++j) s += (v[j].x * v[j].x + v[j].y * v[j].y) + (v[j].z * v[j].z + v[j].w * v[j].w);
        const float rs = rsqrtf(wave_sum(s) * (1.0f / DM) + EPS);
        float amax = 0.f;
#pragma unroll
        for (int j = 0; j < 8; ++j) { v[j] = v[j] * rs * ga[j] + sh[j]; amax = fmaxf(fmaxf(amax, fmaxf(fabsf(v[j].x), fabsf(v[j].y))), fmaxf(fabsf(v[j].z), fabsf(v[j].w))); }
        if (U) { bf16_t* o = U + (size_t)row * DM;
#pragma unroll
            for (int j = 0; j < 8; ++j) { u32x2 w; w.x = pk2(v[j].x, v[j].y); w.y = pk2(v[j].z, v[j].w); *(u32x2*)(o + 4 * F.lane + 256 * j) = w; } }
        if (U8) {
#pragma unroll
            for (int o = 1; o < 64; o <<= 1) amax = fmaxf(amax, __shfl_xor(amax, o));
            const float inv = amax > 0.f ? 127.0f / amax : 0.f;
            unsigned* o8 = (unsigned*)(U8 + (size_t)row * 4096);
#pragma unroll
            for (int j = 0; j < 8; ++j) { const int q0 = __float2int_rn(v[j].x * inv), q1 = __float2int_rn(v[j].y * inv), q2 = __float2int_rn(v[j].z * inv), q3 = __float2int_rn(v[j].w * inv);
                o8[F.lane + 64 * j] = ((unsigned)q0 & 255u) | (((unsigned)q1 & 255u) << 8) | (((unsigned)q2 & 255u) << 16) | ((unsigned)q3 << 24); }
            if (F.lane == 0) rsc[row] = amax * (1.0f / 127.0f);
        }
    }
}

__device__ __forceinline__ void norm192_rope(float (&nope)[16], float (&x1)[4], float (&x2)[4], const float* g, const f32x2* rope, bool lat, int t, int p, float scale) {
    float ss = 0.f;
#pragma unroll
    for (int i = 0; i < 16; ++i) ss += nope[i] * nope[i];
#pragma unroll
    for (int i = 0; i < 4; ++i) ss += x1[i] * x1[i] + x2[i] * x2[i];
    ss += __shfl_xor(ss, 1); ss += __shfl_xor(ss, 2); ss += __shfl_xor(ss, 4);
    const float rs = rsqrtf(ss * (1.0f / 192.0f) + EPS);
    const int a = p >> 2, f0 = (p & 3) * 4;
#pragma unroll
    for (int i = 0; i < 16; ++i) nope[i] = nope[i] * rs * g[p * 16 + i] * scale;
#pragma unroll
    for (int i = 0; i < 4; ++i) { x1[i] = x1[i] * rs * g[128 + a * 32 + f0 + i]; x2[i] = x2[i] * rs * g[128 + a * 32 + 16 + f0 + i]; }
    if (lat) { const int pos = a == 0 ? (t >> 6) : (t & 63);
#pragma unroll
        for (int i = 0; i < 4; ++i) { const f32x2 cs = rope[pos * 16 + f0 + i]; const float y1 = x1[i] * cs.x - x2[i] * cs.y, y2 = x2[i] * cs.x + x1[i] * cs.y; x1[i] = y1; x2[i] = y2; } }
#pragma unroll
    for (int i = 0; i < 4; ++i) { x1[i] *= scale; x2[i] *= scale; }
}
__device__ __forceinline__ void ld16(const bf16_t* p, float (&v)[16]) { const u32x4 a = *(const u32x4*)p, b = *(const u32x4*)(p + 8);
    v[0] = lo16(a.x); v[1] = hi16(a.x); v[2] = lo16(a.y); v[3] = hi16(a.y); v[4] = lo16(a.z); v[5] = hi16(a.z); v[6] = lo16(a.w); v[7] = hi16(a.w);
    v[8] = lo16(b.x); v[9] = hi16(b.x); v[10] = lo16(b.y); v[11] = hi16(b.y); v[12] = lo16(b.z); v[13] = hi16(b.z); v[14] = lo16(b.w); v[15] = hi16(b.w); }
__device__ __forceinline__ void st16(bf16_t* p, const float (&v)[16]) { u32x4 a, b; a.x = pk2(v[0], v[1]); a.y = pk2(v[2], v[3]); a.z = pk2(v[4], v[5]); a.w = pk2(v[6], v[7]);
    b.x = pk2(v[8], v[9]); b.y = pk2(v[10], v[11]); b.z = pk2(v[12], v[13]); b.w = pk2(v[14], v[15]); *(u32x4*)p = a; *(u32x4*)(p + 8) = b; }
__device__ __forceinline__ void ld4(const bf16_t* p, float (&v)[4]) { const u32x2 a = *(const u32x2*)p; v[0] = lo16(a.x); v[1] = hi16(a.x); v[2] = lo16(a.y); v[3] = hi16(a.y); }
__device__ __forceinline__ void st4(bf16_t* p, const float (&v)[4]) { u32x2 a; a.x = pk2(v[0], v[1]); a.y = pk2(v[2], v[3]); *(u32x2*)p = a; }

__device__ __forceinline__ void norm192_rope_r(float (&nope)[16], float (&x1)[4], float (&x2)[4], const float (&gn)[16], const float (&g1)[4], const float (&g2)[4], const f32x2* rope, bool lat, int t, int p, float scale) {
    float ss = 0.f;
#pragma unroll
    for (int i = 0; i < 16; ++i) ss += nope[i] * nope[i];
#pragma unroll
    for (int i = 0; i < 4; ++i) ss += x1[i] * x1[i] + x2[i] * x2[i];
    ss += __shfl_xor(ss, 1); ss += __shfl_xor(ss, 2); ss += __shfl_xor(ss, 4);
    const float rs = rsqrtf(ss * (1.0f / 192.0f) + EPS) * scale;
    const int a = p >> 2, f0 = (p & 3) * 4;
#pragma unroll
    for (int i = 0; i < 16; ++i) nope[i] = nope[i] * rs * gn[i];
#pragma unroll
    for (int i = 0; i < 4; ++i) { x1[i] = x1[i] * rs * g1[i]; x2[i] = x2[i] * rs * g2[i]; }
    if (lat) { const int pos = a == 0 ? (t >> 6) : (t & 63);
#pragma unroll
        for (int i = 0; i < 4; ++i) { const f32x2 cs = rope[pos * 16 + f0 + i]; const float y1 = x1[i] * cs.x - x2[i] * cs.y, y2 = x2[i] * cs.x + x1[i] * cs.y; x1[i] = y1; x2[i] = y2; } }
}
__device__ __forceinline__ int row_seq(int row) { return row < NLAT ? (row >> 11) : 8 + ((row - NLAT) >> 8); }
__device__ __forceinline__ void phase_prep(const Frame& F, int l, bool need_ctx) {
    const int gw = F.bid * 8 + F.wave, NGW = F.G * 8;
    bf16_t* P = F.wsb(WS_P); bf16_t* XBC = F.wsb(WS_XBC); float* DT = F.wsf(WS_DT);
    const f32x2* rope = (const f32x2*)F.wsf(WS_ROPE);
    const int lane = F.lane, h = lane >> 3, p = lane & 7, a = p >> 2, f0 = (p & 3) * 4;
    {
        const float* qg = F.in[I_QG] + l * 192; const float* kvg = F.in[I_KVG] + l * 512; const float* naqg = F.in[I_NAQG] + l * 128; const float* nakg = F.in[I_NAKG] + l * 128;
        float gn[16], g1[4], g2[4], gkv[8], gq[16], gk[16];
#pragma unroll
        for (int i = 0; i < 16; ++i) { gn[i] = qg[p * 16 + i]; gq[i] = naqg[p * 16 + i]; gk[i] = nakg[p * 16 + i]; }
#pragma unroll
        for (int i = 0; i < 4; ++i) { g1[i] = qg[128 + a * 32 + f0 + i]; g2[i] = qg[128 + a * 32 + 16 + f0 + i]; }
#pragma unroll
        for (int i = 0; i < 8; ++i) gkv[i] = kvg[lane * 8 + i];
        const float dtb = lane < 32 ? F.in[I_DTB][l * 32 + lane] : 0.f;
        const int per = (NROW + NGW - 1) / NGW;
#pragma unroll 1
        for (int i = 0; i < per; ++i) {
            const int row = gw * per + i; if (row >= NROW) break;
            const bool lat = row < NLAT, doq = lat || need_ctx; const int t = lat ? (row & 2047) : ((row - NLAT) & 255);
            bf16_t* pr = P + (size_t)row * DINP;
            bf16_t* q = pr + PC_Q + h * 192; bf16_t* c = pr + PC_CKV + lane * 8; bf16_t* xq = pr + PC_NAQ + h * 128 + p * 16; bf16_t* xk = pr + PC_NAK + h * 128 + p * 16;
            float nope[16], x1[4], x2[4], vq[16], vk[16];
            if (doq) { ld16(q + p * 16, nope); ld4(q + 128 + a * 32 + f0, x1); ld4(q + 128 + a * 32 + 16 + f0, x2); ld16(xq, vq); }
            const u32x4 ca = *(const u32x4*)c; ld16(xk, vk);
            const float dtr = lane < 32 ? bf2f(pr[PC_DT + lane]) : 0.f;
            if (doq) {
                norm192_rope_r(nope, x1, x2, gn, g1, g2, rope, lat, t, p, 0.07216878364870322f * LOG2E);
                st16(q + p * 16, nope); st4(q + 128 + a * 32 + f0, x1); st4(q + 128 + a * 32 + 16 + f0, x2);
                float ss = 0.f;
#pragma unroll
                for (int j = 0; j < 16; ++j) ss += vq[j] * vq[j];
                ss += __shfl_xor(ss, 1); ss += __shfl_xor(ss, 2); ss += __shfl_xor(ss, 4);
                const float rs = rsqrtf(ss * (1.0f / 128.0f) + EPS) * (0.08838834764831845f * LOG2E);
#pragma unroll
                for (int j = 0; j < 16; ++j) vq[j] = vq[j] * rs * gq[j];
                st16(xq, vq);
            }
            {
                float v[8] = {lo16(ca.x), hi16(ca.x), lo16(ca.y), hi16(ca.y), lo16(ca.z), hi16(ca.z), lo16(ca.w), hi16(ca.w)}; float ss = 0.f;
#pragma unroll
                for (int j = 0; j < 8; ++j) ss += v[j] * v[j];
                const float rs = rsqrtf(wave_sum(ss) * (1.0f / 512.0f) + EPS);
#pragma unroll
                for (int j = 0; j < 8; ++j) v[j] = v[j] * rs * gkv[j];
                u32x4 o; o.x = pk2(v[0], v[1]); o.y = pk2(v[2], v[3]); o.z = pk2(v[4], v[5]); o.w = pk2(v[6], v[7]); *(u32x4*)c = o;
            }
            {
                float ss = 0.f;
#pragma unroll
                for (int j = 0; j < 16; ++j) ss += vk[j] * vk[j];
                ss += __shfl_xor(ss, 1); ss += __shfl_xor(ss, 2); ss += __shfl_xor(ss, 4);
                const float rs = rsqrtf(ss * (1.0f / 128.0f) + EPS);
#pragma unroll
                for (int j = 0; j < 16; ++j) vk[j] = vk[j] * rs * gk[j];
                st16(xk, vk);
            }
            if (lane < 32) { const float x = dtr + dtb; const float e = fast_exp2(x * LOG2E);
                DT[(size_t)row * 32 + lane] = x > 20.f ? x : (e < 1e-3f ? e * (1.0f - 0.5f * e) : __builtin_amdgcn_logf(1.0f + e) * 0.6931471805599453f); }
        }
    }
    {
        const float* cw = F.in[I_CONVW] + (size_t)l * 5 * 2048; const float* cbias = F.in[I_CONVB] + l * 2048;
#pragma unroll 1
        for (int it = gw; it < 1024 * 4; it += NGW) {
            int tl = lane; asm volatile("" : "+v"(tl));
            const int chunk = it >> 2, r0 = chunk * 18, ch0 = (it & 3) * 512 + tl * 8;
            float w[5][8], bs[8];
#pragma unroll
            for (int k = 0; k < 5; ++k) { const f32x4 w0 = *(const f32x4*)(cw + k * 2048 + ch0), w1 = *(const f32x4*)(cw + k * 2048 + ch0 + 4);
#pragma unroll
                for (int e = 0; e < 4; ++e) { w[k][e] = w0[e]; w[k][4 + e] = w1[e]; } }
            { const f32x4 b0 = *(const f32x4*)(cbias + ch0), b1 = *(const f32x4*)(cbias + ch0 + 4);
#pragma unroll
              for (int e = 0; e < 4; ++e) { bs[e] = b0[e]; bs[4 + e] = b1[e]; } }
            u32x4 raw[22];
#pragma unroll
            for (int i = 0; i < 22; ++i) { int rr = r0 - 2 + i; rr = rr < 0 ? 0 : (rr >= NROW ? NROW - 1 : rr); raw[i] = *(const u32x4*)(P + (size_t)rr * DINP + PC_XBC + ch0); }
            const bool uni = (r0 >= 2) && (r0 + 19 < NROW) && (row_seq(r0 - 2) == row_seq(r0 + 19));
#pragma unroll
            for (int j = 0; j < 18; ++j) {
                float o[8];
#pragma unroll
                for (int e = 0; e < 8; ++e) o[e] = bs[e];
                const int sj = row_seq(r0 + j);
#pragma unroll
                for (int k = 0; k < 5; ++k) {
                    const int src = r0 + j + k - 2;
                    const float m = uni ? 1.0f : ((src >= 0 && src < NROW && row_seq(src < 0 ? 0 : (src >= NROW ? NROW - 1 : src)) == sj) ? 1.0f : 0.0f);
                    const u32x4 a4 = raw[j + k];
                    const float x[8] = {lo16(a4.x), hi16(a4.x), lo16(a4.y), hi16(a4.y), lo16(a4.z), hi16(a4.z), lo16(a4.w), hi16(a4.w)};
#pragma unroll
                    for (int e = 0; e < 8; ++e) o[e] += (w[k][e] * m) * x[e];
                }
#pragma unroll
                for (int e = 0; e < 8; ++e) o[e] = siluf_(o[e]);
                u32x4 wv; wv.x = pk2(o[0], o[1]); wv.y = pk2(o[2], o[3]); wv.z = pk2(o[4], o[5]); wv.w = pk2(o[6], o[7]);
                *(u32x4*)(XBC + (size_t)(r0 + j) * 2048 + ch0) = wv;
            }
        }
    }
}

__device__ __forceinline__ void phase_knorm(const Frame& F, int l) {
    const int gw = F.bid * 8 + F.wave, NGW = F.G * 8, per = (NROW + NGW - 1) / NGW;
    const bf16_t* P = F.wsb(WS_P); bf16_t* Kb = F.wsb(WS_K); const f32x2* rope = (const f32x2*)F.wsf(WS_ROPE); const float* kg = F.in[I_KG] + l * 192;
    const int lane = F.lane, h = lane >> 3, p = lane & 7, a = p >> 2, f0 = (p & 3) * 4;
    for (int i = 0; i < per; ++i) {
        const int row = gw * per + i; if (row >= NROW) break;
        const bool lat = row < NLAT; const int t = lat ? (row & 2047) : 0;
        bf16_t* k = Kb + (size_t)row_kv(row) * 1536 + h * 192; const bf16_t* kr = P + (size_t)row * DINP + PC_KR;
        float nope[16], x1[4], x2[4]; ld16(k + p * 16, nope); ld4(kr + a * 32 + f0, x1); ld4(kr + a * 32 + 16 + f0, x2);
        norm192_rope(nope, x1, x2, kg, rope, lat, t, p, 1.0f);
        st16(k + p * 16, nope); st4(k + 128 + a * 32 + f0, x1); st4(k + 128 + a * 32 + 16 + f0, x2);
    }
}

namespace att {
#define SBAR() __builtin_amdgcn_sched_barrier(0)
constexpr int NW = 8, QBLK = 32, KVBLK = 64, DV = 128;
constexpr float THR2 = 11.5f;
__device__ __forceinline__ int crow(int r, int hi) { return (r & 3) + 8 * (r >> 2) + 4 * hi; }
__device__ __forceinline__ int v_st(int k, int c) { const int kk = (k & ~0xC) | ((k & 4) << 1) | ((k & 8) >> 1); return ((kk >> 3) * 4 + (c >> 5)) * 512 + ((kk & 7) * 32 + (c & 31)) * 2; }
__device__ __forceinline__ int v_rd_base(int lane) { return ((lane & 3) << 3) | (((lane >> 2) & 3) << 6) | (((lane >> 4) & 1) << 5) | (((lane >> 5) & 1) << 8); }
constexpr int v_rd_off(int d0, int ks, int half) { return d0 * 512 + ks * 4096 + half * 2048; }
template <int OFF> __device__ __forceinline__ s16x4 tr_read(int vb) { s16x4 r; asm volatile("ds_read_b64_tr_b16 %0, %1 offset:%2" : "=&v"(r) : "v"(vb), "i"(OFF) : "memory"); return r; }
template <int D0> __device__ __forceinline__ void pv_one(f32x16& od, int vb, bf16x8 pa0, bf16x8 pa1, bf16x8 pa2, bf16x8 pa3) {
    const s16x4 l0 = tr_read<v_rd_off(D0, 0, 0)>(vb), h0 = tr_read<v_rd_off(D0, 0, 1)>(vb), l1 = tr_read<v_rd_off(D0, 1, 0)>(vb), h1 = tr_read<v_rd_off(D0, 1, 1)>(vb);
    const s16x4 l2 = tr_read<v_rd_off(D0, 2, 0)>(vb), h2 = tr_read<v_rd_off(D0, 2, 1)>(vb), l3 = tr_read<v_rd_off(D0, 3, 0)>(vb), h3 = tr_read<v_rd_off(D0, 3, 1)>(vb);
    asm volatile("s_waitcnt lgkmcnt(0)" ::: "memory"); SBAR();
#define PKV(L, H) (bf16x8){L[0], L[1], L[2], L[3], H[0], H[1], H[2], H[3]}
    od = __builtin_amdgcn_mfma_f32_32x32x16_bf16(pa0, PKV(l0, h0), od, 0, 0, 0);
    od = __builtin_amdgcn_mfma_f32_32x32x16_bf16(pa1, PKV(l1, h1), od, 0, 0, 0);
    od = __builtin_amdgcn_mfma_f32_32x32x16_bf16(pa2, PKV(l2, h2), od, 0, 0, 0);
    od = __builtin_amdgcn_mfma_f32_32x32x16_bf16(pa3, PKV(l3, h3), od, 0, 0, 0);
#undef PKV
}
__device__ __forceinline__ void pv_d0(f32x16* o, int vb, bf16x8 pa0, bf16x8 pa1, bf16x8 pa2, bf16x8 pa3) {
    pv_one<0>(o[0], vb, pa0, pa1, pa2, pa3); pv_one<1>(o[1], vb, pa0, pa1, pa2, pa3); pv_one<2>(o[2], vb, pa0, pa1, pa2, pa3); pv_one<3>(o[3], vb, pa0, pa1, pa2, pa3);
}
struct NaMask { int bidx, wcol, rs, r, klo; const LAS float* tab; };
__device__ __forceinline__ void na_apply(f32x16& p0, f32x16& p1, const NaMask& M, int kr) {
    const bool rowok = (kr >= M.rs) && (kr < M.rs + 8);
    int dr = kr - M.r + 7; dr = dr < 0 ? 0 : (dr > 14 ? 14 : dr);
    const LAS float* tb = M.tab + dr * 32 + M.bidx;
#pragma unroll
    for (int r = 0; r < 16; ++r) { const int kc = (r & 3) + 8 * (r >> 2);
        const bool ok0 = rowok && ((unsigned)(kc + M.wcol) < 16u), ok1 = rowok && ((unsigned)(kc + 32 + M.wcol) < 16u);
        p0[r] = ok0 ? p0[r] + tb[kc] : -1e30f; p1[r] = ok1 ? p1[r] + tb[kc + 32] : -1e30f; }
}
__device__ __forceinline__ void partialSM(f32x16& p0, f32x16& p1, float& m_reg, float& mn, float& alpha) {
    float pmax = p0[0];
#pragma unroll
    for (int r = 1; r < 16; ++r) pmax = fmaxf(pmax, p0[r]);
#pragma unroll
    for (int r = 0; r < 16; ++r) pmax = fmaxf(pmax, p1[r]);
    { auto rr = __builtin_amdgcn_permlane32_swap(__float_as_uint(pmax), __float_as_uint(pmax), false, false);
      pmax = fmaxf(__uint_as_float(rr[0]), __uint_as_float(rr[1])); }
    if (__builtin_expect(__all(pmax - m_reg <= THR2), 1)) { mn = m_reg; alpha = 1.f; }
    else { mn = fmaxf(m_reg, pmax); alpha = fast_exp2(m_reg - mn); m_reg = mn; }
#pragma unroll
    for (int r = 0; r < 16; ++r) p0[r] = p0[r] - mn;
#pragma unroll
    for (int r = 0; r < 16; ++r) p1[r] = p1[r] - mn;
#pragma unroll
    for (int r = 0; r < 16; ++r) p0[r] = fast_exp2(p0[r]);
}
__device__ __forceinline__ void finishSM(f32x16& p0, f32x16& p1, float alpha, float& l_reg, bf16x8& pa0, bf16x8& pa1, bf16x8& pa2, bf16x8& pa3) {
#pragma unroll
    for (int r = 0; r < 16; ++r) p1[r] = fast_exp2(p1[r]);
    float ps = 0;
#pragma unroll
    for (int r = 0; r < 16; ++r) ps += p0[r];
#pragma unroll
    for (int r = 0; r < 16; ++r) ps += p1[r];
    { auto rr = __builtin_amdgcn_permlane32_swap(__float_as_uint(ps), __float_as_uint(ps), false, false);
      ps = __uint_as_float(rr[0]) + __uint_as_float(rr[1]); }
    l_reg = l_reg * alpha + ps;
#define PK4(P, BASE, OUT) do { unsigned a0 = pg8::cvt_pk_bf16(P[BASE + 0], P[BASE + 1]), a1 = pg8::cvt_pk_bf16(P[BASE + 2], P[BASE + 3]);   \
    unsigned b0 = pg8::cvt_pk_bf16(P[BASE + 4], P[BASE + 5]), b1 = pg8::cvt_pk_bf16(P[BASE + 6], P[BASE + 7]);                              \
    auto r0 = __builtin_amdgcn_permlane32_swap(a0, b0, false, false); auto r1 = __builtin_amdgcn_permlane32_swap(a1, b1, false, false); \
    u32x4 w = {r0[0], r1[0], r0[1], r1[1]}; OUT = *reinterpret_cast<bf16x8*>(&w); } while (0)
    PK4(p0, 0, pa0); PK4(p0, 8, pa1); PK4(p1, 0, pa2); PK4(p1, 8, pa3);
#undef PK4
}
struct Unit {
    const bf16_t* Q; long ldq;
    const bf16_t* K; const bf16_t* V; long ldk, ldv;
    bf16_t* O; long ldo;
    int NT, nct, rowC, rowL;
    __device__ __forceinline__ long trow(int j) const { return j < nct ? (long)rowC + 64 * j : (long)rowL + 64 * (j - nct); }
};
template <int DQK, bool NA>
__device__ __forceinline__ void attn_unit(const Unit& U, char* lds, const NaMask& M, const int tid) {
    constexpr int NQ = DQK / 16, KP = DQK * 2 + 16, SHM_K = KVBLK * KP, SHM_V = KVBLK * DV * 2;
    const int wid = tid >> 6, lane = tid & 63, r32 = lane & 31, hi = lane >> 5;
    char* V_lds = lds; char* K_lds = lds + 2 * SHM_V;
    constexpr int WSM_OFF = (2 * SHM_V + 2 * SHM_K) > 8 * 8704 ? (2 * SHM_V + 2 * SHM_K) : 8 * 8704;
    float* wsm = (float*)(lds + WSM_OFF) + wid * 64; float* li_l = wsm; float* al_l = wsm + 32;
    constexpr int NQR = (DQK == 192) ? 4 : 8, QLP = (NQ - NQR) * 32 + 16;
    float m_reg = -1e30f, l_reg = 0; f32x16 o[4] = {}; bf16x8 qr[NQR];
    const bf16_t* Qw = U.Q + (long)(wid * QBLK + r32) * U.ldq + hi * 8;
#pragma unroll
    for (int d0 = 0; d0 < NQR; ++d0) qr[d0] = *(const bf16x8*)(Qw + d0 * 16);
    char* Qrl = lds + WSM_OFF + 2048 + wid * (32 * QLP) + r32 * QLP + hi * 16;
    if (NQ > NQR) {
#pragma unroll
        for (int d0 = NQR; d0 < NQ; ++d0) *(bf16x8*)(Qrl + (d0 - NQR) * 32) = *(const bf16x8*)(Qw + d0 * 16);
    }
    const int sr = tid >> 4, sc = (tid & 15) * 8, vst0 = v_st(sr, sc), vst1 = v_st(32 + sr, sc);
    const int sr3 = tid >> 3, sc3 = 128 + (tid & 7) * 8;
    const int vb0 = (int)(uintptr_t)V_lds + v_rd_base(lane);
    bf16x8 vs0, vs1, ks0, ks1, ks2;
    const unsigned vo0 = (unsigned)(sr * U.ldv + sc) * 2u, vo1 = (unsigned)((32 + sr) * U.ldv + sc) * 2u, ko0 = (unsigned)(sr * U.ldk + sc) * 2u, ko1 = (unsigned)((32 + sr) * U.ldk + sc) * 2u, ko2 = (unsigned)(sr3 * U.ldk + sc3) * 2u;
#define KSWZ(row, colB) ((row) * KP + (colB))
#define SLOAD(j) do { const long _r = U.trow(j); const char* _vb = (const char*)(U.V + _r * U.ldv); const char* _kb = (const char*)(U.K + _r * U.ldk); \
    vs0 = *(const bf16x8*)(_vb + vo0); vs1 = *(const bf16x8*)(_vb + vo1); ks0 = *(const bf16x8*)(_kb + ko0); ks1 = *(const bf16x8*)(_kb + ko1); \
    if (DQK == 192) ks2 = *(const bf16x8*)(_kb + ko2); } while (0)
#define SWRITE(b) do { *(bf16x8*)(V_lds + (b) * SHM_V + vst0) = vs0; *(bf16x8*)(V_lds + (b) * SHM_V + vst1) = vs1; \
    *(bf16x8*)(K_lds + (b) * SHM_K + KSWZ(sr, sc * 2)) = ks0; *(bf16x8*)(K_lds + (b) * SHM_K + KSWZ(32 + sr, sc * 2)) = ks1; \
    if (DQK == 192) *(bf16x8*)(K_lds + (b) * SHM_K + KSWZ(sr3, sc3 * 2)) = ks2; } while (0)
#define QKT(P0, P1, b) do { P0 = f32x16{}; P1 = f32x16{}; const char* _Ks = K_lds + (b) * SHM_K; \
    _Pragma("unroll") for (int d0 = 0; d0 < NQ; ++d0) { const int cb = (d0 * 16 + hi * 8) * 2; \
      const bf16x8 b0 = *(const bf16x8*)(_Ks + KSWZ(r32, cb)); const bf16x8 b1 = *(const bf16x8*)(_Ks + KSWZ(32 + r32, cb)); \
      const bf16x8 qf = d0 < NQR ? qr[d0 < NQR ? d0 : 0] : *(const bf16x8*)(Qrl + (d0 - NQR) * 32); \
      P0 = __builtin_amdgcn_mfma_f32_32x32x16_bf16(b0, qf, P0, 0, 0, 0); P1 = __builtin_amdgcn_mfma_f32_32x32x16_bf16(b1, qf, P1, 0, 0, 0); } } while (0)
#define MASK(P0, P1, j) do { if (NA) { if ((j) >= U.nct) na_apply(P0, P1, M, M.klo + (j) - U.nct); } } while (0)
#define RESC(a) do { if (__any((a) < 1.f)) { if (hi == 0) al_l[r32] = (a); asm volatile("s_waitcnt lgkmcnt(0)" ::: "memory"); \
    _Pragma("unroll") for (int d = 0; d < 4; ++d) _Pragma("unroll") for (int r = 0; r < 16; ++r) o[d][r] *= al_l[crow(r, hi)]; } } while (0)
    f32x16 p0, p1; float mn, al; bf16x8 pa0, pa1, pa2, pa3; const int NT = U.NT;
    __syncthreads();
    SLOAD(0); asm volatile("s_waitcnt vmcnt(0)" ::: "memory"); SWRITE(0); __syncthreads();
#pragma unroll 1
    for (int j = 0; j < NT; ++j) {
        const int buf = j & 1;
        if (j + 1 < NT) SLOAD(j + 1);
        bool active = true;
        if (NA) { const int kr = M.klo + j - U.nct; active = (j < U.nct) || (kr >= M.rs && kr < M.rs + 8); }
        if (active) {
        SBAR(); QKT(p0, p1, buf); MASK(p0, p1, j);
        partialSM(p0, p1, m_reg, mn, al); RESC(al);
        finishSM(p0, p1, al, l_reg, pa0, pa1, pa2, pa3); SBAR();
        pv_d0(o, vb0 + buf * SHM_V, pa0, pa1, pa2, pa3);
        }
        if (j + 1 < NT) { asm volatile("s_waitcnt vmcnt(0)" ::: "memory"); SWRITE(buf ^ 1); }
        __syncthreads();
    }
    if (hi == 0) li_l[r32] = l_reg; asm volatile("s_waitcnt lgkmcnt(0)" ::: "memory");
    float rli[16];
#pragma unroll
    for (int r = 0; r < 16; ++r) rli[r] = fast_rcp(li_l[crow(r, hi)]);
    char* Ot = lds + wid * 8704;
#pragma unroll
    for (int r = 0; r < 16; ++r) { const int orow = crow(r, hi);
#pragma unroll
        for (int d0 = 0; d0 < 4; ++d0) { const float v = o[d0][r] * rli[r]; *(bf16_t*)(Ot + orow * 272 + (d0 * 32 + r32) * 2) = (bf16_t)(pk2(v, v) & 0xffffu); } }
    asm volatile("s_waitcnt lgkmcnt(0)" ::: "memory");
    char* Og = (char*)(U.O + (long)(wid * QBLK) * U.ldo);
#pragma unroll
    for (int k = 0; k < 8; ++k) { const int id = lane + 64 * k, row = id >> 4, ch = id & 15;
        *(u32x4*)(Og + (unsigned)(row * (int)U.ldo + ch * 8) * 2u) = *(const u32x4*)(Ot + row * 272 + ch * 16); }
#undef KSWZ
#undef SLOAD
#undef SWRITE
#undef QKT
#undef MASK
#undef RESC
}
}

__device__ __forceinline__ void phase_mla(const Frame& F, bool need_ctx) {
    const bf16_t* P = F.wsb(WS_P); const bf16_t* Kb = F.wsb(WS_K); const bf16_t* Vb = F.wsb(WS_V); bf16_t* BR = F.wsb(WS_BR);
    const int nunits = 512 + (need_ctx ? 64 : 0);
    att::NaMask M{};
    for (int u = F.bid; u < nunits; u += F.G) {
        att::Unit U; int b, h, qrow;
        if (u < 512) { b = u >> 6; h = (u >> 3) & 7; qrow = b * SEQ + (u & 7) * 256; U.NT = KVROWS / 64; }
        else { const int v = u - 512; b = v >> 3; h = v & 7; qrow = NLAT + b * CTX; U.NT = CTX / 64; }
        U.Q = P + (size_t)qrow * DINP + PC_Q + h * 192; U.ldq = DINP;
        U.K = Kb + (size_t)b * KVROWS * 1536 + h * 192; U.ldk = 1536; U.V = Vb + (size_t)b * KVROWS * 1024 + h * 128; U.ldv = 1024;
        U.O = BR + (size_t)qrow * 3072 + h * 128; U.ldo = 3072; U.nct = 0; U.rowC = 0; U.rowL = 0;
        att::attn_unit<192, false>(U, (char*)F.lds, M, F.tid);
    }
}
__device__ __forceinline__ void phase_na(const Frame& F, int l, bool need_ctx) {
    const bf16_t* P = F.wsb(WS_P); bf16_t* BR = F.wsb(WS_BR);
    LAS float* tab = (LAS float*)(F.lds + 131072);
    const int nunits = 512 + (need_ctx ? 64 : 0);
    for (int u = F.bid; u < nunits; u += F.G) {
        att::Unit U; att::NaMask M{}; int b, h, qrow;
        if (u < 512) { b = u >> 6; h = (u >> 3) & 7; const int rg = u & 7; qrow = b * SEQ + rg * 256;
            const int klo = rg == 0 ? 0 : (rg * 4 - 4 > 24 ? 24 : rg * 4 - 4), nr = (rg == 0 || rg == 7) ? 8 : 11;
            U.NT = 4 + nr + (nr & 1); U.nct = 4; U.rowC = NLAT + b * CTX; U.rowL = b * SEQ + klo * 64;
            const int r = rg * 4 + (F.wave >> 1), c = (F.wave & 1) * 32 + (F.lane & 31), hi = F.lane >> 5;
            const int rs = r - 4 < 0 ? 0 : (r - 4 > 24 ? 24 : r - 4), wsc = c - 8 < 0 ? 0 : (c - 8 > 48 ? 48 : c - 8);
            M.bidx = 4 * hi - c + 15; M.wcol = 4 * hi - wsc; M.rs = rs; M.r = r; M.klo = klo; M.tab = tab + 64;
        } else { const int v = u - 512; b = v >> 3; h = v & 7; qrow = NLAT + b * CTX; U.NT = 4; U.nct = 4; U.rowC = NLAT + b * CTX; U.rowL = 0; M.tab = tab + 64; }
        __syncthreads();
        for (int i = F.tid; i < 15 * 32; i += 512) { const int dr = i >> 5, dc = i & 31; tab[64 + i] = dc < 31 ? F.in[I_RPB][((size_t)(l * 8 + h) * 15 + dr) * 31 + dc] * LOG2E : 0.f; }
        U.Q = P + (size_t)qrow * DINP + PC_NAQ + h * 128; U.ldq = DINP;
        U.K = P + PC_NAK + h * 128; U.ldk = DINP; U.V = P + PC_NAV + h * 128; U.ldv = DINP;
        U.O = BR + (size_t)qrow * 3072 + 2048 + h * 128; U.ldo = 3072;
        att::attn_unit<128, true>(U, (char*)F.lds, M, F.tid);
    }
}

__device__ __forceinline__ bf16x8 frag_row(const LAS unsigned char* t, int pitch, int row0, int k0, int lane) {
    return *(const LAS bf16x8*)(t + (row0 + (lane & 31)) * pitch + (k0 + 8 * (lane >> 5)) * 2);
}
__device__ __forceinline__ s16x4 tr16(const LAS unsigned char* p) {
    typedef short v4i16 __attribute__((ext_vector_type(4)));
    return __builtin_bit_cast(s16x4, __builtin_amdgcn_ds_read_tr16_b64_v4i16((LAS v4i16*)p));
}
__device__ __forceinline__ bf16x8 frag_tr(const LAS unsigned char* t, int pitch, int k0, int col0, int lane) {
    const int h = lane >> 5, blk = (lane >> 4) & 1, q = (lane & 15) >> 2, p = lane & 3;
    const LAS unsigned char* a = t + (k0 + 8 * h + q) * pitch + (col0 + 16 * blk + 4 * p) * 2;
    const s16x4 lo = tr16(a), hi = tr16(a + 4 * pitch);
    return (bf16x8){lo[0], lo[1], lo[2], lo[3], hi[0], hi[1], hi[2], hi[3]};
}
__device__ __forceinline__ int chunk_row0(int b, int c) { return c < 2 ? NLAT + b * CTX + c * 128 : b * SEQ + (c - 2) * 128; }
__device__ __forceinline__ float chunk_cumsum(float d0, float d1, int lane, float& c0, float& c1) {
    float s = d0 + d1;
#pragma unroll
    for (int o = 1; o < 64; o <<= 1) { const float t = __shfl_up(s, o); if (lane >= o) s += t; }
    c1 = s; c0 = s - d1; return __shfl(s, 63);
}

__device__ __forceinline__ void phase_ssd_states(const Frame& F, int l) {
    constexpr int XP = 592, BP = 336;
    LAS unsigned char* Xs = F.lds; LAS unsigned char* Bm = F.lds + 128 * XP; LAS float* wts = (LAS float*)(F.lds + 128 * XP + 128 * BP);
    const bf16_t* XBC = F.wsb(WS_XBC); const float* DT = F.wsf(WS_DT); float* SST = F.wsf(WS_SST); float* CDEC = F.wsf(WS_CDEC);
    const int lane = F.lane, w = F.wave, d = w >> 2, hh = w & 3;
    for (int it = F.bid; it < NB * NCHUNK * 4; it += F.G) {
        const int b = it / (NCHUNK * 4), c = (it / 4) % NCHUNK, g = it & 3, row0 = chunk_row0(b, c), h = g * 4 + hh;
        __syncthreads();
        for (int i = F.tid; i < 128 * 32; i += 512) { const int r = i >> 5, ch = i & 31; *(LAS u32x4*)(Xs + r * XP + ch * 16) = *(const u32x4*)(XBC + (size_t)(row0 + r) * 2048 + g * 256 + ch * 8); }
        for (int i = F.tid; i < 128 * 16; i += 512) { const int r = i >> 4, ch = i & 15; *(LAS u32x4*)(Bm + r * BP + ch * 16) = *(const u32x4*)(XBC + (size_t)(row0 + r) * 2048 + 1024 + g * 128 + ch * 8); }
        {   const float a = -expf(F.in[I_ALOG][(l * 2 + d) * 16 + h]);
            const float dt0 = DT[(size_t)(row0 + 2 * lane) * 32 + d * 16 + h], dt1 = DT[(size_t)(row0 + 2 * lane + 1) * 32 + d * 16 + h];
            float c0, c1; const float tot = chunk_cumsum(dt0 * a, dt1 * a, lane, c0, c1);
            const float e0 = d == 0 ? tot - c0 : c0 - dt0 * a, e1 = d == 0 ? tot - c1 : c1 - dt1 * a;
            wts[w * 128 + 2 * lane] = dt0 * expf(e0); wts[w * 128 + 2 * lane + 1] = dt1 * expf(e1);
            if (lane == 0) CDEC[((b * 2 + d) * 16 + h) * NCHUNK + c] = expf(tot);
        }
        __syncthreads();
        bf16_t* dst = (bf16_t*)SST + ((size_t)((b * 2 + d) * 16 + h) * NCHUNK + c) * 8192;
        LAS unsigned char* wsc = F.lds + 122880 + w * 4096;
#pragma unroll 1
        for (int pt = 0; pt < 2; ++pt) {
            f32x16 acc[4] = {};
#pragma unroll 1
            for (int ks = 0; ks < 8; ++ks) {
                const f32x4 w0 = *(const LAS f32x4*)(wts + w * 128 + 16 * ks + 8 * (lane >> 5)), w1 = *(const LAS f32x4*)(wts + w * 128 + 16 * ks + 8 * (lane >> 5) + 4);
                const bf16x8 x = frag_tr(Xs, XP, 16 * ks, hh * 64 + 32 * pt, lane);
                u32x4 o; o.x = pk2(bf2f((unsigned short)x[0]) * w0[0], bf2f((unsigned short)x[1]) * w0[1]); o.y = pk2(bf2f((unsigned short)x[2]) * w0[2], bf2f((unsigned short)x[3]) * w0[3]);
                o.z = pk2(bf2f((unsigned short)x[4]) * w1[0], bf2f((unsigned short)x[5]) * w1[1]); o.w = pk2(bf2f((unsigned short)x[6]) * w1[2], bf2f((unsigned short)x[7]) * w1[3]);
                const bf16x8 a = __builtin_bit_cast(bf16x8, o);
#pragma unroll
                for (int nt = 0; nt < 4; ++nt) { const bf16x8 bb = frag_tr(Bm, BP, 16 * ks, 32 * nt, lane); acc[nt] = __builtin_amdgcn_mfma_f32_32x32x16_bf16(a, bb, acc[nt], 0, 0, 0); }
            }
            int le = lane; asm volatile("" : "+v"(le));
#pragma unroll
            for (int nh = 0; nh < 2; ++nh) {
#pragma unroll
                for (int q = 0; q < 2; ++q)
#pragma unroll
                    for (int r = 0; r < 16; ++r) { const float v = acc[2 * nh + q][r]; *(LAS bf16_t*)(wsc + att::crow(r, le >> 5) * 128 + (32 * q + (le & 31)) * 2) = (bf16_t)(pk2(v, v) & 0xffffu); }
                asm volatile("s_waitcnt lgkmcnt(0)" ::: "memory");
#pragma unroll
                for (int k = 0; k < 4; ++k) { const int id = le + 64 * k, row = id >> 3, ch = id & 7;
                    *(u32x4*)(dst + (size_t)(32 * pt + row) * 128 + 64 * nh + ch * 8) = *(const LAS u32x4*)(wsc + row * 128 + ch * 16); }
                asm volatile("s_waitcnt lgkmcnt(0)" ::: "memory");
            }
        }
    }
}
__device__ __forceinline__ void phase_ssd_scan(const Frame& F) {
    const u32x2* SST = (const u32x2*)F.wsf(WS_SST); const float* CDEC = F.wsf(WS_CDEC); u32x2* SENT = (u32x2*)F.wsb(WS_SENT);
    const int gt = F.bid * 512 + F.tid, NT = F.G * 512;
    for (int idx = gt; idx < 256 * 2048; idx += NT) {
        const int combo = idx >> 11, e4 = idx & 2047, d = (combo >> 4) & 1;
        const u32x2* base = SST + (size_t)combo * NCHUNK * 2048 + e4; u32x2* ob = SENT + (size_t)combo * NCHUNK * 2048 + e4; const float* cd = CDEC + combo * NCHUNK;
        u32x2 v[NCHUNK];
#pragma unroll
        for (int c = 0; c < NCHUNK; ++c) v[c] = base[(size_t)c * 2048];
        float z0; asm volatile("v_mov_b32 %0, 0" : "=v"(z0));
        f32x4 st = {z0, z0, z0, z0};
#pragma unroll
        for (int i = 0; i < NCHUNK; ++i) { const int cf = i, cb = i == 0 ? 1 : (i == 1 ? 0 : NCHUNK + 1 - i); const int cc = d == 0 ? cf : cb;
            u32x2 o; o.x = pk2(st.x, st.y); o.y = pk2(st.z, st.w); ob[(size_t)cc * 2048] = o;
            const f32x4 cs = {lo16(v[cc].x), hi16(v[cc].x), lo16(v[cc].y), hi16(v[cc].y)}; st = st * cd[cc] + cs; }
    }
}
__device__ __forceinline__ void phase_ssd_out(const Frame& F, int l, bool need_ctx) {
    constexpr int CP = 272, XHP = 144;
    LAS unsigned char* Cm = F.lds; LAS unsigned char* Bm = F.lds + 34816; LAS unsigned char* Mc = Bm; LAS unsigned char* Xh = F.lds + 69632;
    LAS unsigned char* Zh = F.lds + 88064; LAS unsigned char* Sf = F.lds + 106496; LAS unsigned char* Sb = F.lds + 123904;
    LAS float* arr = (LAS float*)(F.lds + 141312);
    const bf16_t* XBC = F.wsb(WS_XBC); const bf16_t* P = F.wsb(WS_P); const float* DT = F.wsf(WS_DT); const bf16_t* SENT = F.wsb(WS_SENT); bf16_t* BR = F.wsb(WS_BR);
    float* GSS = F.wsf(WS_GSS) + (size_t)l * NROW * 4;
    const int lane = F.lane, w = F.wave, hi = lane >> 5, c_lo = need_ctx ? 0 : 2, nch = NCHUNK - c_lo;
    const int lt = w >> 1, pt = w & 1;
#pragma unroll 1
    for (int it = F.bid; it < NB * nch * 16; it += F.G) {
        const int b = it / (nch * 16), c = c_lo + (it >> 4) % nch, h = it & 15, g = h >> 2, row0 = chunk_row0(b, c);
        int tq = F.tid; asm volatile("" : "+v"(tq));
        __syncthreads();
        {
            u32x4 vb[4], vc[4], vx[2], vz[2], vf[2], vs[2];
            const bf16_t* sf = SENT + ((size_t)((b * 2 + 0) * 16 + h) * NCHUNK + c) * 8192; const bf16_t* sb = SENT + ((size_t)((b * 2 + 1) * 16 + h) * NCHUNK + c) * 8192;
#pragma unroll
            for (int k = 0; k < 4; ++k) { const int i = tq + 512 * k, r = i >> 4, ch = i & 15; const bf16_t* src = XBC + (size_t)(row0 + r) * 2048 + 1024 + g * 128 + ch * 8; vb[k] = *(const u32x4*)src; vc[k] = *(const u32x4*)(src + 512); }
#pragma unroll
            for (int k = 0; k < 2; ++k) { const int i = tq + 512 * k, r = i >> 3, ch = i & 7; vx[k] = *(const u32x4*)(XBC + (size_t)(row0 + r) * 2048 + h * 64 + ch * 8); vz[k] = *(const u32x4*)(P + (size_t)(row0 + r) * DINP + PC_Z + h * 64 + ch * 8);
                vf[k] = *(const u32x4*)(sf + (size_t)i * 8); vs[k] = *(const u32x4*)(sb + (size_t)i * 8); }
#pragma unroll
            for (int k = 0; k < 4; ++k) { const int i = tq + 512 * k, r = i >> 4, ch = i & 15; *(LAS u32x4*)(Bm + r * CP + ch * 16) = vb[k]; *(LAS u32x4*)(Cm + r * CP + ch * 16) = vc[k]; }
#pragma unroll
            for (int k = 0; k < 2; ++k) { const int i = tq + 512 * k, r = i >> 3, ch = i & 7; *(LAS u32x4*)(Xh + r * XHP + ch * 16) = vx[k]; *(LAS u32x4*)(Zh + r * XHP + ch * 16) = vz[k];
                const int rs_ = i >> 4, cs_ = i & 15; *(LAS u32x4*)(Sf + rs_ * CP + cs_ * 16) = vf[k]; *(LAS u32x4*)(Sb + rs_ * CP + cs_ * 16) = vs[k]; }
        }
        if (w < 2) {
            const int d = w; const float a = -expf(F.in[I_ALOG][(l * 2 + d) * 16 + h]);
            const float dt0 = DT[(size_t)(row0 + 2 * lane) * 32 + d * 16 + h], dt1 = DT[(size_t)(row0 + 2 * lane + 1) * 32 + d * 16 + h];
            float c0, c1; const float tot = chunk_cumsum(dt0 * a, dt1 * a, lane, c0, c1);
            if (d == 1) { c0 = tot - c0 + dt0 * a; c1 = tot - c1 + dt1 * a; }
            LAS float* q = arr + d * 128 + 2 * lane;
            q[0] = c0 * LOG2E; q[1] = c1 * LOG2E; q[256] = dt0; q[257] = dt1; q[512] = fast_exp2(c0 * LOG2E); q[513] = fast_exp2(c1 * LOG2E);
        }
        __syncthreads();
        f32x16 cb[2] = {};
#pragma unroll 2
        for (int ks = 0; ks < 8; ++ks) { const bf16x8 a = frag_row(Cm, CP, 32 * lt, 16 * ks, lane);
#pragma unroll
            for (int i = 0; i < 2; ++i) { const bf16x8 bb = frag_row(Bm, CP, 32 * (2 * pt + i), 16 * ks, lane); cb[i] = __builtin_amdgcn_mfma_f32_32x32x16_bf16(a, bb, cb[i], 0, 0, 0); } }
        int lb = 32 * lt + 4 * hi, sb0 = 64 * pt + (lane & 31);
        asm volatile("" : "+v"(lb), "+v"(sb0));
        __syncthreads();
        const LAS float* aF = arr; const LAS float* rB = arr + 128;
#pragma unroll
        for (int i = 0; i < 2; ++i) { const int sidx = sb0 + 32 * i, dlt = sidx - lb;
            const float afs = aF[sidx], rbs = rB[sidx], dfs = aF[256 + sidx], dbs = rB[256 + sidx];
#pragma unroll
            for (int r = 0; r < 16; ++r) { const int cr = (r & 3) + 8 * (r >> 2), ll = lb + cr;
                const float f = dlt <= cr ? fast_exp2(aF[ll] - afs) * dfs : 0.f, bk = dlt >= cr ? fast_exp2(rB[ll] - rbs) * dbs : 0.f;
                const float m = cb[i][r] * (f + bk);
                *(LAS bf16_t*)(Mc + ll * CP + sidx * 2) = (bf16_t)(pk2(m, m) & 0xffffu); } }
        __syncthreads();
        f32x16 yd = {}, yf = {}, yb = {};
#pragma unroll 2
        for (int ks = 0; ks < 8; ++ks) {
            const bf16x8 am = frag_row(Mc, CP, 32 * lt, 16 * ks, lane), bx = frag_tr(Xh, XHP, 16 * ks, 32 * pt, lane);
            yd = __builtin_amdgcn_mfma_f32_32x32x16_bf16(am, bx, yd, 0, 0, 0);
            const bf16x8 ac = frag_row(Cm, CP, 32 * lt, 16 * ks, lane), bf = frag_row(Sf, CP, 32 * pt, 16 * ks, lane), bb = frag_row(Sb, CP, 32 * pt, 16 * ks, lane);
            yf = __builtin_amdgcn_mfma_f32_32x32x16_bf16(ac, bf, yf, 0, 0, 0);
            yb = __builtin_amdgcn_mfma_f32_32x32x16_bf16(ac, bb, yb, 0, 0, 0);
        }
        const float dsk = F.in[I_SSDD][l * 16 + h]; const int pcol = 32 * pt + (lane & 31);
#pragma unroll
        for (int r = 0; r < 16; ++r) { const int cr = (r & 3) + 8 * (r >> 2), ll = lb + cr;
            const float xs = bf2f(*(const LAS bf16_t*)(Xh + ll * XHP + pcol * 2));
            const float y = yd[r] + aF[512 + ll] * yf[r] + rB[512 + ll] * yb[r] + dsk * xs;
            LAS bf16_t* zp = (LAS bf16_t*)(Zh + ll * XHP + pcol * 2);
            const float v = y * siluf_(bf2f(*zp));
            *zp = (bf16_t)(pk2(v, v) & 0xffffu); }
        __syncthreads();
        {
            int tz = F.tid; asm volatile("" : "+v"(tz));
            const int r = tz >> 2, q4 = tz & 3; const LAS unsigned char* src = Zh + r * XHP + q4 * 32;
            const u32x4 a = *(const LAS u32x4*)src, b2 = *(const LAS u32x4*)(src + 16);
            bf16_t* dst = BR + (size_t)(row0 + r) * 3072 + 1024 + h * 64 + q4 * 16;
            *(u32x4*)dst = a; *(u32x4*)(dst + 8) = b2;
            float ss = 0.f;
            { const unsigned wv[8] = {a.x, a.y, a.z, a.w, b2.x, b2.y, b2.z, b2.w};
#pragma unroll
              for (int k = 0; k < 8; ++k) { const float x0 = lo16(wv[k]), x1 = hi16(wv[k]); ss += x0 * x0 + x1 * x1; } }
            ss += __shfl_xor(ss, 1); ss += __shfl_xor(ss, 2);
            if (q4 == 0) atomicAdd(GSS + (size_t)(row0 + r) * 4 + g, ss);
        }
    }
}
__device__ __forceinline__ void phase_ssd_norm(const Frame& F, int l, bool need_ctx) {
    bf16_t* BR = F.wsb(WS_BR); const float* GSS = F.wsf(WS_GSS) + (size_t)l * NROW * 4; const float* ng = F.in[I_SSDG] + l * 1024;
    const int gw = F.bid * 8 + F.wave, nrows = need_ctx ? NROW : NLAT, per = nrows / (GRID * 8), lane = F.lane;
    float gg[16];
#pragma unroll
    for (int i = 0; i < 16; ++i) gg[i] = ng[lane * 16 + i];
    for (int i = 0; i < per; ++i) { const int row = gw * per + i;
        bf16_t* p = BR + (size_t)row * 3072 + 1024 + lane * 16; float v[16]; ld16(p, v);
        const float rs = rsqrtf(GSS[(size_t)row * 4 + (lane >> 4)] * (1.0f / 256.0f) + EPS);
#pragma unroll
        for (int j = 0; j < 16; ++j) v[j] = v[j] * rs * gg[j];
        st16(p, v); }
}

constexpr int NSTEPS = 2 + 4 * 16;
__global__ void __launch_bounds__(512, 2) fwd_kernel(Args args) {
    extern __shared__ __attribute__((aligned(16))) unsigned char lds_raw[];
    asm volatile("s_nop 0\n\ts_nop 0\n\ts_nop 0\n\ts_nop 0\n\ts_nop 0\n\ts_nop 0\n\ts_nop 0\n\ts_nop 0\n\ts_nop 0\n\ts_nop 0\n\ts_nop 0\n\ts_nop 0\n\ts_nop 0\n\ts_nop 0");
    Frame F; F.lds = (LAS unsigned char*)lds_raw; F.tid = threadIdx.x; F.lane = F.tid & 63; F.wave = __builtin_amdgcn_readfirstlane(F.tid >> 6); F.bid = blockIdx.x;
    F.in = args.in; F.out = args.out; F.ws = args.ws;
    volatile LAS unsigned* MISC = (volatile LAS unsigned*)(F.lds + MISC_OFF);
    for (int u = F.tid; u < (LDS_BYTES - MISC_OFF) / 4; u += 512) MISC[u] = 0u;
    __syncthreads();
    unsigned* ctl = (unsigned*)(F.ws + WS_CTL);
#if !MK_PER_STEP
    XcdBarrier bar = xcd_barrier_post(ctl + CW_BAR, MISC + 8);
#endif
    const int lo = args.st_lo, hi = args.st_hi;
#ifndef MK_PHASES
#define MK_PHASES 0xFFFFFFFFu
#endif
#define EN(k) (((MK_PHASES) >> (k)) & 1u)
#ifndef MK_DUPGU
#define MK_DUPGU 0
#endif
#ifndef MK_DUP
#define MK_DUP 0u
#endif
#define REP(k) for (int rep_ = 0; rep_ <= (int)(((MK_DUP) >> (k)) & 1u); ++rep_)
#define RUN(s) (lo <= (s) && (s) < hi)
#if MK_PER_STEP
#define SEAM() do { } while (0)
#else
#define SEAM() xcd_barrier(bar)
#endif
#define PH Frame Fp = F; { int t_; asm volatile("v_mbcnt_lo_u32_b32 %0, -1, 0\n\tv_mbcnt_hi_u32_b32 %0, -1, %0" : "=v"(t_)); t_ += F.wave << 6;     Fp.tid = t_; Fp.lane = t_ & 63; Fp.wave = __builtin_amdgcn_readfirstlane(t_ >> 6); \
    unsigned char* w_ = args.ws; asm volatile("" : "+s"(w_)); Fp.ws = w_; int b_ = blockIdx.x; asm volatile("" : "+s"(b_)); Fp.bid = b_; float* o_ = args.out; asm volatile("" : "+s"(o_)); Fp.out = o_; } \
    float* HC = Fp.wsf(WS_HC); bf16_t* U = Fp.wsb(WS_U); bf16_t* P = Fp.wsb(WS_P); bf16_t* HID = Fp.wsb(WS_P); const float* mod = Fp.wsf(WS_MOD) + (size_t)l * 9 * (NMOD * DM); \
    (void)HC; (void)U; (void)P; (void)HID; (void)mod;

    if (EN(0) && RUN(0)) { const int l = 0; PH; phase_adaln(Fp); }

#pragma unroll 1
    for (int hl = 0; hl < 4; ++hl) {
        const int l = hl >> 1, second = hl & 1, sb = 2 + 16 * hl;
        const bool need_ctx = (l == 0);
        const float* normg = F.in[I_NORMG] + (size_t)l * 3 * DM;
        if (!second) {
            if (EN(1) && RUN(sb + 0)) { PH; phase_convert(Fp, l); if (l == 0) SEAM(); }
        } else {
            const int mrows = need_ctx ? NROW : NLAT;
            if (EN(2) && RUN(sb + 0)) { PH; phase_norm(Fp, Fp.out, HC, normg + DM, mod, 3, U, NROW, HC, Fp.wsf(WS_SST), MK_I8GATE ? Fp.ws + WS_U8M : nullptr, Fp.wsf(WS_RSC)); SEAM(); }
            if (EN(3) && RUN(sb + 1)) { PH; pg8::ProbWin57 S{U, Fp.wsb(WS_U8M), Fp.wsb(WS_WIN), DM, DM, DM, need_ctx ? 1 : 0, Fp.G, Fp.bid};
                pg8::EpiP57 E{P, DINP, Fp.wsb(WS_GATE), Fp.wsf(WS_RSC), (const float*)(Fp.ws + WS_CMAX) + (size_t)l * NQCOL + 22528};
                pg8::gemm_phase<pg8::EpiP57, pg8::ProbWin57, MK_I8GATE ? 2 : 0>(Fp.lds, S, E, Fp.tid); SEAM(); }
            if (EN(4) && RUN(sb + 2)) { PH; phase_prep(Fp, l, need_ctx); SEAM(); }
            if (EN(5) && RUN(sb + 3)) { PH; pg8::ProbStd S{P + PC_CKV, Fp.wsb(WS_WUKV), DINP, 512, 512, NROW / 256, 8, Fp.G, Fp.bid}; pg8::EpiKV E{Fp.wsb(WS_K), Fp.wsb(WS_V)};
                pg8::gemm_phase(Fp.lds, S, E, Fp.tid); SEAM(); }
            if (EN(6) && RUN(sb + 4)) { PH; phase_knorm(Fp, l); REP(6) phase_ssd_states(Fp, l); SEAM(); }
            if (EN(7) && RUN(sb + 5)) { PH; phase_ssd_scan(Fp); }
            if (EN(9) && RUN(sb + 5)) { PH; REP(9) phase_na(Fp, l, need_ctx); SEAM(); }
            if (EN(8) && RUN(sb + 6)) { PH; REP(8) phase_mla(Fp, need_ctx); }
            if (EN(10) && RUN(sb + 6)) { PH; REP(10) phase_ssd_out(Fp, l, need_ctx); SEAM(); }
            if (EN(10) && RUN(sb + 7)) { PH; phase_ssd_norm(Fp, l, need_ctx); SEAM(); }
            if (EN(11) && RUN(sb + 9)) { PH; pg8::ProbMerge S{Fp.wsb(WS_BR), Fp.wsb(WS_WBR), 3072, 1024, 1024, mrows / 256, 8, Fp.G, Fp.bid}; pg8::EpiMerge E{Fp.wsb(WS_GATE), U};
                REP(11) pg8::gemm_phase(Fp.lds, S, E, Fp.tid); SEAM(); }
            if (EN(12) && RUN(sb + 10)) { PH; pg8::ProbSplit S{U, Fp.wsb(WS_WOUT), DM, DM, DM, mrows / 256, Fp.G, Fp.bid};
                pg8::EpiResid E{{Fp.out, HC}, {Fp.out, HC}, mod, 5, 1.0f, Fp.wsf(WS_SST)};
                pg8::gemm_phase(Fp.lds, S, E, Fp.tid); SEAM(); }
        }
        {
            const int frows = (second && !need_ctx) ? NLAT : NROW;
            const int nbase = second ? 6 : 0;
            if (EN(13) && RUN(sb + 11)) { PH; const float* inl = (hl == 0) ? F.in[I_X] : Fp.out; const float* inc = (hl == 0) ? F.in[I_CTX] : HC; phase_norm(Fp, inl, inc, normg + (second ? 2 : 0) * DM, mod, nbase, MK_I8GU ? nullptr : U, frows, HC, hl == 0 ? nullptr : Fp.wsf(WS_SST), MK_I8GU ? (unsigned char*)U : nullptr, Fp.wsf(WS_RSC)); SEAM(); }
            if (EN(14) && RUN(sb + 12)) { PH; pg8::ProbStd S{U, Fp.wsb(second ? WS_WGU2 : WS_WGU1), DM, DM, MK_I8GU ? DM / 2 : DM, frows / 256, 44, Fp.G, Fp.bid};
                pg8::EpiSwiglu<MK_I8GU != 0> E{HID, Fp.wsf(WS_RSC), (const float*)(Fp.ws + WS_CMAX) + (size_t)l * NQCOL + (second ? 11264 : 0), Fp.lds};
                pg8::gemm_phase<pg8::EpiSwiglu<MK_I8GU != 0>, pg8::ProbStd, MK_I8GU ? 1 : 0>(Fp.lds, S, E, Fp.tid); SEAM(); }
            if (EN(15) && RUN(sb + 13)) { PH; const float* inl = (hl == 0) ? F.in[I_X] : Fp.out; const float* inc = (hl == 0) ? F.in[I_CTX] : HC; pg8::ProbSplit S{HID, Fp.wsb(second ? WS_WDN2 : WS_WDN1), DFF, DFF, DFF, frows / 256, Fp.G, Fp.bid};
                pg8::EpiResid E{{(float*)inl, (float*)inc}, {Fp.out, HC}, mod, nbase + 2, 0.5f, Fp.wsf(WS_SST)};
                pg8::gemm_phase(Fp.lds, S, E, Fp.tid); if (hl != 3) SEAM(); }
        }
    }
#undef RUN
#undef SEAM
}

extern "C" void kernel_launch(void* const* d_in, const int* in_sizes, int n_in, void* d_out, int out_size, void* d_ws, size_t ws_size, hipStream_t stream) {
    static int grid = 0;
    if (grid == 0) {
        if (n_in != 30 || in_sizes[0] != NLAT * DM || out_size != NLAT * DM || ws_size < WS_END) {
            fprintf(stderr, "kernel_launch: unexpected shapes (n_in %d in0 %d out %d ws %zu, need ws >= %zu); nothing launched\n", n_in, n_in > 0 ? in_sizes[0] : -1, out_size, ws_size, (size_t)WS_END); grid = -1; return; }
        int dev = 0, cus = 0, per_cu = 0;
        if (hipGetDevice(&dev) != hipSuccess || hipDeviceGetAttribute(&cus, hipDeviceAttributeMultiprocessorCount, dev) != hipSuccess) { grid = -1; return; }
        if (hipFuncSetAttribute((const void*)fwd_kernel, hipFuncAttributeMaxDynamicSharedMemorySize, LDS_BYTES) != hipSuccess) { fprintf(stderr, "kernel_launch: hipFuncSetAttribute failed\n"); grid = -1; return; }
        if (hipOccupancyMaxActiveBlocksPerMultiprocessor(&per_cu, (const void*)fwd_kernel, 512, LDS_BYTES) != hipSuccess || per_cu < 1) fprintf(stderr, "kernel_launch: occupancy query reports %d\n", per_cu);
        (void)hipGetLastError();
        if (cus < GRID) { fprintf(stderr, "kernel_launch: %d CUs < %d: the persistent grid would not be resident; nothing launched\n", cus, GRID); grid = -1; return; }
        grid = GRID;
    }
    if (grid < 0) return;
    if (hipMemsetAsync((char*)d_ws + WS_CTL, 0, CTL_ZERO_BYTES, stream) != hipSuccess) { fprintf(stderr, "kernel_launch: memset failed\n"); return; }
    Args a{};
    for (int i = 0; i < 30; ++i) a.in[i] = (const float*)d_in[i];
    a.out = (float*)d_out; a.ws = (unsigned char*)d_ws;
#if MK_PER_STEP
    for (int s = 0; s < NSTEPS; ++s) {
        if (s == 1) continue;
        const int hl = (s - 2) / 16, k = (s - 2) % 16;
        if (s >= 2) { if ((hl & 1) == 0 && k >= 1 && k <= 10) continue; if ((hl & 1) == 1 && k > 10 && false) continue; if (k > 13) continue; }
        a.st_lo = s; a.st_hi = s + 1;
        hipLaunchKernelGGL(fwd_kernel, dim3(grid), dim3(512), LDS_BYTES, stream, a);
    }
#else
    a.st_lo = 0; a.st_hi = NSTEPS;
    hipLaunchKernelGGL(fwd_kernel, dim3(grid), dim3(512), LDS_BYTES, stream, a);
#endif
    const hipError_t le = hipPeekAtLastError();
    if (le != hipSuccess) fprintf(stderr, "kernel_launch: launch failed: %s\n", hipGetErrorName(le));
}
```

```cpp
#include <hip/hip_runtime.h>
#include <cstdio>
#include <cstdint>

#ifndef MK_PER_STEP
#define MK_PER_STEP 0
#endif

#ifndef MK_I8GATE
#define MK_I8GATE 1
#endif
#ifndef MK_I8GU
#define MK_I8GU 1
#endif
#define LAS __attribute__((address_space(3)))
#define GAS __attribute__((address_space(1)))
typedef unsigned short bf16_t;
typedef short bf16x8 __attribute__((ext_vector_type(8)));
typedef short s16x4 __attribute__((ext_vector_type(4)));
typedef float f32x2 __attribute__((ext_vector_type(2)));
typedef float f32x4 __attribute__((ext_vector_type(4)));
typedef float f32x16 __attribute__((ext_vector_type(16)));
typedef unsigned u32x2 __attribute__((ext_vector_type(2)));
typedef unsigned u32x4 __attribute__((ext_vector_type(4)));
typedef int i32x4 __attribute__((ext_vector_type(4)));
typedef GAS unsigned gu32;

constexpr int DM = 2048, NB = 8, SEQ = 2048, CTX = 256, NLAT = NB * SEQ, NCTXR = NB * CTX, NROW = NLAT + NCTXR;
constexpr int DFF = 5632, NMOD = 9, DIN = 14432, DINP = 8448, NWIN = 14592;
constexpr int PC_Q = 0, PC_CKV = 1536, PC_Z = 2048, PC_XBC = 3072, PC_NAQ = 5120, PC_NAK = 6144, PC_NAV = 7168, PC_KR = 8192, PC_DT = 8256;
constexpr int GT0 = 33;
constexpr int KVROWS = CTX + SEQ;
constexpr int NCHUNK = 18;
constexpr float EPS = 1e-6f;
constexpr float LOG2E = 1.4426950408889634f;

constexpr size_t MiB = 1u << 20;
constexpr size_t WS_CTL = 0, CTL_ZERO_BYTES = 4 * MiB;
constexpr size_t WS_MOD = 1 * MiB;
constexpr size_t WS_ROPE = 4 * MiB;
constexpr size_t WS_CDEC = 4 * MiB + 65536;
constexpr size_t WS_DT = 5 * MiB;
constexpr size_t WS_HC = 8 * MiB;
constexpr size_t WS_WGU1 = 24 * MiB, WS_WDN1 = 68 * MiB, WS_WGU2 = 90 * MiB, WS_WDN2 = 134 * MiB, WS_WIN = 156 * MiB, WS_WUKV = 213 * MiB, WS_WBR = 215 * MiB, WS_WOUT = 227 * MiB;
constexpr size_t WS_U = 236 * MiB;
constexpr size_t WS_P = 308 * MiB;
constexpr size_t WS_GATE = 605 * MiB;
constexpr size_t WS_K = 821 * MiB;
constexpr size_t WS_V = 875 * MiB;
constexpr size_t WS_XBC = 911 * MiB;
constexpr size_t WS_SST = 983 * MiB;
constexpr size_t WS_BR = 1127 * MiB;
constexpr size_t WS_END = 1235 * MiB;
constexpr int CW_TMO = 0, CW_BAR = 4096, CW_Q = 16384;
constexpr size_t WS_GSS = 3 * MiB;
constexpr size_t WS_CMAX = 3 * MiB + 640 * 1024;
constexpr size_t WS_RSC = 4 * MiB + 131072;
constexpr size_t WS_U8M = WS_XBC;
constexpr int NQCOL = 28672;
constexpr size_t WS_SENT = WS_U;

constexpr int LDS_SCRATCH = 155648, MISC_OFF = LDS_SCRATCH, LDS_BYTES = 159744;

__device__ __forceinline__ float bf2f(unsigned short b) { return __uint_as_float(((unsigned)b) << 16); }
__device__ __forceinline__ unsigned pk2(float lo, float hi) { unsigned r; asm("v_cvt_pk_bf16_f32 %0, %1, %2" : "=v"(r) : "v"(lo), "v"(hi)); return r; }
__device__ __forceinline__ float lo16(unsigned w) { return __uint_as_float(w << 16); }
__device__ __forceinline__ float hi16(unsigned w) { return __uint_as_float(w & 0xffff0000u); }
__device__ __forceinline__ float fast_exp2(float x) { return __builtin_amdgcn_exp2f(x); }
__device__ __forceinline__ float fast_rcp(float x) { return __builtin_amdgcn_rcpf(x); }
__device__ __forceinline__ float sigmoidf_(float x) { return fast_rcp(1.0f + fast_exp2(-x * LOG2E)); }
__device__ __forceinline__ float siluf_(float x) { return x * sigmoidf_(x); }
__device__ __forceinline__ float wave_sum(float v) {
#pragma unroll
    for (int o = 1; o < 64; o <<= 1) v += __shfl_xor(v, o);
    return v;
}
#define LDS_WAIT() asm volatile("s_waitcnt lgkmcnt(0)" ::: "memory")
#define VM_WAIT() asm volatile("s_waitcnt vmcnt(0)" ::: "memory")

namespace pg8 {
constexpr int BM = 256, BK = 64, HALF = 128, HTB = HALF * BK * 2, STAGE_BYTES = 8 * HTB, NXCD = 8, WGM = 4;
__host__ __device__ __forceinline__ int lds_byte(int r, int c) { const int st = (r >> 4) * 2 + (c >> 5), rr = r & 15, cc = c & 31, ob = rr * 64 + cc * 2; return st * 1024 + (ob ^ (((ob >> 9) & 1) << 5)); }
__host__ __device__ __forceinline__ void stage_rc(int b, int& R, int& C) { const int st = b / 1024, sb = b % 1024, swz = sb ^ (((sb >> 9) & 1) << 5); R = (st >> 1) * 16 + swz / 64; C = (st & 1) * 32 + (swz % 64) / 2; }
__host__ __device__ __forceinline__ int perm32(int rho) { const int n = rho >> 4, i = rho & 15; return 8 * (i >> 2) + 4 * n + (i & 3); }
struct Unit { int pm, pn, sub; };
__device__ __forceinline__ unsigned cvt_pk_bf16(float lo, float hi) { unsigned r; asm volatile("v_cvt_pk_bf16_f32 %0, %1, %2" : "=v"(r) : "v"(lo), "v"(hi)); return r; }

__device__ __forceinline__ bool tile_of(long L, int nM, int nN, Unit& u) {
    const int nwg = nM * nN; if (L >= nwg) return false;
    int wgid = (int)L; { const int q = nwg / NXCD, r = nwg % NXCD, xcd = wgid % NXCD, off = wgid / NXCD; wgid = (xcd < r ? xcd * (q + 1) : r * (q + 1) + (xcd - r) * q) + off; }
    const int nig = WGM * nN, gid = wgid / nig, fm = gid * WGM, gsz = (nM - fm) < WGM ? (nM - fm) : WGM;
    u.pm = fm + ((wgid % nig) % gsz); u.pn = (wgid % nig) / gsz; u.sub = 0; return true;
}
struct ProbStd {
    const bf16_t* A; const bf16_t* Bt; int lda, ldb, K, nM, nN, G, c;
    __device__ __forceinline__ bool next(int i, Unit& u) const { return tile_of((long)i * G + c, nM, nN, u); }
    __device__ __forceinline__ const char* a_base(const Unit& u) const { return (const char*)(A + (size_t)u.pm * BM * lda); }
    __device__ __forceinline__ const char* b_base(const Unit& u) const { return (const char*)(Bt + (size_t)u.pn * BM * ldb); }
    __device__ __forceinline__ bool is_i8(const Unit&) const { return false; }
    __device__ __forceinline__ bool keep_acc(const Unit&) const { return false; }
    __device__ __forceinline__ int nt(const Unit&) const { return K / BK; }
};
struct ProbSplit {
    const bf16_t* A; const bf16_t* Bt; int lda, ldb, K, nM, G, c;
    __device__ __forceinline__ bool next(int i, Unit& u) const {
        if (i < 2) { const bool ok = tile_of((long)i * G + c, 64, 8, u); u.pm = 63 - u.pm; return ok; }
        if (i > 2 || nM == 64) return false;
        const int q = c >> 2; u.pm = 64 + (q >> 3); u.pn = q & 7; u.sub = 1 + (c & 3); return true; }
    __device__ __forceinline__ int nt(const Unit& u) const { return u.sub ? K / (4 * BK) : K / BK; }
    __device__ __forceinline__ const char* a_base(const Unit& u) const { return (const char*)(A + (size_t)u.pm * BM * lda + (u.sub ? (u.sub - 1) * (K / 4) : 0)); }
    __device__ __forceinline__ const char* b_base(const Unit& u) const { return (const char*)(Bt + (size_t)u.pn * BM * ldb + (u.sub ? (u.sub - 1) * (K / 4) : 0)); }
    __device__ __forceinline__ bool is_i8(const Unit&) const { return false; }
    __device__ __forceinline__ bool keep_acc(const Unit&) const { return false; }
};
struct ProbWin {
    const bf16_t* A; const bf16_t* Bt; int lda, ldb, K, full, G, c;
    __device__ __forceinline__ bool next(int i, Unit& u) const {
        const int L = i * G + c, per = full ? 33 : 19;
        Unit t; const bool lat = tile_of(L < 64 * 33 ? L : 0, 64, 33, t);
        const int r = L - 64 * 33, rr = r < 0 ? 0 : r, j = rr % per;
        const int cpn = full ? j : j + 6 + (j >= 2 ? 4 : 0) + (j >= 10 ? 4 : 0);
        const bool isl = L < 64 * 33;
        u.pm = isl ? t.pm : 64 + rr / per; u.pn = isl ? t.pn : cpn; u.sub = 0;
        return isl ? lat : (r < 8 * per); }
    __device__ __forceinline__ bool is_i8(const Unit&) const { return false; }
    __device__ __forceinline__ const char* a_base(const Unit& u) const { return (const char*)(A + (size_t)u.pm * BM * lda); }
    __device__ __forceinline__ const char* b_base(const Unit& u) const { return (const char*)(Bt + (size_t)u.pn * BM * ldb); }
    __device__ __forceinline__ bool keep_acc(const Unit&) const { return false; }
    __device__ __forceinline__ size_t a_kstep() const { return (size_t)BK * 2; }
    __device__ __forceinline__ int nt(const Unit&) const { return K / BK; }
};
struct ProbGate {
    const bf16_t* A8; const bf16_t* Bt; int lda, ldb, K, nM, G, c;
    __device__ __forceinline__ bool next(int i, Unit& u) const { const bool ok = tile_of((long)i * G + c, nM, 24, u); u.pn += GT0; return ok; }
    __device__ __forceinline__ bool is_i8(const Unit&) const { return true; }
    __device__ __forceinline__ const char* a_base(const Unit& u) const { return (const char*)(A8 + (size_t)u.pm * BM * lda); }
    __device__ __forceinline__ const char* b_base(const Unit& u) const { return (const char*)(Bt + (size_t)u.pn * BM * ldb); }
    __device__ __forceinline__ bool keep_acc(const Unit&) const { return false; }
    __device__ __forceinline__ size_t a_kstep() const { return (size_t)BK * 2; }
    __device__ __forceinline__ int nt(const Unit&) const { return K / BK; }
};
struct ProbWin57 {
    const bf16_t* A; const bf16_t* A8; const bf16_t* Bt; int lda, ldb, K, full, G, c;
    __device__ __forceinline__ bool next(int i, Unit& u) const {
        const int L = i * G + c, per = full ? 57 : 19;
        Unit t; const bool lat = tile_of(L < 64 * 57 ? L : 0, 64, 57, t);
        const int r = L - 64 * 57, rr = r < 0 ? 0 : r, j = rr % per;
        const int cpn = full ? j : j + 6 + (j >= 2 ? 4 : 0) + (j >= 10 ? 4 : 0);
        const bool isl = L < 64 * 57;
        u.pm = isl ? t.pm : 64 + rr / per; u.pn = isl ? t.pn : cpn; u.sub = 0;
        return isl ? lat : (r < 8 * per); }
    __device__ __forceinline__ const char* a_base(const Unit& u) const { return (const char*)((MK_I8GATE && u.pn >= GT0 ? A8 : A) + (size_t)u.pm * BM * lda); }
    __device__ __forceinline__ const char* b_base(const Unit& u) const { return (const char*)(Bt + (size_t)u.pn * BM * ldb); }
    __device__ __forceinline__ bool is_i8(const Unit& u) const { return MK_I8GATE && u.pn >= GT0; }
    __device__ __forceinline__ bool keep_acc(const Unit&) const { return false; }
    __device__ __forceinline__ int nt(const Unit& u) const { return (MK_I8GATE && u.pn >= GT0) ? K / (2 * BK) : K / BK; }
};
struct ProbMerge {
    const bf16_t* A; const bf16_t* Bt; int lda, ldb, K, nM, nN, G, c;
    __device__ __forceinline__ bool next(int i, Unit& u) const { const int t = i / 3; const bool ok = tile_of((long)t * G + c, nM, nN, u); u.sub = i - 3 * t; return ok; }
    __device__ __forceinline__ const char* a_base(const Unit& u) const { return (const char*)(A + (size_t)u.pm * BM * lda + u.sub * 1024); }
    __device__ __forceinline__ const char* b_base(const Unit& u) const { return (const char*)(Bt + (size_t)u.sub * DM * 1024 + (size_t)u.pn * BM * ldb); }
    __device__ __forceinline__ bool is_i8(const Unit&) const { return false; }
    __device__ __forceinline__ bool keep_acc(const Unit& u) const { return u.sub != 2; }
    __device__ __forceinline__ int nt(const Unit&) const { return K / BK; }
};

template <class Epi, class Prob, int MODE = 0>
__device__ __forceinline__ void gemm_phase(LAS unsigned char* lds, const Prob& S, const Epi& E, const int tid) {
    const int wid = __builtin_amdgcn_readfirstlane(tid >> 6), lane = tid & 63, wr = wid >> 2, wc = wid & 3, fr = lane & 15, fq = lane >> 4;
    unsigned voffA[2], voffB[2];
#pragma unroll
    for (int i = 0; i < 2; ++i) { int R, C; stage_rc(tid * 16 + i * 8192, R, C); const int Rb = Epi::PERM ? ((R & ~31) + perm32(R & 31)) : R;
        voffA[i] = (unsigned)(R * S.lda + C) * 2u; voffB[i] = (unsigned)(Rb * S.ldb + C) * 2u; }
    const size_t kstep = (size_t)(BK * 2);
    const size_t hstepA = (size_t)HALF * S.lda * 2, hstepB = (size_t)HALF * S.ldb * 2;
    const unsigned ldsw = (unsigned)wid * 1024u;
    constexpr unsigned STAGE_BYTES_ = 8u * HTB;
    const int aoff = lds_byte(wr * 64 + fr, fq * 8), boff = lds_byte(wc * 32 + fr, fq * 8);
#define PG8_SA(b, h) (((b) * 2 + (h)) * HTB)
#define PG8_SB(b, h) ((4 + (b) * 2 + (h)) * HTB)
#define PG8_STAGE(bufoff, gbase, voff) do { _Pragma("unroll") for (int _i = 0; _i < 2; ++_i) \
        __builtin_amdgcn_global_load_lds((const unsigned*)((const char*)(gbase) + (voff)[_i]), (LAS unsigned*)(lds + (bufoff) + ldsw + _i * 8192), 16, 0, 0); } while (0)
#define PG8_LDA(dst, b, h) do { _Pragma("unroll") for (int m = 0; m < 4; ++m) _Pragma("unroll") for (int k = 0; k < 2; ++k) dst[m][k] = *(const LAS bf16x8*)(lds + PG8_SA(b, h) + aoff + m * 2048 + k * 1024); } while (0)
#define PG8_LDB(dst, b, h) do { _Pragma("unroll") for (int n = 0; n < 2; ++n) _Pragma("unroll") for (int k = 0; k < 2; ++k) dst[n][k] = *(const LAS bf16x8*)(lds + PG8_SB(b, h) + boff + n * 2048 + k * 1024); } while (0)
#define PG8_MMA_I8(ai, bj, At, Bt) do { __builtin_amdgcn_s_setprio(1); _Pragma("unroll") for (int m = 0; m < 4; ++m) _Pragma("unroll") for (int n = 0; n < 2; ++n) _Pragma("unroll") for (int k = 0; k < 2; ++k) \
        acc[ai][bj][m][n] = __builtin_bit_cast(f32x4, __builtin_amdgcn_mfma_i32_16x16x64_i8(__builtin_bit_cast(i32x4, Bt[n][k]), __builtin_bit_cast(i32x4, At[m][k]), __builtin_bit_cast(i32x4, acc[ai][bj][m][n]), 0, 0, 0)); \
        __builtin_amdgcn_s_setprio(0); } while (0)
#define PG8_MMA_BF(ai, bj, At, Bt) do { __builtin_amdgcn_s_setprio(1); _Pragma("unroll") for (int m = 0; m < 4; ++m) _Pragma("unroll") for (int n = 0; n < 2; ++n) _Pragma("unroll") for (int k = 0; k < 2; ++k) \
        acc[ai][bj][m][n] = __builtin_amdgcn_mfma_f32_16x16x32_bf16(Bt[n][k], At[m][k], acc[ai][bj][m][n], 0, 0, 0); __builtin_amdgcn_s_setprio(0); } while (0)
#define PG8_WAIT_V(n) asm volatile("s_waitcnt vmcnt(" #n ")" ::: "memory")
#define PG8_WAIT_L(n) asm volatile("s_waitcnt lgkmcnt(" #n ")" ::: "memory")
#define PG8_BAR __builtin_amdgcn_s_barrier()
#define PG8_SCHED __builtin_amdgcn_sched_barrier(0)
#define PG8_KLOOP(MMAX) \
        for (int t = 0; t < nt; t += 2) { \
            const bool last = (t == nt - 2); \
            if (Epi::LDSSC && last) E.issue_scales(cur, lds + STAGE_BYTES_ + ldsw - (unsigned)wid * 256u, wr, wc, lane); \
            const char* a1 = cA + (size_t)(t + 1) * kstep; \
            const char* a2 = last ? nA : cA + (size_t)(t + 2) * kstep; const char* b2 = last ? nB : cB + (size_t)(t + 2) * kstep; \
            const char* a3 = a2 + kstep; const char* b3 = b2 + kstep; \
            PG8_LDB(B0, 0, 0); PG8_LDB(B1, 0, 1); PG8_SCHED; PG8_LDA(At, 0, 0); PG8_STAGE(PG8_SA(1, 1), a1 + hstepA, voffA); \
            PG8_WAIT_V(8); PG8_WAIT_L(0); PG8_BAR; MMAX(0, 0, At, B0); MMAX(0, 1, At, B1); PG8_BAR; PG8_SCHED; \
            PG8_LDA(At, 0, 1); PG8_STAGE(PG8_SB(0, 0), b2, voffB); PG8_STAGE(PG8_SB(0, 1), b2 + hstepB, voffB); PG8_STAGE(PG8_SA(0, 0), a2, voffA); \
            PG8_WAIT_V(8); PG8_WAIT_L(0); PG8_BAR; MMAX(1, 0, At, B0); MMAX(1, 1, At, B1); PG8_BAR; PG8_SCHED; \
            PG8_LDB(B0, 1, 0); PG8_LDB(B1, 1, 1); PG8_SCHED; PG8_LDA(At, 1, 0); PG8_STAGE(PG8_SA(0, 1), a2 + hstepA, voffA); \
            PG8_WAIT_V(8); PG8_WAIT_L(0); PG8_BAR; MMAX(0, 0, At, B0); MMAX(0, 1, At, B1); PG8_BAR; PG8_SCHED; \
            PG8_LDA(At, 1, 1); PG8_STAGE(PG8_SB(1, 0), b3, voffB); PG8_STAGE(PG8_SB(1, 1), b3 + hstepB, voffB); PG8_STAGE(PG8_SA(1, 0), a3, voffA); \
            PG8_WAIT_V(8); PG8_WAIT_L(0); PG8_BAR; MMAX(1, 0, At, B0); MMAX(1, 1, At, B1); PG8_BAR; PG8_SCHED; \
        }
    Unit cur, nxt; int ui = 0;
    if (!S.next(0, cur)) return;
    int nt = S.nt(cur); bool i8u = S.is_i8(cur); (void)i8u;
    f32x4 acc[2][2][4][2];
#pragma unroll
    for (int a = 0; a < 2; ++a)
#pragma unroll
        for (int b = 0; b < 2; ++b)
#pragma unroll
            for (int m = 0; m < 4; ++m)
#pragma unroll
                for (int n = 0; n < 2; ++n) acc[a][b][m][n] = (f32x4){0.f, 0.f, 0.f, 0.f};
    bf16x8 At[4][2], B0[2][2], B1[2][2];
    const char* cA = S.a_base(cur); const char* cB = S.b_base(cur);
    PG8_STAGE(PG8_SB(0, 0), cB, voffB); PG8_STAGE(PG8_SB(0, 1), cB + hstepB, voffB); PG8_STAGE(PG8_SA(0, 0), cA, voffA); PG8_STAGE(PG8_SA(0, 1), cA + hstepA, voffA);
    if (wr == 1) PG8_BAR;
    PG8_WAIT_V(2); PG8_BAR;
    PG8_STAGE(PG8_SB(1, 0), cB + kstep, voffB); PG8_STAGE(PG8_SA(1, 0), cA + kstep, voffA); PG8_STAGE(PG8_SB(1, 1), cB + hstepB + kstep, voffB);
    PG8_WAIT_V(6); PG8_BAR;
    for (;;) {
        const bool has_next = S.next(ui + 1, nxt);
        const char* nA = has_next ? S.a_base(nxt) : cA; const char* nB = has_next ? S.b_base(nxt) : cB;
        if (MODE == 1 || (MODE == 2 && i8u)) { PG8_KLOOP(PG8_MMA_I8) } else { PG8_KLOOP(PG8_MMA_BF) }
        if (wr == 0) PG8_BAR;
        E(acc, cur, wr, wc, fr, fq);
        if (!has_next) break;
        if (!S.keep_acc(cur)) {
#pragma unroll
            for (int a = 0; a < 2; ++a)
#pragma unroll
                for (int b = 0; b < 2; ++b)
#pragma unroll
                    for (int m = 0; m < 4; ++m)
#pragma unroll
                        for (int n = 0; n < 2; ++n) acc[a][b][m][n] = (f32x4){0.f, 0.f, 0.f, 0.f};
        }
        cur = nxt; cA = nA; cB = nB; ++ui; nt = S.nt(cur); i8u = S.is_i8(cur);
        if (wr == 1) PG8_BAR;
    }
    PG8_WAIT_V(0);
    PG8_BAR;
#undef PG8_SA
#undef PG8_SB
#undef PG8_STAGE
#undef PG8_LDA
#undef PG8_LDB
#undef PG8_MMA_I8
#undef PG8_MMA_BF
#undef PG8_KLOOP
#undef PG8_WAIT_V
#undef PG8_WAIT_L
#undef PG8_BAR
#undef PG8_SCHED
}

struct RowMap { float* lat; float* ctx;
    __device__ __forceinline__ float* tile(int pm) const { return pm < 64 ? lat + (size_t)pm * 256 * DM : ctx + (size_t)(pm - 64) * 256 * DM; } };

template <bool I8> struct EpiSwiglu {
    static constexpr bool PERM = true;
    static constexpr bool LDSSC = I8;
    bf16_t* O;
    const float* rsc; const float* cmax;
    LAS unsigned char* ldsb;
    __device__ __forceinline__ void issue_scales(const Unit& u, LAS unsigned char* slot, int wr, int wc, int lane) const {
        const float* rp = rsc + u.pm * BM + wr * 64 + lane;
        __builtin_amdgcn_global_load_lds((const unsigned*)rp, (LAS unsigned*)slot, 4, 0, 0);
        __builtin_amdgcn_global_load_lds((const unsigned*)(rp + HALF), (LAS unsigned*)(slot + 256), 4, 0, 0);
        __builtin_amdgcn_global_load_lds((const unsigned*)(cmax + u.pn * BM + (lane >> 5) * HALF + wc * 32 + (lane & 31)), (LAS unsigned*)(slot + 512), 4, 0, 0);
    }
    __device__ __forceinline__ void operator()(f32x4 (&acc)[2][2][4][2], const Unit& u, int wr, int wc, int fr, int fq) const {
        const int row0 = u.pm * BM + wr * 64 + fr, col0 = u.pn * 128 + wc * 32 + 8 * fq;
        const LAS float* sl = (const LAS float*)(ldsb + 8 * HTB + (wr * 4 + wc) * 768);
        f32x4 cs[2][2];
        if (I8) {
#pragma unroll
            for (int bj = 0; bj < 2; ++bj)
#pragma unroll
                for (int n = 0; n < 2; ++n) cs[bj][n] = *(const LAS f32x4*)(sl + 128 + bj * 32 + 8 * fq + 4 * n) * (1.0f / 127.0f);
        }
#pragma unroll
        for (int ai = 0; ai < 2; ++ai)
#pragma unroll
            for (int m = 0; m < 4; ++m) {
                f32x4 g0 = acc[ai][0][m][0], g1 = acc[ai][0][m][1], u0 = acc[ai][1][m][0], u1 = acc[ai][1][m][1], v0, v1;
                if (I8) { const float rs = sl[ai * 64 + 16 * m + fr];
                    const i32x4 ig0 = __builtin_bit_cast(i32x4, g0), ig1 = __builtin_bit_cast(i32x4, g1), iu0 = __builtin_bit_cast(i32x4, u0), iu1 = __builtin_bit_cast(i32x4, u1);
#pragma unroll
                    for (int j = 0; j < 4; ++j) { g0[j] = (float)ig0[j] * rs * cs[0][0][j]; g1[j] = (float)ig1[j] * rs * cs[0][1][j]; u0[j] = (float)iu0[j] * rs * cs[1][0][j]; u1[j] = (float)iu1[j] * rs * cs[1][1][j]; } }
#pragma unroll
                for (int j = 0; j < 4; ++j) { v0[j] = siluf_(g0[j]) * u0[j]; v1[j] = siluf_(g1[j]) * u1[j]; }
                u32x4 w; w.x = cvt_pk_bf16(v0[0], v0[1]); w.y = cvt_pk_bf16(v0[2], v0[3]); w.z = cvt_pk_bf16(v1[0], v1[1]); w.w = cvt_pk_bf16(v1[2], v1[3]);
                *(GAS u32x4*)((GAS bf16_t*)O + (size_t)(row0 + ai * HALF + m * 16) * DFF + col0) = w; }
    }
};
struct EpiResid {
    static constexpr bool LDSSC = false; __device__ __forceinline__ void issue_scales(const Unit&, LAS unsigned char*, int, int, int) const {}
    static constexpr bool PERM = false;
    RowMap base, out; const float* mod; int modidx; float mul; float* slab;
    __device__ __forceinline__ void operator()(f32x4 (&acc)[2][2][4][2], const Unit& u, int wr, int wc, int fr, int fq) const {
        const int r9 = u.pm < 64 ? (u.pm >> 3) : 8;
        const float* sc = mod + (size_t)r9 * (NMOD * DM) + modidx * DM;
        const int rloc = wr * 64 + fr, col0 = u.pn * BM + wc * 32 + 4 * fq;
        const float* bp = base.tile(u.pm); float* op = out.tile(u.pm);
        f32x4 sv[2][2];
#pragma unroll
        for (int bj = 0; bj < 2; ++bj)
#pragma unroll
            for (int n = 0; n < 2; ++n) sv[bj][n] = *(const f32x4*)(sc + col0 + bj * HALF + n * 16) * mul;
        const bool split = u.sub != 0;
        if (split) { op = slab + ((size_t)(u.sub - 1) * NCTXR + (size_t)(u.pm - 64) * 256) * DM; bp = op; }
        const GAS float* bpg = (const GAS float*)bp; GAS float* opg = (GAS float*)op;
#pragma unroll
        for (int ai = 0; ai < 2; ++ai)
#pragma unroll
            for (int mp = 0; mp < 2; ++mp) {
                f32x4 b[2][2][2];
#pragma unroll
                for (int mm = 0; mm < 2; ++mm) { const size_t off = (size_t)(rloc + ai * HALF + (2 * mp + mm) * 16) * DM + col0;
#pragma unroll
                    for (int bj = 0; bj < 2; ++bj)
#pragma unroll
                        for (int n = 0; n < 2; ++n) b[mm][bj][n] = split ? (f32x4){0.f, 0.f, 0.f, 0.f} : *(const GAS f32x4*)(bpg + off + bj * HALF + n * 16); }
#pragma unroll
                for (int mm = 0; mm < 2; ++mm) { const size_t off = (size_t)(rloc + ai * HALF + (2 * mp + mm) * 16) * DM + col0;
#pragma unroll
                    for (int bj = 0; bj < 2; ++bj)
#pragma unroll
                        for (int n = 0; n < 2; ++n) *(GAS f32x4*)(opg + off + bj * HALF + n * 16) = b[mm][bj][n] + sv[bj][n] * acc[ai][bj][2 * mp + mm][n]; }
            }
    }
};
struct EpiP {
    static constexpr bool LDSSC = false; __device__ __forceinline__ void issue_scales(const Unit&, LAS unsigned char*, int, int, int) const {}
    static constexpr bool PERM = true;
    bf16_t* O; int ldc;
    __device__ __forceinline__ void operator()(f32x4 (&acc)[2][2][4][2], const Unit& u, int wr, int wc, int fr, int fq) const {
        char* bu = (char*)(O + (size_t)(u.pm * BM + wr * 64) * ldc + u.pn * BM + wc * 32);
        const unsigned lo = (unsigned)(fr * ldc + 8 * fq) * 2u, s_m = (unsigned)(16 * ldc) * 2u, s_ai = (unsigned)(HALF * ldc) * 2u, s_bj = (unsigned)HALF * 2u;
#pragma unroll
        for (int ai = 0; ai < 2; ++ai)
#pragma unroll
            for (int m = 0; m < 4; ++m)
#pragma unroll
                for (int bj = 0; bj < 2; ++bj) { const f32x4 v0 = acc[ai][bj][m][0], v1 = acc[ai][bj][m][1];
                    u32x4 w; w.x = cvt_pk_bf16(v0[0], v0[1]); w.y = cvt_pk_bf16(v0[2], v0[3]); w.z = cvt_pk_bf16(v1[0], v1[1]); w.w = cvt_pk_bf16(v1[2], v1[3]);
                    *(u32x4*)(bu + (size_t)(ai * s_ai + m * s_m + bj * s_bj) + lo) = w; }
    }
};
struct EpiGate {
    static constexpr bool LDSSC = false; __device__ __forceinline__ void issue_scales(const Unit&, LAS unsigned char*, int, int, int) const {}
    static constexpr bool PERM = true;
    bf16_t* G; const float* rsc; const float* cmax;
    __device__ __forceinline__ void operator()(f32x4 (&acc)[2][2][4][2], const Unit& u, int wr, int wc, int fr, int fq) const {
        char* bu = (char*)(G + ((size_t)((u.pm * 24 + (u.pn - GT0)) * 8 + wr * 4 + wc) * 16) * 512);
        const unsigned lo = (unsigned)(fq * 16 + fr) * 16u;
        const float* cm = cmax + (u.pn - GT0) * BM + wc * 32 + 8 * fq;
        const float* rp = rsc + u.pm * BM + wr * 64 + fr;
        f32x4 cs[2][2];
#pragma unroll
        for (int bj = 0; bj < 2; ++bj) { cs[bj][0] = *(const f32x4*)(cm + bj * HALF) * (1.0f / 127.0f); cs[bj][1] = *(const f32x4*)(cm + bj * HALF + 4) * (1.0f / 127.0f); }
#pragma unroll
        for (int ai = 0; ai < 2; ++ai)
#pragma unroll
            for (int m = 0; m < 4; ++m) { const float rs = rp[ai * HALF + m * 16];
#pragma unroll
                for (int bj = 0; bj < 2; ++bj) { const i32x4 i0 = __builtin_bit_cast(i32x4, acc[ai][bj][m][0]), i1 = __builtin_bit_cast(i32x4, acc[ai][bj][m][1]); f32x4 v0, v1;
#pragma unroll
                    for (int j = 0; j < 4; ++j) { if (MK_I8GATE) { v0[j] = sigmoidf_((float)i0[j] * rs * cs[bj][0][j]); v1[j] = sigmoidf_((float)i1[j] * rs * cs[bj][1][j]); } else { v0[j] = sigmoidf_(acc[ai][bj][m][0][j]); v1[j] = sigmoidf_(acc[ai][bj][m][1][j]); } }
                    u32x4 w; w.x = cvt_pk_bf16(v0[0], v0[1]); w.y = cvt_pk_bf16(v0[2], v0[3]); w.z = cvt_pk_bf16(v1[0], v1[1]); w.w = cvt_pk_bf16(v1[2], v1[3]);
                    *(u32x4*)(bu + (size_t)(ai * 8 + m * 2 + bj) * 1024 + lo) = w; } }
    }
};
struct EpiP57 {
    static constexpr bool LDSSC = false; __device__ __forceinline__ void issue_scales(const Unit&, LAS unsigned char*, int, int, int) const {}
    static constexpr bool PERM = true;
    bf16_t* O; int ldc; bf16_t* G; const float* rsc; const float* cmax;
    __device__ __forceinline__ void operator()(f32x4 (&acc)[2][2][4][2], const Unit& u, int wr, int wc, int fr, int fq) const {
        const bool gate = u.pn >= GT0;
        char* bu = gate ? (char*)(G + ((size_t)((u.pm * 24 + (u.pn - GT0)) * 8 + wr * 4 + wc) * 16) * 512)
                        : (char*)(O + (size_t)(u.pm * BM + wr * 64) * ldc + u.pn * BM + wc * 32);
        const unsigned lo = gate ? (unsigned)(fq * 16 + fr) * 16u : (unsigned)(fr * ldc + 8 * fq) * 2u;
        const unsigned s_m = gate ? 2u * 1024u : (unsigned)(16 * ldc) * 2u, s_ai = gate ? 8u * 1024u : (unsigned)(HALF * ldc) * 2u, s_bj = gate ? 1024u : (unsigned)HALF * 2u;
        f32x4 cs[2][2];
        if (MK_I8GATE && gate) { const float* cm = cmax + (u.pn - GT0) * BM + wc * 32 + 8 * fq;
#pragma unroll
            for (int bj = 0; bj < 2; ++bj) { cs[bj][0] = *(const f32x4*)(cm + bj * HALF) * (1.0f / 127.0f); cs[bj][1] = *(const f32x4*)(cm + bj * HALF + 4) * (1.0f / 127.0f); } }
        const float* rp = rsc + u.pm * BM + wr * 64 + fr;
#pragma unroll
        for (int ai = 0; ai < 2; ++ai)
#pragma unroll
            for (int m = 0; m < 4; ++m) { float rs = 1.0f; if (MK_I8GATE && gate) rs = rp[ai * HALF + m * 16];
#pragma unroll
                for (int bj = 0; bj < 2; ++bj) { f32x4 v0 = acc[ai][bj][m][0], v1 = acc[ai][bj][m][1];
                    if (gate) {
                        if (MK_I8GATE) { const i32x4 i0 = __builtin_bit_cast(i32x4, v0), i1 = __builtin_bit_cast(i32x4, v1);
#pragma unroll
                            for (int j = 0; j < 4; ++j) { v0[j] = (float)i0[j] * rs * cs[bj][0][j]; v1[j] = (float)i1[j] * rs * cs[bj][1][j]; } }
#pragma unroll
                        for (int j = 0; j < 4; ++j) { v0[j] = sigmoidf_(v0[j]); v1[j] = sigmoidf_(v1[j]); } }
                    u32x4 w; w.x = cvt_pk_bf16(v0[0], v0[1]); w.y = cvt_pk_bf16(v0[2], v0[3]); w.z = cvt_pk_bf16(v1[0], v1[1]); w.w = cvt_pk_bf16(v1[2], v1[3]);
                    *(u32x4*)(bu + (size_t)(ai * s_ai + m * s_m + bj * s_bj) + lo) = w; } }
    }
};
struct EpiKV {
    static constexpr bool LDSSC = false; __device__ __forceinline__ void issue_scales(const Unit&, LAS unsigned char*, int, int, int) const {}
    static constexpr bool PERM = true;
    bf16_t* Kb; bf16_t* Vb;
    __device__ __forceinline__ void operator()(f32x4 (&acc)[2][2][4][2], const Unit& u, int wr, int wc, int fr, int fq) const {
        const int kv0 = u.pm < 64 ? (u.pm >> 3) * KVROWS + CTX + (u.pm & 7) * 256 : (u.pm - 64) * KVROWS;
        const bool isk = u.pn < 4;
        const int ld = isk ? 1536 : 1024, bjs = isk ? 192 : 128;
        bf16_t* dst = (isk ? Kb + u.pn * 384 : Vb + (u.pn - 4) * 256) + (size_t)(kv0 + wr * 64 + fr) * ld + wc * 32 + 8 * fq;
#pragma unroll
        for (int ai = 0; ai < 2; ++ai)
#pragma unroll
            for (int m = 0; m < 4; ++m)
#pragma unroll
                for (int bj = 0; bj < 2; ++bj) { const f32x4 v0 = acc[ai][bj][m][0], v1 = acc[ai][bj][m][1];
                    u32x4 w; w.x = cvt_pk_bf16(v0[0], v0[1]); w.y = cvt_pk_bf16(v0[2], v0[3]); w.z = cvt_pk_bf16(v1[0], v1[1]); w.w = cvt_pk_bf16(v1[2], v1[3]);
                    *(u32x4*)(dst + (size_t)(ai * HALF + m * 16) * ld + bj * bjs) = w; }
    }
};
struct EpiMerge {
    static constexpr bool LDSSC = false; __device__ __forceinline__ void issue_scales(const Unit&, LAS unsigned char*, int, int, int) const {}
    static constexpr bool PERM = true;
    const bf16_t* G; bf16_t* O;
    __device__ __forceinline__ void operator()(f32x4 (&acc)[2][2][4][2], const Unit& u, int wr, int wc, int fr, int fq) const {
        const int row0 = u.pm * BM + wr * 64 + fr, col0 = u.pn * BM + wc * 32 + 8 * fq;
        const bf16_t* gp = G + ((size_t)((u.pm * 24 + u.sub * 8 + u.pn) * 8 + wr * 4 + wc) * 16) * 512 + (fq * 16 + fr) * 8;
        constexpr size_t NEXTB = (size_t)8 * 8 * 16 * 512;
#pragma unroll
        for (int ai = 0; ai < 2; ++ai)
#pragma unroll
            for (int m = 0; m < 4; ++m) { const size_t row = (size_t)(row0 + ai * HALF + m * 16);
#pragma unroll
                for (int bj = 0; bj < 2; ++bj) {
                    const bf16_t* gq = gp + ((ai * 4 + m) * 2 + bj) * 512;
                    const u32x4 ga = *(const u32x4*)gq;
                    float f[8] = {lo16(ga.x), hi16(ga.x), lo16(ga.y), hi16(ga.y), lo16(ga.z), hi16(ga.z), lo16(ga.w), hi16(ga.w)};
                    if (u.sub != 2) { const u32x4 gb = *(const u32x4*)(gq + NEXTB);
                        const float d[8] = {lo16(gb.x), hi16(gb.x), lo16(gb.y), hi16(gb.y), lo16(gb.z), hi16(gb.z), lo16(gb.w), hi16(gb.w)};
#pragma unroll
                        for (int j = 0; j < 8; ++j) f[j] = f[j] * fast_rcp(fmaxf(d[j], 1e-20f)); }
                    f32x4 v0 = acc[ai][bj][m][0], v1 = acc[ai][bj][m][1];
#pragma unroll
                    for (int j = 0; j < 4; ++j) { v0[j] *= f[j]; v1[j] *= f[4 + j]; }
                    acc[ai][bj][m][0] = v0; acc[ai][bj][m][1] = v1;
                    if (u.sub == 2) { u32x4 w; w.x = cvt_pk_bf16(v0[0], v0[1]); w.y = cvt_pk_bf16(v0[2], v0[3]); w.z = cvt_pk_bf16(v1[0], v1[1]); w.w = cvt_pk_bf16(v1[2], v1[3]);
                        *(u32x4*)(O + row * DM + col0 + bj * HALF) = w; } } }
    }
};
}

#define XB_TMO      128
#define XB_XCNT(j)  (256  + 64 * (j))
#define XB_XSUB(j)  (1280 + 64 * (j))
#define XB_XGEN(j)  (2304 + 64 * (j))
#define XB_TOP      3328
#define XB_TOPGEN   3392
#define XCD_BAR_WORDS 3456
#define XB_SPIN_CAP (1u << 22)
__device__ __forceinline__ unsigned xb_ld(unsigned* p)              { return __hip_atomic_load(p, __ATOMIC_RELAXED, __HIP_MEMORY_SCOPE_AGENT); }
__device__ __forceinline__ unsigned xb_add(unsigned* p, unsigned v) { return __hip_atomic_fetch_add(p, v, __ATOMIC_RELAXED, __HIP_MEMORY_SCOPE_AGENT); }
__device__ __forceinline__ unsigned xb_xcc_id() { return (unsigned)__builtin_amdgcn_s_getreg((3 << 11) | 20) & 0xFu; }
#define XB_SPIN(cond, bar) do { unsigned _sp = 0; while (cond) { __builtin_amdgcn_s_sleep(1); \
    if ((++_sp & 255u) == 0u) { if (xb_ld(&(bar)[XB_TMO])) break; if (_sp > XB_SPIN_CAP) { atomicAdd(&(bar)[XB_TMO], 1u); break; } } } } while (0)
struct XcdBarrier { unsigned* bar; unsigned x; volatile LAS unsigned* st; };
__device__ __forceinline__ XcdBarrier xcd_barrier_post(unsigned* bar, volatile LAS unsigned* st) {
    XcdBarrier b; b.bar = bar; b.x = xb_xcc_id(); b.st = st;
    if (threadIdx.x == 0) (void)xb_add(&bar[XB_XCNT(b.x)], 1u);
    return b;
}
__device__ __forceinline__ void xcd_barrier_complete(unsigned* bar, unsigned x, unsigned& nloc, unsigned& nx) {
    const unsigned G = gridDim.x * gridDim.y * gridDim.z;
    unsigned sum, cnt, mine, sp = 0u;
    for (;;) {
        sum = 0u; cnt = 0u; mine = 0u;
#pragma unroll
        for (unsigned j = 0; j < 16; ++j) { const unsigned c = xb_ld(&bar[XB_XCNT(j)]); sum += c; cnt += (c > 0u) ? 1u : 0u; mine = (j == x) ? c : mine; }
        if (sum == G) break;
        __builtin_amdgcn_s_sleep(1);
        if ((++sp & 255u) == 0u) { if (xb_ld(&bar[XB_TMO])) break; if (sp > XB_SPIN_CAP) { atomicAdd(&bar[XB_TMO], 1u); break; } }
    }
    nloc = mine > 0u ? mine : 1u; nx = cnt > 0u ? cnt : 1u;
}
__device__ __forceinline__ void xcd_barrier(const XcdBarrier& b) {
    asm volatile("s_waitcnt vmcnt(0)" ::: "memory");
    __syncthreads();
    if (threadIdx.x == 0) {
        unsigned* bar = b.bar;
        __builtin_amdgcn_s_waitcnt(0);
        unsigned nloc = b.st[0], nx = b.st[1];
        if (nloc == 0u) { xcd_barrier_complete(bar, b.x, nloc, nx); b.st[0] = nloc; b.st[1] = nx; }
        const unsigned old = xb_add(&bar[XB_XSUB(b.x)], 1u);
        const unsigned gen = old / nloc;
        if (old + 1u == (gen + 1u) * nloc) {
            __builtin_amdgcn_fence(__ATOMIC_RELEASE, "agent");
            asm volatile("s_waitcnt vmcnt(0)" ::: "memory");
            const unsigned og = xb_add(&bar[XB_TOP], 1u);
            const unsigned tg = og / nx;
            if (og + 1u == (tg + 1u) * nx) xb_add(&bar[XB_TOPGEN], 1u);
            else XB_SPIN(xb_ld(&bar[XB_TOPGEN]) == tg, bar);
            __builtin_amdgcn_fence(__ATOMIC_ACQUIRE, "agent");
            xb_add(&bar[XB_XGEN(b.x)], 1u);
            asm volatile("s_waitcnt vmcnt(0)" ::: "memory");
        } else {
            XB_SPIN(xb_ld(&bar[XB_XGEN(b.x)]) == gen, bar);
            __builtin_amdgcn_fence(__ATOMIC_ACQUIRE, "agent");
            asm volatile("s_waitcnt vmcnt(0)" ::: "memory");
        }
    }
    __syncthreads();
}

struct Args { const float* in[30]; float* out; unsigned char* ws; int st_lo, st_hi; };
enum { I_X = 0, I_C, I_CTX, I_CCTX, I_WADA, I_BADA, I_NORMG, I_F1G, I_F1U, I_F1D, I_F2G, I_F2U, I_F2D, I_WIN, I_KVG, I_WUK, I_WUV, I_QG, I_KG, I_CONVW, I_CONVB, I_ALOG, I_DTB, I_SSDD, I_SSDG, I_NAQG, I_NAKG, I_RPB, I_WBR, I_WOUT };

constexpr int GRID = 256;
struct Frame {
    LAS unsigned char* lds; int tid, lane, wave, bid; static constexpr int G = GRID;
    const float* const* in; float* out; unsigned char* ws;
    __device__ __forceinline__ bf16_t* wsb(size_t off) const { return (bf16_t*)(ws + off); }
    __device__ __forceinline__ float* wsf(size_t off) const { return (float*)(ws + off); }
};

__device__ __forceinline__ int row_r9(int row) { return row < NLAT ? (row >> 11) : 8; }
__device__ __forceinline__ int row_kv(int row) { return row < NLAT ? (row >> 11) * KVROWS + CTX + (row & 2047) : ((row - NLAT) >> 8) * KVROWS + ((row - NLAT) & 255); }

__device__ __forceinline__ void transpose_item(const float* W, int N, int src_n0, bf16_t* WT, int ldt, int dst_n0, int k0, LAS float* scr, int lane) {
    if (src_n0 >= 0) {
        const GAS float* src = (const GAS float*)W + (size_t)(k0 + (lane >> 3)) * N + src_n0 + 4 * (lane & 7);
        f32x4 v[8];
#pragma unroll
        for (int i = 0; i < 8; ++i) v[i] = *(const GAS f32x4*)(src + (size_t)(8 * i) * N);
#pragma unroll
        for (int i = 0; i < 8; ++i) { LAS float* d = scr + (8 * i + (lane >> 3)) * 33 + 4 * (lane & 7); d[0] = v[i].x; d[1] = v[i].y; d[2] = v[i].z; d[3] = v[i].w; }
    } else {
#pragma unroll 8
        for (int i = 0; i < 32; ++i) { const int kk = 2 * i + (lane >> 5); scr[kk * 33 + (lane & 31)] = 0.f; }
    }
    LDS_WAIT(); asm volatile("" ::: "memory");
    const int c = lane & 7;
#pragma unroll
    for (int j = 0; j < 4; ++j) { const int n = (lane >> 3) + 8 * j; const LAS float* s = scr + (8 * c) * 33 + n;
        u32x4 o; o.x = pk2(s[0 * 33], s[1 * 33]); o.y = pk2(s[2 * 33], s[3 * 33]); o.z = pk2(s[4 * 33], s[5 * 33]); o.w = pk2(s[6 * 33], s[7 * 33]);
        *(GAS u32x4*)(WT + (size_t)(dst_n0 + n) * ldt + k0 + 8 * c) = o; }
    LDS_WAIT(); asm volatile("" ::: "memory");
}
__device__ __forceinline__ int win_src_col(int n) {
    if (n < 2048) return n;
    if (n < 5120) return n + 64;
    if (n < 8192) return n + 96;
    if (n < 8256) return n - 6144;
    if (n < 8288) return n - 3072;
    if (n < 8448) return -1;
    return n - 160;
}
__device__ __forceinline__ void absmax_item(const float* W, int N, int src_n0, unsigned* cmax, int k0, int lane) {
    float m = 0.f;
#pragma unroll 8
    for (int i = 0; i < 32; ++i) { const int kk = 2 * i + (lane >> 5); m = fmaxf(m, fabsf(W[(size_t)(k0 + kk) * N + src_n0 + (lane & 31)])); }
    m = fmaxf(m, __shfl_xor(m, 32));
    if (lane < 32) atomicMax(cmax + lane, __float_as_uint(m));
}
__device__ __forceinline__ void quant_item(const float* W, int N, int src_n0, unsigned char* WT8, int dst_n0, int k0, const unsigned* cmax, LAS float* scr, int lane) {
#pragma unroll 8
    for (int i = 0; i < 32; ++i) { const int kk = 2 * i + (lane >> 5); scr[kk * 33 + (lane & 31)] = W[(size_t)(k0 + kk) * N + src_n0 + (lane & 31)]; }
    LDS_WAIT(); asm volatile("" ::: "memory");
    const int c = lane & 3;
#pragma unroll
    for (int j = 0; j < 2; ++j) { const int n = (lane >> 2) + 16 * j; const float mx = __uint_as_float(cmax[n]), inv = mx > 0.f ? 127.0f / mx : 0.f;
        const LAS float* sp = scr + (16 * c) * 33 + n; unsigned w[4];
#pragma unroll
        for (int d = 0; d < 4; ++d) { unsigned x = 0;
#pragma unroll
            for (int e = 0; e < 4; ++e) { int q = __float2int_rn(sp[(4 * d + e) * 33] * inv); q = q > 127 ? 127 : (q < -127 ? -127 : q); x |= ((unsigned)q & 255u) << (8 * e); }
            w[d] = x; }
        *(GAS u32x4*)(WT8 + (size_t)(dst_n0 + n) * 4096 + k0 + 16 * c) = (u32x4){w[0], w[1], w[2], w[3]}; }
    LDS_WAIT(); asm volatile("" ::: "memory");
}
__device__ __forceinline__ void quant_block(const Frame& F, const float* W, int N, int src_n0, unsigned char* WT8, int dst_n0, float* cmax_out) {
    constexpr int QP = 4104;
    LAS unsigned char* LT = F.lds; LAS float* red = (LAS float*)(F.lds + 32 * QP); LAS float* cml = red + 256;
    int tq = F.tid; asm volatile("" : "+v"(tq));
    const int lane = tq & 63, n = lane & 31, kp = lane >> 5;
    __syncthreads();
    {
        (void)n; (void)kp;
        const int c4 = lane & 7, kr = lane >> 3;
        const GAS float* src = (const GAS float*)W + (size_t)(F.wave * 256 + kr) * N + src_n0 + 4 * c4;
        LAS unsigned char* lcol = LT + (4 * c4) * QP + (F.wave * 256 + kr) * 2;
        float m0 = 0.f, m1 = 0.f, m2 = 0.f, m3 = 0.f;
#pragma unroll 1
        for (int i0 = 0; i0 < 32; i0 += 16) { f32x4 v[16];
#pragma unroll
            for (int j = 0; j < 16; ++j) v[j] = *(const GAS f32x4*)(src + (size_t)(8 * (i0 + j)) * N);
#pragma unroll
            for (int j = 0; j < 16; ++j) { m0 = fmaxf(m0, fabsf(v[j].x)); m1 = fmaxf(m1, fabsf(v[j].y)); m2 = fmaxf(m2, fabsf(v[j].z)); m3 = fmaxf(m3, fabsf(v[j].w));
                LAS unsigned char* d = lcol + 16 * (i0 + j);
                *(LAS bf16_t*)(d) = (bf16_t)(pk2(v[j].x, v[j].x) & 0xffffu); *(LAS bf16_t*)(d + QP) = (bf16_t)(pk2(v[j].y, v[j].y) & 0xffffu);
                *(LAS bf16_t*)(d + 2 * QP) = (bf16_t)(pk2(v[j].z, v[j].z) & 0xffffu); *(LAS bf16_t*)(d + 3 * QP) = (bf16_t)(pk2(v[j].w, v[j].w) & 0xffffu); } }
#pragma unroll
        for (int o = 8; o < 64; o <<= 1) { m0 = fmaxf(m0, __shfl_xor(m0, o)); m1 = fmaxf(m1, __shfl_xor(m1, o)); m2 = fmaxf(m2, __shfl_xor(m2, o)); m3 = fmaxf(m3, __shfl_xor(m3, o)); }
        if (lane < 8) { LAS float* r = red + F.wave * 32 + 4 * lane; r[0] = m0; r[1] = m1; r[2] = m2; r[3] = m3; }
    }
    __syncthreads();
    if (tq < 32) { float mx = red[tq];
#pragma unroll
        for (int w = 1; w < 8; ++w) mx = fmaxf(mx, red[w * 32 + tq]);
        cml[tq] = mx; cmax_out[tq] = mx; }
    __syncthreads();
    {   const int nn = tq >> 4, c = tq & 15; const float mx = cml[nn], inv = mx > 0.f ? 127.0f / mx : 0.f;
        const LAS unsigned char* lr = LT + nn * QP; unsigned char* orow = WT8 + (size_t)(dst_n0 + nn) * 4096;
#pragma unroll
        for (int j = 0; j < 8; ++j) { const int k0 = (c + 16 * j) * 16; unsigned w4[4];
#pragma unroll
            for (int d = 0; d < 4; ++d) { const u32x2 pr = *(const LAS u32x2*)(lr + k0 * 2 + d * 8);
                int q0 = __float2int_rn(lo16(pr.x) * inv), q1 = __float2int_rn(hi16(pr.x) * inv), q2 = __float2int_rn(lo16(pr.y) * inv), q3 = __float2int_rn(hi16(pr.y) * inv);
                w4[d] = ((unsigned)q0 & 255u) | (((unsigned)q1 & 255u) << 8) | (((unsigned)q2 & 255u) << 16) | ((unsigned)q3 << 24); }
            *(GAS u32x4*)(orow + k0) = (u32x4){w4[0], w4[1], w4[2], w4[3]}; }
    }
}
__device__ __forceinline__ void phase_convert(const Frame& F, int l) {
    const int gw = F.bid * 8 + F.wave, NGW = F.G * 8;
    constexpr int I_GU = 32 * 352, I_DN = 88 * 64, I_IN = 32 * 456, I_UKV = 8 * 64, I_BR = 16 * 64, I_OUT = 32 * 64;
    constexpr int NITEMS = 2 * I_GU + 2 * I_DN + I_IN + I_UKV + 3 * I_BR + I_OUT;
    const size_t ffo = (size_t)l * DM * DFF;
    float* CM = (float*)(F.ws + WS_CMAX) + (size_t)l * NQCOL;
    {   constexpr int QB = (MK_I8GU ? 704 : 0) + (MK_I8GATE ? 192 : 0);
        for (int qi = F.bid; qi < QB; qi += F.G) { int r = qi;
            if (MK_I8GU && r < 704) { const int s = r >= 352 ? 1 : 0, nb = r - s * 352, pn = nb >> 3, jb = nb & 7;
                const float* W = F.in[(s ? I_F2G : I_F1G) + (jb >= 4 ? 1 : 0)] + ffo;
                quant_block(F, W, DFF, pn * 128 + (jb & 3) * 32, F.ws + (s ? WS_WGU2 : WS_WGU1), nb * 32, CM + s * 11264 + nb * 32); continue; }
            if (MK_I8GU) r -= 704;
            { const int nb = 264 + r;
              quant_block(F, F.in[I_WIN] + (size_t)l * DM * DIN, DIN, win_src_col(nb * 32), F.ws + WS_WIN, nb * 32, CM + 22528 + (nb - 264) * 32); } }
        __syncthreads();
    }
    LAS float* scr = (LAS float*)(F.lds + F.wave * 16384);
    for (int it = gw; it < NITEMS; it += NGW) {
        int r = it;
        if (r < 2 * I_GU) { if (MK_I8GU) continue; const int s = r >= I_GU; r -= s * I_GU; const int kb = r / 352, nb = r % 352, pn = nb >> 3, jb = nb & 7;
            const float* W = F.in[(s ? I_F2G : I_F1G) + (jb >= 4 ? 1 : 0)] + ffo;
            transpose_item(W, DFF, pn * 128 + (jb & 3) * 32, F.wsb(s ? WS_WGU2 : WS_WGU1), DM, nb * 32, kb * 64, scr, F.lane);
            continue; }
        r -= 2 * I_GU;
        if (r < 2 * I_DN) { const int s = r >= I_DN; r -= s * I_DN; const int kb = r / 64, nb = r % 64;
            transpose_item(F.in[s ? I_F2D : I_F1D] + ffo, DM, nb * 32, F.wsb(s ? WS_WDN2 : WS_WDN1), DFF, nb * 32, kb * 64, scr, F.lane); continue; }
        r -= 2 * I_DN;
        if (r < I_IN) { const int kb = r / 456, nb = r % 456;
            if (MK_I8GATE && nb >= 264) continue;
            transpose_item(F.in[I_WIN] + (size_t)l * DM * DIN, DIN, win_src_col(nb * 32), F.wsb(WS_WIN), DM, nb * 32, kb * 64, scr, F.lane);
            continue; }
        r -= I_IN;
        if (r < I_UKV) { const int kb = r / 64, nb = r % 64;
            transpose_item(F.in[nb < 32 ? I_WUK : I_WUV] + (size_t)l * 512 * 1024, 1024, (nb & 31) * 32, F.wsb(WS_WUKV), 512, nb * 32, kb * 64, scr, F.lane); continue; }
        r -= I_UKV;
        if (r < 3 * I_BR) { const int i = r / I_BR; r -= i * I_BR; const int kb = r / 64, nb = r % 64;
            transpose_item(F.in[I_WBR] + ((size_t)l * 3 + i) * 1024 * DM, DM, nb * 32, F.wsb(WS_WBR) + (size_t)i * DM * 1024, 1024, nb * 32, kb * 64, scr, F.lane); continue; }
        r -= 3 * I_BR;
        { const int kb = r / 64, nb = r % 64;
            transpose_item(F.in[I_WOUT] + (size_t)l * DM * DM, DM, nb * 32, F.wsb(WS_WOUT), DM, nb * 32, kb * 64, scr, F.lane); }
    }
}

__device__ __forceinline__ void phase_adaln(const Frame& F) {
    LAS float* sc = (LAS float*)F.lds;
    LAS float* red = (LAS float*)(F.lds + 16384);
    float* MOD = F.wsf(WS_MOD);
    if (F.bid == 0) {
        for (int i = F.tid; i < 1024; i += 512) { const int pos = i >> 4, f = i & 15;
            const float inv = fast_exp2(-(float)f * (13.287712379549449f / 16.0f)); const float ang = (float)pos * inv;
            ((f32x2*)F.wsf(WS_ROPE))[i] = (f32x2){cosf(ang), sinf(ang)}; }
    }
    for (int it = F.bid; it < 2 * 72 * 8; it += F.G) {
        const int l = it / 576, r0 = it % 576, cb = r0 >> 3, ks = r0 & 7, k0 = ks * 256, col0 = cb * 256;
        __syncthreads();
        for (int i = F.tid; i < 9 * 256; i += 512) { const int r = i >> 8, k = i & 255;
            const float c = r < 8 ? F.in[I_C][r * DM + k0 + k] : F.in[I_CCTX][k0 + k]; sc[i] = siluf_(c) ; }
        __syncthreads();
        const float* W = F.in[I_WADA] + ((size_t)l * DM + k0 + F.wave * 32) * (NMOD * DM) + col0 + 4 * F.lane;
        f32x4 acc[9];
#pragma unroll
        for (int r = 0; r < 9; ++r) acc[r] = (f32x4){0.f, 0.f, 0.f, 0.f};
#pragma unroll 4
        for (int kk = 0; kk < 32; ++kk) { const f32x4 w = *(const f32x4*)(W + (size_t)kk * (NMOD * DM));
#pragma unroll
            for (int r = 0; r < 9; ++r) acc[r] += w * sc[r * 256 + F.wave * 32 + kk]; }
#pragma unroll
        for (int r = 0; r < 9; ++r) *(LAS f32x4*)(red + (F.wave * 9 + r) * 256 + 4 * F.lane) = acc[r];
        __syncthreads();
        for (int i = F.tid; i < 9 * 256; i += 512) { float s = 0.f;
#pragma unroll
            for (int w = 0; w < 8; ++w) s += red[w * 2304 + i];
            const int r = i >> 8, j = col0 + (i & 255);
            if (ks == 0) s += F.in[I_BADA][(size_t)l * (NMOD * DM) + j];
            atomicAdd(MOD + ((size_t)l * 9 + r) * (NMOD * DM) + j, s); }
    }
}

__device__ __forceinline__ void phase_norm(const Frame& F, const float* lat, const float* ctx, const float* g, const float* mod, int base, bf16_t* U, int nrows, float* hcw, const float* slab, unsigned char* U8, float* rsc) {
    const int gw = F.bid * 8 + F.wave, NGW = F.G * 8;
    static_assert(NLAT == 8 * GRID * 8 && NCTXR == GRID * 8, "row deal of phase_norm");
    const int per = nrows > NLAT ? 9 : 8; (void)NGW;
    f32x4 ga[8], sh[8]; int cur = -1;
    for (int i = 0; i < per; ++i) {
        const int row = i < 8 ? gw * 8 + i : NLAT + gw;
        const int r9 = row_r9(row);
        if (r9 != cur) { cur = r9; const float* ms = mod + (size_t)r9 * (NMOD * DM) + base * DM;
#pragma unroll
            for (int j = 0; j < 8; ++j) { const int c = 4 * F.lane + 256 * j; const f32x4 gg = *(const f32x4*)(g + c), scl = *(const f32x4*)(ms + DM + c); sh[j] = *(const f32x4*)(ms + c); ga[j] = gg * (scl + 1.0f); } }
        const float* xr = row < NLAT ? lat + (size_t)row * DM : ctx + (size_t)(row - NLAT) * DM;
        f32x4 v[8]; float s = 0.f;
#pragma unroll
        for (int j = 0; j < 8; ++j) v[j] = *(const f32x4*)(xr + 4 * F.lane + 256 * j);
        if (row >= NLAT && hcw) {
            if (slab) {
#pragma unroll
                for (int q = 0; q < 4; ++q) { const float* sp = slab + ((size_t)q * NCTXR + (row - NLAT)) * DM + 4 * F.lane;
#pragma unroll
                    for (int j = 0; j < 8; ++j) v[j] += *(const f32x4*)(sp + 256 * j); } }
            float* hw = hcw + (size_t)(row - NLAT) * DM + 4 * F.lane;
#pragma unroll
            for (int j = 0; j < 8; ++j) *(f32x4*)(hw + 256 * j) = v[j];
        }
#pragma unroll
        for (int j = 0; j < 8; ++j) s += (v[j].x * v[j].x + v[j].y * v[j].y) + (v[j].z * v[j].z + v[j].w * v[j].w);
        const float rs = rsqrtf(wave_sum(s) * (1.0f / DM) + EPS);
        float amax = 0.f;
#pragma unroll
        for (int j = 0; j < 8; ++j) { v[j] = v[j] * rs * ga[j] + sh[j]; amax = fmaxf(fmaxf(amax, fmaxf(fabsf(v[j].x), fabsf(v[j].y))), fmaxf(fabsf(v[j].z), fabsf(v[j].w))); }
        if (U) { bf16_t* o = U + (size_t)row * DM;
#pragma unroll
            for (int j = 0; j < 8; ++j) { u32x2 w; w.x = pk2(v[j].x, v[j].y); w.y = pk2(v[j].z, v[j].w); *(u32x2*)(o + 4 * F.lane + 256 * j) = w; } }
        if (U8) {
#pragma unroll
            for (int o = 1; o < 64; o <<= 1) amax = fmaxf(amax, __shfl_xor(amax, o));
            const float inv = amax > 0.f ? 127.0f / amax : 0.f;
            unsigned* o8 = (unsigned*)(U8 + (size_t)row * 4096);
#pragma unroll
            for (int j = 0; j < 8; ++j) { const int q0 = __float2int_rn(v[j].x * inv), q1 = __float2int_rn(v[j].y * inv), q2 = __float2int_rn(v[j].z * inv), q3 = __float2int_rn(v[j].w * inv);
                o8[F.lane + 64 * j] = ((unsigned)q0 & 255u) | (((unsigned)q1 & 255u) << 8) | (((unsigned)q2 & 255u) << 16) | ((unsigned)q3 << 24); }
            if (F.lane == 0) rsc[row] = amax * (1.0f / 127.0f);
        }
    }
}

__device__ __forceinline__ void norm192_rope(float (&nope)[16], float (&x1)[4], float (&x2)[4], const float* g, const f32x2* rope, bool lat, int t, int p, float scale) {
    float ss = 0.f;
#pragma unroll
    for (int i = 0; i < 16; ++i) ss += nope[i] * nope[i];
#pragma unroll
    for (int i = 0; i < 4; ++i) ss += x1[i] * x1[i] + x2[i] * x2[i];
    ss += __shfl_xor(ss, 1); ss += __shfl_xor(ss, 2); ss += __shfl_xor(ss, 4);
    const float rs = rsqrtf(ss * (1.0f / 192.0f) + EPS);
    const int a = p >> 2, f0 = (p & 3) * 4;
#pragma unroll
    for (int i = 0; i < 16; ++i) nope[i] = nope[i] * rs * g[p * 16 + i] * scale;
#pragma unroll
    for (int i = 0; i < 4; ++i) { x1[i] = x1[i] * rs * g[128 + a * 32 + f0 + i]; x2[i] = x2[i] * rs * g[128 + a * 32 + 16 + f0 + i]; }
    if (lat) { const int pos = a == 0 ? (t >> 6) : (t & 63);
#pragma unroll
        for (int i = 0; i < 4; ++i) { const f32x2 cs = rope[pos * 16 + f0 + i]; const float y1 = x1[i] * cs.x - x2[i] * cs.y, y2 = x2[i] * cs.x + x1[i] * cs.y; x1[i] = y1; x2[i] = y2; } }
#pragma unroll
    for (int i = 0; i < 4; ++i) { x1[i] *= scale; x2[i] *= scale; }
}
__device__ __forceinline__ void ld16(const bf16_t* p, float (&v)[16]) { const u32x4 a = *(const u32x4*)p, b = *(const u32x4*)(p + 8);
    v[0] = lo16(a.x); v[1] = hi16(a.x); v[2] = lo16(a.y); v[3] = hi16(a.y); v[4] = lo16(a.z); v[5] = hi16(a.z); v[6] = lo16(a.w); v[7] = hi16(a.w);
    v[8] = lo16(b.x); v[9] = hi16(b.x); v[10] = lo16(b.y); v[11] = hi16(b.y); v[12] = lo16(b.z); v[13] = hi16(b.z); v[14] = lo16(b.w); v[15] = hi16(b.w); }
__device__ __forceinline__ void st16(bf16_t* p, const float (&v)[16]) { u32x4 a, b; a.x = pk2(v[0], v[1]); a.y = pk2(v[2], v[3]); a.z = pk2(v[4], v[5]); a.w = pk2(v[6], v[7]);
    b.x = pk2(v[8], v[9]); b.y = pk2(v[10], v[11]); b.z = pk2(v[12], v[13]); b.w = pk2(v[14], v[15]); *(u32x4*)p = a; *(u32x4*)(p + 8) = b; }
__device__ __forceinline__ void ld4(const bf16_t* p, float (&v)[4]) { const u32x2 a = *(const u32x2*)p; v[0] = lo16(a.x); v[1] = hi16(a.x); v[2] = lo16(a.y); v[3] = hi16(a.y); }
__device__ __forceinline__ void st4(bf16_t* p, const float (&v)[4]) { u32x2 a; a.x = pk2(v[0], v[1]); a.y = pk2(v[2], v[3]); *(u32x2*)p = a; }

__device__ __forceinline__ void norm192_rope_r(float (&nope)[16], float (&x1)[4], float (&x2)[4], const float (&gn)[16], const float (&g1)[4], const float (&g2)[4], const f32x2* rope, bool lat, int t, int p, float scale) {
    float ss = 0.f;
#pragma unroll
    for (int i = 0; i < 16; ++i) ss += nope[i] * nope[i];
#pragma unroll
    for (int i = 0; i < 4; ++i) ss += x1[i] * x1[i] + x2[i] * x2[i];
    ss += __shfl_xor(ss, 1); ss += __shfl_xor(ss, 2); ss += __shfl_xor(ss, 4);
    const float rs = rsqrtf(ss * (1.0f / 192.0f) + EPS) * scale;
    const int a = p >> 2, f0 = (p & 3) * 4;
#pragma unroll
    for (int i = 0; i < 16; ++i) nope[i] = nope[i] * rs * gn[i];
#pragma unroll
    for (int i = 0; i < 4; ++i) { x1[i] = x1[i] * rs * g1[i]; x2[i] = x2[i] * rs * g2[i]; }
    if (lat) { const int pos = a == 0 ? (t >> 6) : (t & 63);
#pragma unroll
        for (int i = 0; i < 4; ++i) { const f32x2 cs = rope[pos * 16 + f0 + i]; const float y1 = x1[i] * cs.x - x2[i] * cs.y, y2 = x2[i] * cs.x + x1[i] * cs.y; x1[i] = y1; x2[i] = y2; } }
}
__device__ __forceinline__ int row_seq(int row) { return row < NLAT ? (row >> 11) : 8 + ((row - NLAT) >> 8); }
__device__ __forceinline__ void phase_prep(const Frame& F, int l, bool need_ctx) {
    const int gw = F.bid * 8 + F.wave, NGW = F.G * 8;
    bf16_t* P = F.wsb(WS_P); bf16_t* XBC = F.wsb(WS_XBC); float* DT = F.wsf(WS_DT);
    const f32x2* rope = (const f32x2*)F.wsf(WS_ROPE);
    const int lane = F.lane, h = lane >> 3, p = lane & 7, a = p >> 2, f0 = (p & 3) * 4;
    {
        const float* qg = F.in[I_QG] + l * 192; const float* kvg = F.in[I_KVG] + l * 512; const float* naqg = F.in[I_NAQG] + l * 128; const float* nakg = F.in[I_NAKG] + l * 128;
        float gn[16], g1[4], g2[4], gkv[8], gq[16], gk[16];
#pragma unroll
        for (int i = 0; i < 16; ++i) { gn[i] = qg[p * 16 + i]; gq[i] = naqg[p * 16 + i]; gk[i] = nakg[p * 16 + i]; }
#pragma unroll
        for (int i = 0; i < 4; ++i) { g1[i] = qg[128 + a * 32 + f0 + i]; g2[i] = qg[128 + a * 32 + 16 + f0 + i]; }
#pragma unroll
        for (int i = 0; i < 8; ++i) gkv[i] = kvg[lane * 8 + i];
        const float dtb = lane < 32 ? F.in[I_DTB][l * 32 + lane] : 0.f;
        const int per = (NROW + NGW - 1) / NGW;
#pragma unroll 1
        for (int i = 0; i < per; ++i) {
            const int row = gw * per + i; if (row >= NROW) break;
            const bool lat = row < NLAT, doq = lat || need_ctx; const int t = lat ? (row & 2047) : ((row - NLAT) & 255);
            bf16_t* pr = P + (size_t)row * DINP;
            bf16_t* q = pr + PC_Q + h * 192; bf16_t* c = pr + PC_CKV + lane * 8; bf16_t* xq = pr + PC_NAQ + h * 128 + p * 16; bf16_t* xk = pr + PC_NAK + h * 128 + p * 16;
            float nope[16], x1[4], x2[4], vq[16], vk[16];
            if (doq) { ld16(q + p * 16, nope); ld4(q + 128 + a * 32 + f0, x1); ld4(q + 128 + a * 32 + 16 + f0, x2); ld16(xq, vq); }
            const u32x4 ca = *(const u32x4*)c; ld16(xk, vk);
            const float dtr = lane < 32 ? bf2f(pr[PC_DT + lane]) : 0.f;
            if (doq) {
                norm192_rope_r(nope, x1, x2, gn, g1, g2, rope, lat, t, p, 0.07216878364870322f * LOG2E);
                st16(q + p * 16, nope); st4(q + 128 + a * 32 + f0, x1); st4(q + 128 + a * 32 + 16 + f0, x2);
                float ss = 0.f;
#pragma unroll
                for (int j = 0; j < 16; ++j) ss += vq[j] * vq[j];
                ss += __shfl_xor(ss, 1); ss += __shfl_xor(ss, 2); ss += __shfl_xor(ss, 4);
                const float rs = rsqrtf(ss * (1.0f / 128.0f) + EPS) * (0.08838834764831845f * LOG2E);
#pragma unroll
                for (int j = 0; j < 16; ++j) vq[j] = vq[j] * rs * gq[j];
                st16(xq, vq);
            }
            {
                float v[8] = {lo16(ca.x), hi16(ca.x), lo16(ca.y), hi16(ca.y), lo16(ca.z), hi16(ca.z), lo16(ca.w), hi16(ca.w)}; float ss = 0.f;
#pragma unroll
                for (int j = 0; j < 8; ++j) ss += v[j] * v[j];
                const float rs = rsqrtf(wave_sum(ss) * (1.0f / 512.0f) + EPS);
#pragma unroll
                for (int j = 0; j < 8; ++j) v[j] = v[j] * rs * gkv[j];
                u32x4 o; o.x = pk2(v[0], v[1]); o.y = pk2(v[2], v[3]); o.z = pk2(v[4], v[5]); o.w = pk2(v[6], v[7]); *(u32x4*)c = o;
            }
            {
                float ss = 0.f;
#pragma unroll
                for (int j = 0; j < 16; ++j) ss += vk[j] * vk[j];
                ss += __shfl_xor(ss, 1); ss += __shfl_xor(ss, 2); ss += __shfl_xor(ss, 4);
                const float rs = rsqrtf(ss * (1.0f / 128.0f) + EPS);
#pragma unroll
                for (int j = 0; j < 16; ++j) vk[j] = vk[j] * rs * gk[j];
                st16(xk, vk);
            }
            if (lane < 32) { const float x = dtr + dtb; const float e = fast_exp2(x * LOG2E);
                DT[(size_t)row * 32 + lane] = x > 20.f ? x : (e < 1e-3f ? e * (1.0f - 0.5f * e) : __builtin_amdgcn_logf(1.0f + e) * 0.6931471805599453f); }
        }
    }
    {
        const float* cw = F.in[I_CONVW] + (size_t)l * 5 * 2048; const float* cbias = F.in[I_CONVB] + l * 2048;
#pragma unroll 1
        for (int it = gw; it < 1024 * 4; it += NGW) {
            int tl = lane; asm volatile("" : "+v"(tl));
            const int chunk = it >> 2, r0 = chunk * 18, ch0 = (it & 3) * 512 + tl * 8;
            float w[5][8], bs[8];
#pragma unroll
            for (int k = 0; k < 5; ++k) { const f32x4 w0 = *(const f32x4*)(cw + k * 2048 + ch0), w1 = *(const f32x4*)(cw + k * 2048 + ch0 + 4);
#pragma unroll
                for (int e = 0; e < 4; ++e) { w[k][e] = w0[e]; w[k][4 + e] = w1[e]; } }
            { const f32x4 b0 = *(const f32x4*)(cbias + ch0), b1 = *(const f32x4*)(cbias + ch0 + 4);
#pragma unroll
              for (int e = 0; e < 4; ++e) { bs[e] = b0[e]; bs[4 + e] = b1[e]; } }
            u32x4 raw[22];
#pragma unroll
            for (int i = 0; i < 22; ++i) { int rr = r0 - 2 + i; rr = rr < 0 ? 0 : (rr >= NROW ? NROW - 1 : rr); raw[i] = *(const u32x4*)(P + (size_t)rr * DINP + PC_XBC + ch0); }
            const bool uni = (r0 >= 2) && (r0 + 19 < NROW) && (row_seq(r0 - 2) == row_seq(r0 + 19));
#pragma unroll
            for (int j = 0; j < 18; ++j) {
                float o[8];
#pragma unroll
                for (int e = 0; e < 8; ++e) o[e] = bs[e];
                const int sj = row_seq(r0 + j);
#pragma unroll
                for (int k = 0; k < 5; ++k) {
                    const int src = r0 + j + k - 2;
                    const float m = uni ? 1.0f : ((src >= 0 && src < NROW && row_seq(src < 0 ? 0 : (src >= NROW ? NROW - 1 : src)) == sj) ? 1.0f : 0.0f);
                    const u32x4 a4 = raw[j + k];
                    const float x[8] = {lo16(a4.x), hi16(a4.x), lo16(a4.y), hi16(a4.y), lo16(a4.z), hi16(a4.z), lo16(a4.w), hi16(a4.w)};
#pragma unroll
                    for (int e = 0; e < 8; ++e) o[e] += (w[k][e] * m) * x[e];
                }
#pragma unroll
                for (int e = 0; e < 8; ++e) o[e] = siluf_(o[e]);
                u32x4 wv; wv.x = pk2(o[0], o[1]); wv.y = pk2(o[2], o[3]); wv.z = pk2(o[4], o[5]); wv.w = pk2(o[6], o[7]);
                *(u32x4*)(XBC + (size_t)(r0 + j) * 2048 + ch0) = wv;
            }
        }
    }
}

__device__ __forceinline__ void phase_knorm(const Frame& F, int l) {
    const int gw = F.bid * 8 + F.wave, NGW = F.G * 8, per = (NROW + NGW - 1) / NGW;
    const bf16_t* P = F.wsb(WS_P); bf16_t* Kb = F.wsb(WS_K); const f32x2* rope = (const f32x2*)F.wsf(WS_ROPE); const float* kg = F.in[I_KG] + l * 192;
    const int lane = F.lane, h = lane >> 3, p = lane & 7, a = p >> 2, f0 = (p & 3) * 4;
    static_assert(NROW == 9 * GRID * 8, "phase_knorm: 9 rows per wave, loaded 3 at a time");
#pragma unroll 1
    for (int i0 = 0; i0 < 9; i0 += 3) {
        u32x4 ra[3], rb[3]; u32x2 r1[3], r2[3];
#pragma unroll
        for (int j = 0; j < 3; ++j) { const int row = gw * per + i0 + j;
            const GAS bf16_t* k = (const GAS bf16_t*)Kb + (size_t)row_kv(row) * 1536 + h * 192 + p * 16; const GAS bf16_t* kr = (const GAS bf16_t*)P + (size_t)row * DINP + PC_KR + a * 32 + f0;
            ra[j] = *(const GAS u32x4*)k; rb[j] = *(const GAS u32x4*)(k + 8); r1[j] = *(const GAS u32x2*)kr; r2[j] = *(const GAS u32x2*)(kr + 16); }
#pragma unroll
        for (int j = 0; j < 3; ++j) { const int row = gw * per + i0 + j;
            const bool lat = row < NLAT; const int t = lat ? (row & 2047) : 0;
            bf16_t* k = Kb + (size_t)row_kv(row) * 1536 + h * 192;
            float nope[16], x1[4], x2[4];
            nope[0] = lo16(ra[j].x); nope[1] = hi16(ra[j].x); nope[2] = lo16(ra[j].y); nope[3] = hi16(ra[j].y); nope[4] = lo16(ra[j].z); nope[5] = hi16(ra[j].z); nope[6] = lo16(ra[j].w); nope[7] = hi16(ra[j].w);
            nope[8] = lo16(rb[j].x); nope[9] = hi16(rb[j].x); nope[10] = lo16(rb[j].y); nope[11] = hi16(rb[j].y); nope[12] = lo16(rb[j].z); nope[13] = hi16(rb[j].z); nope[14] = lo16(rb[j].w); nope[15] = hi16(rb[j].w);
            x1[0] = lo16(r1[j].x); x1[1] = hi16(r1[j].x); x1[2] = lo16(r1[j].y); x1[3] = hi16(r1[j].y); x2[0] = lo16(r2[j].x); x2[1] = hi16(r2[j].x); x2[2] = lo16(r2[j].y); x2[3] = hi16(r2[j].y);
            norm192_rope(nope, x1, x2, kg, rope, lat, t, p, 1.0f);
            st16(k + p * 16, nope); st4(k + 128 + a * 32 + f0, x1); st4(k + 128 + a * 32 + 16 + f0, x2); }
    }
}

namespace att {
#define SBAR() __builtin_amdgcn_sched_barrier(0)
constexpr int NW = 8, QBLK = 32, KVBLK = 64, DV = 128;
constexpr float THR2 = 11.5f;
__device__ __forceinline__ int crow(int r, int hi) { return (r & 3) + 8 * (r >> 2) + 4 * hi; }
__device__ __forceinline__ int v_st(int k, int c) { const int kk = (k & ~0xC) | ((k & 4) << 1) | ((k & 8) >> 1); return ((kk >> 3) * 4 + (c >> 5)) * 512 + ((kk & 7) * 32 + (c & 31)) * 2; }
__device__ __forceinline__ int v_rd_base(int lane) { return ((lane & 3) << 3) | (((lane >> 2) & 3) << 6) | (((lane >> 4) & 1) << 5) | (((lane >> 5) & 1) << 8); }
constexpr int v_rd_off(int d0, int ks, int half) { return d0 * 512 + ks * 4096 + half * 2048; }
template <int OFF> __device__ __forceinline__ s16x4 tr_read(int vb) { s16x4 r; asm volatile("ds_read_b64_tr_b16 %0, %1 offset:%2" : "=&v"(r) : "v"(vb), "i"(OFF) : "memory"); return r; }
template <int D0> __device__ __forceinline__ void pv_one(f32x16& od, int vb, bf16x8 pa0, bf16x8 pa1, bf16x8 pa2, bf16x8 pa3) {
    const s16x4 l0 = tr_read<v_rd_off(D0, 0, 0)>(vb), h0 = tr_read<v_rd_off(D0, 0, 1)>(vb), l1 = tr_read<v_rd_off(D0, 1, 0)>(vb), h1 = tr_read<v_rd_off(D0, 1, 1)>(vb);
    const s16x4 l2 = tr_read<v_rd_off(D0, 2, 0)>(vb), h2 = tr_read<v_rd_off(D0, 2, 1)>(vb), l3 = tr_read<v_rd_off(D0, 3, 0)>(vb), h3 = tr_read<v_rd_off(D0, 3, 1)>(vb);
    asm volatile("s_waitcnt lgkmcnt(0)" ::: "memory"); SBAR();
#define PKV(L, H) (bf16x8){L[0], L[1], L[2], L[3], H[0], H[1], H[2], H[3]}
    od = __builtin_amdgcn_mfma_f32_32x32x16_bf16(pa0, PKV(l0, h0), od, 0, 0, 0);
    od = __builtin_amdgcn_mfma_f32_32x32x16_bf16(pa1, PKV(l1, h1), od, 0, 0, 0);
    od = __builtin_amdgcn_mfma_f32_32x32x16_bf16(pa2, PKV(l2, h2), od, 0, 0, 0);
    od = __builtin_amdgcn_mfma_f32_32x32x16_bf16(pa3, PKV(l3, h3), od, 0, 0, 0);
#undef PKV
}
__device__ __forceinline__ void pv_d0(f32x16* o, int vb, bf16x8 pa0, bf16x8 pa1, bf16x8 pa2, bf16x8 pa3) {
    pv_one<0>(o[0], vb, pa0, pa1, pa2, pa3); pv_one<1>(o[1], vb, pa0, pa1, pa2, pa3); pv_one<2>(o[2], vb, pa0, pa1, pa2, pa3); pv_one<3>(o[3], vb, pa0, pa1, pa2, pa3);
}
struct NaMask { int bidx, wcol, rs, r, klo; const LAS float* tab; };
__device__ __forceinline__ void na_apply(f32x16& p0, f32x16& p1, const NaMask& M, int kr) {
    const bool rowok = (kr >= M.rs) && (kr < M.rs + 8);
    int dr = kr - M.r + 7; dr = dr < 0 ? 0 : (dr > 14 ? 14 : dr);
    const LAS float* tb = M.tab + dr * 32 + M.bidx;
#pragma unroll
    for (int r = 0; r < 16; ++r) { const int kc = (r & 3) + 8 * (r >> 2);
        const bool ok0 = rowok && ((unsigned)(kc + M.wcol) < 16u), ok1 = rowok && ((unsigned)(kc + 32 + M.wcol) < 16u);
        p0[r] = ok0 ? p0[r] + tb[kc] : -1e30f; p1[r] = ok1 ? p1[r] + tb[kc + 32] : -1e30f; }
}
__device__ __forceinline__ void partialSM(f32x16& p0, f32x16& p1, float& m_reg, float& mn, float& alpha) {
    float pmax = p0[0];
#pragma unroll
    for (int r = 1; r < 16; ++r) pmax = fmaxf(pmax, p0[r]);
#pragma unroll
    for (int r = 0; r < 16; ++r) pmax = fmaxf(pmax, p1[r]);
    { auto rr = __builtin_amdgcn_permlane32_swap(__float_as_uint(pmax), __float_as_uint(pmax), false, false);
      pmax = fmaxf(__uint_as_float(rr[0]), __uint_as_float(rr[1])); }
    if (__builtin_expect(__all(pmax - m_reg <= THR2), 1)) { mn = m_reg; alpha = 1.f; }
    else { mn = fmaxf(m_reg, pmax); alpha = fast_exp2(m_reg - mn); m_reg = mn; }
#pragma unroll
    for (int r = 0; r < 16; ++r) p0[r] = p0[r] - mn;
#pragma unroll
    for (int r = 0; r < 16; ++r) p1[r] = p1[r] - mn;
#pragma unroll
    for (int r = 0; r < 16; ++r) p0[r] = fast_exp2(p0[r]);
}
__device__ __forceinline__ void finishSM(f32x16& p0, f32x16& p1, float alpha, float& l_reg, bf16x8& pa0, bf16x8& pa1, bf16x8& pa2, bf16x8& pa3) {
#pragma unroll
    for (int r = 0; r < 16; ++r) p1[r] = fast_exp2(p1[r]);
    float ps = 0;
#pragma unroll
    for (int r = 0; r < 16; ++r) ps += p0[r];
#pragma unroll
    for (int r = 0; r < 16; ++r) ps += p1[r];
    { auto rr = __builtin_amdgcn_permlane32_swap(__float_as_uint(ps), __float_as_uint(ps), false, false);
      ps = __uint_as_float(rr[0]) + __uint_as_float(rr[1]); }
    l_reg = l_reg * alpha + ps;
#define PK4(P, BASE, OUT) do { unsigned a0 = pg8::cvt_pk_bf16(P[BASE + 0], P[BASE + 1]), a1 = pg8::cvt_pk_bf16(P[BASE + 2], P[BASE + 3]);   \
    unsigned b0 = pg8::cvt_pk_bf16(P[BASE + 4], P[BASE + 5]), b1 = pg8::cvt_pk_bf16(P[BASE + 6], P[BASE + 7]);                              \
    auto r0 = __builtin_amdgcn_permlane32_swap(a0, b0, false, false); auto r1 = __builtin_amdgcn_permlane32_swap(a1, b1, false, false); \
    u32x4 w = {r0[0], r1[0], r0[1], r1[1]}; OUT = *reinterpret_cast<bf16x8*>(&w); } while (0)
    PK4(p0, 0, pa0); PK4(p0, 8, pa1); PK4(p1, 0, pa2); PK4(p1, 8, pa3);
#undef PK4
}
struct Unit {
    const bf16_t* Q; long ldq;
    const bf16_t* K; const bf16_t* V; long ldk, ldv;
    bf16_t* O; long ldo;
    int NT, nct, rowC, rowL;
    __device__ __forceinline__ long trow(int j) const { return j < nct ? (long)rowC + 64 * j : (long)rowL + 64 * (j - nct); }
};
template <int DQK, bool NA>
__device__ __forceinline__ void attn_unit(const Unit& U, char* lds, const NaMask& M, const int tid) {
    constexpr int NQ = DQK / 16, KP = DQK * 2 + 16, SHM_K = KVBLK * KP, SHM_V = KVBLK * DV * 2;
    const int wid = tid >> 6, lane = tid & 63, r32 = lane & 31, hi = lane >> 5;
    char* V_lds = lds; char* K_lds = lds + 2 * SHM_V;
    constexpr int WSM_OFF = (2 * SHM_V + 2 * SHM_K) > 8 * 8704 ? (2 * SHM_V + 2 * SHM_K) : 8 * 8704;
    float* wsm = (float*)(lds + WSM_OFF) + wid * 64; float* li_l = wsm; float* al_l = wsm + 32;
    constexpr int NQR = (DQK == 192) ? 4 : 8, QLP = (NQ - NQR) * 32 + 16;
    float m_reg = -1e30f, l_reg = 0; f32x16 o[4] = {}; bf16x8 qr[NQR];
    const bf16_t* Qw = U.Q + (long)(wid * QBLK + r32) * U.ldq + hi * 8;
#pragma unroll
    for (int d0 = 0; d0 < NQR; ++d0) qr[d0] = *(const bf16x8*)(Qw + d0 * 16);
    char* Qrl = lds + WSM_OFF + 2048 + wid * (32 * QLP) + r32 * QLP + hi * 16;
    if (NQ > NQR) {
#pragma unroll
        for (int d0 = NQR; d0 < NQ; ++d0) *(bf16x8*)(Qrl + (d0 - NQR) * 32) = *(const bf16x8*)(Qw + d0 * 16);
    }
    const int sr = tid >> 4, sc = (tid & 15) * 8, vst0 = v_st(sr, sc), vst1 = v_st(32 + sr, sc);
    const int sr3 = tid >> 3, sc3 = 128 + (tid & 7) * 8;
    const int vb0 = (int)(uintptr_t)V_lds + v_rd_base(lane);
    bf16x8 vs0, vs1, ks0, ks1, ks2;
    const unsigned vo0 = (unsigned)(sr * U.ldv + sc) * 2u, vo1 = (unsigned)((32 + sr) * U.ldv + sc) * 2u, ko0 = (unsigned)(sr * U.ldk + sc) * 2u, ko1 = (unsigned)((32 + sr) * U.ldk + sc) * 2u, ko2 = (unsigned)(sr3 * U.ldk + sc3) * 2u;
#define KSWZ(row, colB) ((row) * KP + (colB))
#define SLOAD(j) do { const long _r = U.trow(j); const char* _vb = (const char*)(U.V + _r * U.ldv); const char* _kb = (const char*)(U.K + _r * U.ldk); \
    vs0 = *(const bf16x8*)(_vb + vo0); vs1 = *(const bf16x8*)(_vb + vo1); ks0 = *(const bf16x8*)(_kb + ko0); ks1 = *(const bf16x8*)(_kb + ko1); \
    if (DQK == 192) ks2 = *(const bf16x8*)(_kb + ko2); } while (0)
#define SWRITE(b) do { *(bf16x8*)(V_lds + (b) * SHM_V + vst0) = vs0; *(bf16x8*)(V_lds + (b) * SHM_V + vst1) = vs1; \
    *(bf16x8*)(K_lds + (b) * SHM_K + KSWZ(sr, sc * 2)) = ks0; *(bf16x8*)(K_lds + (b) * SHM_K + KSWZ(32 + sr, sc * 2)) = ks1; \
    if (DQK == 192) *(bf16x8*)(K_lds + (b) * SHM_K + KSWZ(sr3, sc3 * 2)) = ks2; } while (0)
#define QKT(P0, P1, b) do { P0 = f32x16{}; P1 = f32x16{}; const char* _Ks = K_lds + (b) * SHM_K; \
    _Pragma("unroll") for (int d0 = 0; d0 < NQ; ++d0) { const int cb = (d0 * 16 + hi * 8) * 2; \
      const bf16x8 b0 = *(const bf16x8*)(_Ks + KSWZ(r32, cb)); const bf16x8 b1 = *(const bf16x8*)(_Ks + KSWZ(32 + r32, cb)); \
      const bf16x8 qf = d0 < NQR ? qr[d0 < NQR ? d0 : 0] : *(const bf16x8*)(Qrl + (d0 - NQR) * 32); \
      P0 = __builtin_amdgcn_mfma_f32_32x32x16_bf16(b0, qf, P0, 0, 0, 0); P1 = __builtin_amdgcn_mfma_f32_32x32x16_bf16(b1, qf, P1, 0, 0, 0); } } while (0)
#define MASK(P0, P1, j) do { if (NA) { if ((j) >= U.nct) na_apply(P0, P1, M, M.klo + (j) - U.nct); } } while (0)
#define RESC(a) do { if (__any((a) < 1.f)) { if (hi == 0) al_l[r32] = (a); asm volatile("s_waitcnt lgkmcnt(0)" ::: "memory"); \
    _Pragma("unroll") for (int d = 0; d < 4; ++d) _Pragma("unroll") for (int r = 0; r < 16; ++r) o[d][r] *= al_l[crow(r, hi)]; } } while (0)
    f32x16 p0, p1; float mn, al; bf16x8 pa0, pa1, pa2, pa3; const int NT = U.NT;
    __syncthreads();
    SLOAD(0); asm volatile("s_waitcnt vmcnt(0)" ::: "memory"); SWRITE(0); __syncthreads();
#pragma unroll 1
    for (int j = 0; j < NT; ++j) {
        const int buf = j & 1;
        if (j + 1 < NT) SLOAD(j + 1);
        bool active = true;
        if (NA) { const int kr = M.klo + j - U.nct; active = (j < U.nct) || (kr >= M.rs && kr < M.rs + 8); }
        if (active) {
        SBAR(); QKT(p0, p1, buf); MASK(p0, p1, j);
        partialSM(p0, p1, m_reg, mn, al); RESC(al);
        finishSM(p0, p1, al, l_reg, pa0, pa1, pa2, pa3); SBAR();
        pv_d0(o, vb0 + buf * SHM_V, pa0, pa1, pa2, pa3);
        }
        if (j + 1 < NT) { asm volatile("s_waitcnt vmcnt(0)" ::: "memory"); SWRITE(buf ^ 1); }
        __syncthreads();
    }
    if (hi == 0) li_l[r32] = l_reg; asm volatile("s_waitcnt lgkmcnt(0)" ::: "memory");
    float rli[16];
#pragma unroll
    for (int r = 0; r < 16; ++r) rli[r] = fast_rcp(li_l[crow(r, hi)]);
    char* Ot = lds + wid * 8704;
#pragma unroll
    for (int r = 0; r < 16; ++r) { const int orow = crow(r, hi);
#pragma unroll
        for (int d0 = 0; d0 < 4; ++d0) { const float v = o[d0][r] * rli[r]; *(bf16_t*)(Ot + orow * 272 + (d0 * 32 + r32) * 2) = (bf16_t)(pk2(v, v) & 0xffffu); } }
    asm volatile("s_waitcnt lgkmcnt(0)" ::: "memory");
    char* Og = (char*)(U.O + (long)(wid * QBLK) * U.ldo);
#pragma unroll
    for (int k = 0; k < 8; ++k) { const int id = lane + 64 * k, row = id >> 4, ch = id & 15;
        *(u32x4*)(Og + (unsigned)(row * (int)U.ldo + ch * 8) * 2u) = *(const u32x4*)(Ot + row * 272 + ch * 16); }
#undef KSWZ
#undef SLOAD
#undef SWRITE
#undef QKT
#undef MASK
#undef RESC
}
}

__device__ __forceinline__ void phase_mla(const Frame& F, bool need_ctx) {
    const bf16_t* P = F.wsb(WS_P); const bf16_t* Kb = F.wsb(WS_K); const bf16_t* Vb = F.wsb(WS_V); bf16_t* BR = F.wsb(WS_BR);
    const int nunits = 512 + (need_ctx ? 64 : 0);
    att::NaMask M{};
    for (int u = F.bid; u < nunits; u += F.G) {
        att::Unit U; int b, h, qrow;
        if (u < 512) { b = u >> 6; h = (u >> 3) & 7; qrow = b * SEQ + (u & 7) * 256; U.NT = KVROWS / 64; }
        else { const int v = u - 512; b = v >> 3; h = v & 7; qrow = NLAT + b * CTX; U.NT = CTX / 64; }
        U.Q = P + (size_t)qrow * DINP + PC_Q + h * 192; U.ldq = DINP;
        U.K = Kb + (size_t)b * KVROWS * 1536 + h * 192; U.ldk = 1536; U.V = Vb + (size_t)b * KVROWS * 1024 + h * 128; U.ldv = 1024;
        U.O = BR + (size_t)qrow * 3072 + h * 128; U.ldo = 3072; U.nct = 0; U.rowC = 0; U.rowL = 0;
        att::attn_unit<192, false>(U, (char*)F.lds, M, F.tid);
    }
}
__device__ __forceinline__ void phase_na(const Frame& F, int l, bool need_ctx) {
    const bf16_t* P = F.wsb(WS_P); bf16_t* BR = F.wsb(WS_BR);
    LAS float* tab = (LAS float*)(F.lds + 131072);
    const int nunits = 512 + (need_ctx ? 64 : 0);
    for (int u = F.bid; u < nunits; u += F.G) {
        att::Unit U; att::NaMask M{}; int b, h, qrow;
        if (u < 512) { b = u >> 6; h = (u >> 3) & 7; const int rg = u & 7; qrow = b * SEQ + rg * 256;
            const int klo = rg == 0 ? 0 : (rg * 4 - 4 > 24 ? 24 : rg * 4 - 4), nr = (rg == 0 || rg == 7) ? 8 : 11;
            U.NT = 4 + nr + (nr & 1); U.nct = 4; U.rowC = NLAT + b * CTX; U.rowL = b * SEQ + klo * 64;
            const int r = rg * 4 + (F.wave >> 1), c = (F.wave & 1) * 32 + (F.lane & 31), hi = F.lane >> 5;
            const int rs = r - 4 < 0 ? 0 : (r - 4 > 24 ? 24 : r - 4), wsc = c - 8 < 0 ? 0 : (c - 8 > 48 ? 48 : c - 8);
            M.bidx = 4 * hi - c + 15; M.wcol = 4 * hi - wsc; M.rs = rs; M.r = r; M.klo = klo; M.tab = tab + 64;
        } else { const int v = u - 512; b = v >> 3; h = v & 7; qrow = NLAT + b * CTX; U.NT = 4; U.nct = 4; U.rowC = NLAT + b * CTX; U.rowL = 0; M.tab = tab + 64; }
        __syncthreads();
        for (int i = F.tid; i < 15 * 32; i += 512) { const int dr = i >> 5, dc = i & 31; tab[64 + i] = dc < 31 ? F.in[I_RPB][((size_t)(l * 8 + h) * 15 + dr) * 31 + dc] * LOG2E : 0.f; }
        U.Q = P + (size_t)qrow * DINP + PC_NAQ + h * 128; U.ldq = DINP;
        U.K = P + PC_NAK + h * 128; U.ldk = DINP; U.V = P + PC_NAV + h * 128; U.ldv = DINP;
        U.O = BR + (size_t)qrow * 3072 + 2048 + h * 128; U.ldo = 3072;
        att::attn_unit<128, true>(U, (char*)F.lds, M, F.tid);
    }
}

__device__ __forceinline__ bf16x8 frag_row(const LAS unsigned char* t, int pitch, int row0, int k0, int lane) {
    return *(const LAS bf16x8*)(t + (row0 + (lane & 31)) * pitch + (k0 + 8 * (lane >> 5)) * 2);
}
__device__ __forceinline__ s16x4 tr16(const LAS unsigned char* p) {
    typedef short v4i16 __attribute__((ext_vector_type(4)));
    return __builtin_bit_cast(s16x4, __builtin_amdgcn_ds_read_tr16_b64_v4i16((LAS v4i16*)p));
}
__device__ __forceinline__ bf16x8 frag_tr(const LAS unsigned char* t, int pitch, int k0, int col0, int lane) {
    const int h = lane >> 5, blk = (lane >> 4) & 1, q = (lane & 15) >> 2, p = lane & 3;
    const LAS unsigned char* a = t + (k0 + 8 * h + q) * pitch + (col0 + 16 * blk + 4 * p) * 2;
    const s16x4 lo = tr16(a), hi = tr16(a + 4 * pitch);
    return (bf16x8){lo[0], lo[1], lo[2], lo[3], hi[0], hi[1], hi[2], hi[3]};
}
__device__ __forceinline__ int chunk_row0(int b, int c) { return c < 2 ? NLAT + b * CTX + c * 128 : b * SEQ + (c - 2) * 128; }
__device__ __forceinline__ float chunk_cumsum(float d0, float d1, int lane, float& c0, float& c1) {
    float s = d0 + d1;
#pragma unroll
    for (int o = 1; o < 64; o <<= 1) { const float t = __shfl_up(s, o); if (lane >= o) s += t; }
    c1 = s; c0 = s - d1; return __shfl(s, 63);
}

__device__ __forceinline__ void phase_ssd_states(const Frame& F, int l) {
    constexpr int XP = 592, BP = 336;
    LAS unsigned char* Xs = F.lds; LAS unsigned char* Bm = F.lds + 128 * XP; LAS float* wts = (LAS float*)(F.lds + 128 * XP + 128 * BP);
    const bf16_t* XBC = F.wsb(WS_XBC); const float* DT = F.wsf(WS_DT); float* SST = F.wsf(WS_SST); float* CDEC = F.wsf(WS_CDEC);
    const int lane = F.lane, w = F.wave, d = w >> 2, hh = w & 3;
    for (int it = F.bid; it < NB * NCHUNK * 4; it += F.G) {
        const int b = it / (NCHUNK * 4), c = (it / 4) % NCHUNK, g = it & 3, row0 = chunk_row0(b, c), h = g * 4 + hh;
        __syncthreads();
        for (int i = F.tid; i < 128 * 32; i += 512) { const int r = i >> 5, ch = i & 31; *(LAS u32x4*)(Xs + r * XP + ch * 16) = *(const u32x4*)(XBC + (size_t)(row0 + r) * 2048 + g * 256 + ch * 8); }
        for (int i = F.tid; i < 128 * 16; i += 512) { const int r = i >> 4, ch = i & 15; *(LAS u32x4*)(Bm + r * BP + ch * 16) = *(const u32x4*)(XBC + (size_t)(row0 + r) * 2048 + 1024 + g * 128 + ch * 8); }
        {   const float a = -expf(F.in[I_ALOG][(l * 2 + d) * 16 + h]);
            const float dt0 = DT[(size_t)(row0 + 2 * lane) * 32 + d * 16 + h], dt1 = DT[(size_t)(row0 + 2 * lane + 1) * 32 + d * 16 + h];
            float c0, c1; const float tot = chunk_cumsum(dt0 * a, dt1 * a, lane, c0, c1);
            const float e0 = d == 0 ? tot - c0 : c0 - dt0 * a, e1 = d == 0 ? tot - c1 : c1 - dt1 * a;
            wts[w * 128 + 2 * lane] = dt0 * expf(e0); wts[w * 128 + 2 * lane + 1] = dt1 * expf(e1);
            if (lane == 0) CDEC[((b * 2 + d) * 16 + h) * NCHUNK + c] = expf(tot);
        }
        __syncthreads();
        bf16_t* dst = (bf16_t*)SST + ((size_t)((b * 2 + d) * 16 + h) * NCHUNK + c) * 8192;
        LAS unsigned char* wsc = F.lds + 122880 + w * 4096;
#pragma unroll 1
        for (int pt = 0; pt < 2; ++pt) {
            f32x16 acc[4] = {};
#pragma unroll 1
            for (int ks = 0; ks < 8; ++ks) {
                const f32x4 w0 = *(const LAS f32x4*)(wts + w * 128 + 16 * ks + 8 * (lane >> 5)), w1 = *(const LAS f32x4*)(wts + w * 128 + 16 * ks + 8 * (lane >> 5) + 4);
                const bf16x8 x = frag_tr(Xs, XP, 16 * ks, hh * 64 + 32 * pt, lane);
                u32x4 o; o.x = pk2(bf2f((unsigned short)x[0]) * w0[0], bf2f((unsigned short)x[1]) * w0[1]); o.y = pk2(bf2f((unsigned short)x[2]) * w0[2], bf2f((unsigned short)x[3]) * w0[3]);
                o.z = pk2(bf2f((unsigned short)x[4]) * w1[0], bf2f((unsigned short)x[5]) * w1[1]); o.w = pk2(bf2f((unsigned short)x[6]) * w1[2], bf2f((unsigned short)x[7]) * w1[3]);
                const bf16x8 a = __builtin_bit_cast(bf16x8, o);
#pragma unroll
                for (int nt = 0; nt < 4; ++nt) { const bf16x8 bb = frag_tr(Bm, BP, 16 * ks, 32 * nt, lane); acc[nt] = __builtin_amdgcn_mfma_f32_32x32x16_bf16(a, bb, acc[nt], 0, 0, 0); }
            }
            int le = lane; asm volatile("" : "+v"(le));
#pragma unroll
            for (int nh = 0; nh < 2; ++nh) {
#pragma unroll
                for (int q = 0; q < 2; ++q)
#pragma unroll
                    for (int r = 0; r < 16; ++r) { const float v = acc[2 * nh + q][r]; *(LAS bf16_t*)(wsc + att::crow(r, le >> 5) * 128 + (32 * q + (le & 31)) * 2) = (bf16_t)(pk2(v, v) & 0xffffu); }
                asm volatile("s_waitcnt lgkmcnt(0)" ::: "memory");
#pragma unroll
                for (int k = 0; k < 4; ++k) { const int id = le + 64 * k, row = id >> 3, ch = id & 7;
                    *(u32x4*)(dst + (size_t)(32 * pt + row) * 128 + 64 * nh + ch * 8) = *(const LAS u32x4*)(wsc + row * 128 + ch * 16); }
                asm volatile("s_waitcnt lgkmcnt(0)" ::: "memory");
            }
        }
    }
}
__device__ __forceinline__ void phase_ssd_scan(const Frame& F) {
    const u32x2* SST = (const u32x2*)F.wsf(WS_SST); const float* CDEC = F.wsf(WS_CDEC); u32x2* SENT = (u32x2*)F.wsb(WS_SENT);
    const int gt = F.bid * 512 + F.tid, NT = F.G * 512;
    for (int idx = gt; idx < 256 * 2048; idx += NT) {
        const int combo = idx >> 11, e4 = idx & 2047, d = (combo >> 4) & 1;
        const u32x2* base = SST + (size_t)combo * NCHUNK * 2048 + e4; u32x2* ob = SENT + (size_t)combo * NCHUNK * 2048 + e4; const float* cd = CDEC + combo * NCHUNK;
        u32x2 v[NCHUNK];
#pragma unroll
        for (int c = 0; c < NCHUNK; ++c) v[c] = base[(size_t)c * 2048];
        float z0; asm volatile("v_mov_b32 %0, 0" : "=v"(z0));
        f32x4 st = {z0, z0, z0, z0};
#pragma unroll
        for (int i = 0; i < NCHUNK; ++i) { const int cf = i, cb = i == 0 ? 1 : (i == 1 ? 0 : NCHUNK + 1 - i); const int cc = d == 0 ? cf : cb;
            u32x2 o; o.x = pk2(st.x, st.y); o.y = pk2(st.z, st.w); ob[(size_t)cc * 2048] = o;
            const f32x4 cs = {lo16(v[cc].x), hi16(v[cc].x), lo16(v[cc].y), hi16(v[cc].y)}; st = st * cd[cc] + cs; }
    }
}
__device__ __forceinline__ void phase_ssd_out(const Frame& F, int l, bool need_ctx) {
    constexpr int CP = 272, XHP = 144;
    LAS unsigned char* Cm = F.lds; LAS unsigned char* Bm = F.lds + 34816; LAS unsigned char* Mc = Bm; LAS unsigned char* Xh = F.lds + 69632;
    LAS unsigned char* Zh = F.lds + 88064; LAS unsigned char* Sf = F.lds + 106496; LAS unsigned char* Sb = F.lds + 123904;
    LAS float* arr = (LAS float*)(F.lds + 141312);
    const bf16_t* XBC = F.wsb(WS_XBC); const bf16_t* P = F.wsb(WS_P); const float* DT = F.wsf(WS_DT); const bf16_t* SENT = F.wsb(WS_SENT); bf16_t* BR = F.wsb(WS_BR);
    float* GSS = F.wsf(WS_GSS) + (size_t)l * NROW * 4;
    const int lane = F.lane, w = F.wave, hi = lane >> 5, c_lo = need_ctx ? 0 : 2, nch = NCHUNK - c_lo;
    const int lt = w >> 1, pt = w & 1;
#pragma unroll 1
    for (int it = F.bid; it < NB * nch * 16; it += F.G) {
        const int b = it / (nch * 16), c = c_lo + (it >> 4) % nch, h = it & 15, g = h >> 2, row0 = chunk_row0(b, c);
        int tq = F.tid; asm volatile("" : "+v"(tq));
        __syncthreads();
        {
            u32x4 vb[4], vc[4], vx[2], vz[2], vf[2], vs[2];
            const bf16_t* sf = SENT + ((size_t)((b * 2 + 0) * 16 + h) * NCHUNK + c) * 8192; const bf16_t* sb = SENT + ((size_t)((b * 2 + 1) * 16 + h) * NCHUNK + c) * 8192;
#pragma unroll
            for (int k = 0; k < 4; ++k) { const int i = tq + 512 * k, r = i >> 4, ch = i & 15; const bf16_t* src = XBC + (size_t)(row0 + r) * 2048 + 1024 + g * 128 + ch * 8; vb[k] = *(const u32x4*)src; vc[k] = *(const u32x4*)(src + 512); }
#pragma unroll
            for (int k = 0; k < 2; ++k) { const int i = tq + 512 * k, r = i >> 3, ch = i & 7; vx[k] = *(const u32x4*)(XBC + (size_t)(row0 + r) * 2048 + h * 64 + ch * 8); vz[k] = *(const u32x4*)(P + (size_t)(row0 + r) * DINP + PC_Z + h * 64 + ch * 8);
                vf[k] = *(const u32x4*)(sf + (size_t)i * 8); vs[k] = *(const u32x4*)(sb + (size_t)i * 8); }
#pragma unroll
            for (int k = 0; k < 4; ++k) { const int i = tq + 512 * k, r = i >> 4, ch = i & 15; *(LAS u32x4*)(Bm + r * CP + ch * 16) = vb[k]; *(LAS u32x4*)(Cm + r * CP + ch * 16) = vc[k]; }
#pragma unroll
            for (int k = 0; k < 2; ++k) { const int i = tq + 512 * k, r = i >> 3, ch = i & 7; *(LAS u32x4*)(Xh + r * XHP + ch * 16) = vx[k]; *(LAS u32x4*)(Zh + r * XHP + ch * 16) = vz[k];
                const int rs_ = i >> 4, cs_ = i & 15; *(LAS u32x4*)(Sf + rs_ * CP + cs_ * 16) = vf[k]; *(LAS u32x4*)(Sb + rs_ * CP + cs_ * 16) = vs[k]; }
        }
        if (w < 2) {
            const int d = w; const float a = -expf(F.in[I_ALOG][(l * 2 + d) * 16 + h]);
            const float dt0 = DT[(size_t)(row0 + 2 * lane) * 32 + d * 16 + h], dt1 = DT[(size_t)(row0 + 2 * lane + 1) * 32 + d * 16 + h];
            float c0, c1; const float tot = chunk_cumsum(dt0 * a, dt1 * a, lane, c0, c1);
            if (d == 1) { c0 = tot - c0 + dt0 * a; c1 = tot - c1 + dt1 * a; }
            LAS float* q = arr + d * 128 + 2 * lane;
            q[0] = c0 * LOG2E; q[1] = c1 * LOG2E; q[256] = dt0; q[257] = dt1; q[512] = fast_exp2(c0 * LOG2E); q[513] = fast_exp2(c1 * LOG2E);
        }
        __syncthreads();
        f32x16 cb[2] = {};
#pragma unroll 2
        for (int ks = 0; ks < 8; ++ks) { const bf16x8 a = frag_row(Cm, CP, 32 * lt, 16 * ks, lane);
#pragma unroll
            for (int i = 0; i < 2; ++i) { const bf16x8 bb = frag_row(Bm, CP, 32 * (2 * pt + i), 16 * ks, lane); cb[i] = __builtin_amdgcn_mfma_f32_32x32x16_bf16(a, bb, cb[i], 0, 0, 0); } }
        int lb = 32 * lt + 4 * hi, sb0 = 64 * pt + (lane & 31);
        asm volatile("" : "+v"(lb), "+v"(sb0));
        __syncthreads();
        const LAS float* aF = arr; const LAS float* rB = arr + 128;
#pragma unroll
        for (int i = 0; i < 2; ++i) { const int sidx = sb0 + 32 * i, dlt = sidx - lb;
            const float afs = aF[sidx], rbs = rB[sidx], dfs = aF[256 + sidx], dbs = rB[256 + sidx];
#pragma unroll
            for (int r = 0; r < 16; ++r) { const int cr = (r & 3) + 8 * (r >> 2), ll = lb + cr;
                const float f = dlt <= cr ? fast_exp2(aF[ll] - afs) * dfs : 0.f, bk = dlt >= cr ? fast_exp2(rB[ll] - rbs) * dbs : 0.f;
                const float m = cb[i][r] * (f + bk);
                *(LAS bf16_t*)(Mc + ll * CP + sidx * 2) = (bf16_t)(pk2(m, m) & 0xffffu); } }
        __syncthreads();
        f32x16 yd = {}, yf = {}, yb = {};
#pragma unroll 2
        for (int ks = 0; ks < 8; ++ks) {
            const bf16x8 am = frag_row(Mc, CP, 32 * lt, 16 * ks, lane), bx = frag_tr(Xh, XHP, 16 * ks, 32 * pt, lane);
            yd = __builtin_amdgcn_mfma_f32_32x32x16_bf16(am, bx, yd, 0, 0, 0);
            const bf16x8 ac = frag_row(Cm, CP, 32 * lt, 16 * ks, lane), bf = frag_row(Sf, CP, 32 * pt, 16 * ks, lane), bb = frag_row(Sb, CP, 32 * pt, 16 * ks, lane);
            yf = __builtin_amdgcn_mfma_f32_32x32x16_bf16(ac, bf, yf, 0, 0, 0);
            yb = __builtin_amdgcn_mfma_f32_32x32x16_bf16(ac, bb, yb, 0, 0, 0);
        }
        const float dsk = F.in[I_SSDD][l * 16 + h]; const int pcol = 32 * pt + (lane & 31);
#pragma unroll
        for (int r = 0; r < 16; ++r) { const int cr = (r & 3) + 8 * (r >> 2), ll = lb + cr;
            const float xs = bf2f(*(const LAS bf16_t*)(Xh + ll * XHP + pcol * 2));
            const float y = yd[r] + aF[512 + ll] * yf[r] + rB[512 + ll] * yb[r] + dsk * xs;
            LAS bf16_t* zp = (LAS bf16_t*)(Zh + ll * XHP + pcol * 2);
            const float v = y * siluf_(bf2f(*zp));
            *zp = (bf16_t)(pk2(v, v) & 0xffffu); }
        __syncthreads();
        {
            int tz = F.tid; asm volatile("" : "+v"(tz));
            const int r = tz >> 2, q4 = tz & 3; const LAS unsigned char* src = Zh + r * XHP + q4 * 32;
            const u32x4 a = *(const LAS u32x4*)src, b2 = *(const LAS u32x4*)(src + 16);
            bf16_t* dst = BR + (size_t)(row0 + r) * 3072 + 1024 + h * 64 + q4 * 16;
            *(u32x4*)dst = a; *(u32x4*)(dst + 8) = b2;
            float ss = 0.f;
            { const unsigned wv[8] = {a.x, a.y, a.z, a.w, b2.x, b2.y, b2.z, b2.w};
#pragma unroll
              for (int k = 0; k < 8; ++k) { const float x0 = lo16(wv[k]), x1 = hi16(wv[k]); ss += x0 * x0 + x1 * x1; } }
            ss += __shfl_xor(ss, 1); ss += __shfl_xor(ss, 2);
            if (q4 == 0) atomicAdd(GSS + (size_t)(row0 + r) * 4 + g, ss);
        }
    }
}
__device__ __forceinline__ void phase_ssd_norm(const Frame& F, int l, bool need_ctx) {
    bf16_t* BR = F.wsb(WS_BR); const float* GSS = F.wsf(WS_GSS) + (size_t)l * NROW * 4; const float* ng = F.in[I_SSDG] + l * 1024;
    const int gw = F.bid * 8 + F.wave, nrows = need_ctx ? NROW : NLAT, per = nrows / (GRID * 8), lane = F.lane;
    float gg[16];
#pragma unroll
    for (int i = 0; i < 16; ++i) gg[i] = ng[lane * 16 + i];
    for (int i = 0; i < per; ++i) { const int row = gw * per + i;
        bf16_t* p = BR + (size_t)row * 3072 + 1024 + lane * 16; float v[16]; ld16(p, v);
        const float rs = rsqrtf(GSS[(size_t)row * 4 + (lane >> 4)] * (1.0f / 256.0f) + EPS);
#pragma unroll
        for (int j = 0; j < 16; ++j) v[j] = v[j] * rs * gg[j];
        st16(p, v); }
}

constexpr int NSTEPS = 2 + 4 * 16;
__global__ void __launch_bounds__(512, 2) fwd_kernel(Args args) {
    extern __shared__ __attribute__((aligned(16))) unsigned char lds_raw[];
    asm volatile("s_nop 0\n\ts_nop 0");
    Frame F; F.lds = (LAS unsigned char*)lds_raw; F.tid = threadIdx.x; F.lane = F.tid & 63; F.wave = __builtin_amdgcn_readfirstlane(F.tid >> 6); F.bid = blockIdx.x;
    F.in = args.in; F.out = args.out; F.ws = args.ws;
    volatile LAS unsigned* MISC = (volatile LAS unsigned*)(F.lds + MISC_OFF);
    for (int u = F.tid; u < (LDS_BYTES - MISC_OFF) / 4; u += 512) MISC[u] = 0u;
    __syncthreads();
    unsigned* ctl = (unsigned*)(F.ws + WS_CTL);
#if !MK_PER_STEP
    XcdBarrier bar = xcd_barrier_post(ctl + CW_BAR, MISC + 8);
#endif
    const int lo = args.st_lo, hi = args.st_hi;
#ifndef MK_PHASES
#define MK_PHASES 0xFFFFFFFFu
#endif
#define EN(k) (((MK_PHASES) >> (k)) & 1u)
#ifndef MK_DUPGU
#define MK_DUPGU 0
#endif
#ifndef MK_DUP
#define MK_DUP 0u
#endif
#define REP(k) for (int rep_ = 0; rep_ <= (int)(((MK_DUP) >> (k)) & 1u); ++rep_)
#define RUN(s) (lo <= (s) && (s) < hi)
#if MK_PER_STEP
#define SEAM() do { } while (0)
#else
#define SEAM() xcd_barrier(bar)
#endif
#define PH Frame Fp = F; { int t_; asm volatile("v_mbcnt_lo_u32_b32 %0, -1, 0\n\tv_mbcnt_hi_u32_b32 %0, -1, %0" : "=v"(t_)); t_ += F.wave << 6;     Fp.tid = t_; Fp.lane = t_ & 63; Fp.wave = __builtin_amdgcn_readfirstlane(t_ >> 6); \
    unsigned char* w_ = args.ws; asm volatile("" : "+s"(w_)); Fp.ws = w_; int b_ = blockIdx.x; asm volatile("" : "+s"(b_)); Fp.bid = b_; float* o_ = args.out; asm volatile("" : "+s"(o_)); Fp.out = o_; } \
    float* HC = Fp.wsf(WS_HC); bf16_t* U = Fp.wsb(WS_U); bf16_t* P = Fp.wsb(WS_P); bf16_t* HID = Fp.wsb(WS_P); const float* mod = Fp.wsf(WS_MOD) + (size_t)l * 9 * (NMOD * DM); \
    (void)HC; (void)U; (void)P; (void)HID; (void)mod;

    if (EN(0) && RUN(0)) { const int l = 0; PH; phase_adaln(Fp); }

#pragma unroll 1
    for (int hl = 0; hl < 4; ++hl) {
        const int l = hl >> 1, second = hl & 1, sb = 2 + 16 * hl;
        const bool need_ctx = (l == 0);
        const float* normg = F.in[I_NORMG] + (size_t)l * 3 * DM;
        if (!second) {
            if (EN(1) && RUN(sb + 0)) { PH; phase_convert(Fp, l); if (l == 0) SEAM(); }
        } else {
            const int mrows = need_ctx ? NROW : NLAT;
            if (EN(2) && RUN(sb + 0)) { PH; phase_norm(Fp, Fp.out, HC, normg + DM, mod, 3, U, NROW, HC, Fp.wsf(WS_SST), MK_I8GATE ? Fp.ws + WS_U8M : nullptr, Fp.wsf(WS_RSC)); SEAM(); }
            if (EN(3) && RUN(sb + 1)) { PH; pg8::ProbWin57 S{U, Fp.wsb(WS_U8M), Fp.wsb(WS_WIN), DM, DM, DM, need_ctx ? 1 : 0, Fp.G, Fp.bid};
                pg8::EpiP57 E{P, DINP, Fp.wsb(WS_GATE), Fp.wsf(WS_RSC), (const float*)(Fp.ws + WS_CMAX) + (size_t)l * NQCOL + 22528};
                pg8::gemm_phase<pg8::EpiP57, pg8::ProbWin57, MK_I8GATE ? 2 : 0>(Fp.lds, S, E, Fp.tid); SEAM(); }
            if (EN(4) && RUN(sb + 2)) { PH; phase_prep(Fp, l, need_ctx); SEAM(); }
            if (EN(5) && RUN(sb + 3)) { PH; pg8::ProbStd S{P + PC_CKV, Fp.wsb(WS_WUKV), DINP, 512, 512, NROW / 256, 8, Fp.G, Fp.bid}; pg8::EpiKV E{Fp.wsb(WS_K), Fp.wsb(WS_V)};
                pg8::gemm_phase(Fp.lds, S, E, Fp.tid); SEAM(); }
            if (EN(6) && RUN(sb + 4)) { PH; phase_knorm(Fp, l); REP(6) phase_ssd_states(Fp, l); SEAM(); }
            if (EN(7) && RUN(sb + 5)) { PH; phase_ssd_scan(Fp); }
            if (EN(9) && RUN(sb + 5)) { PH; REP(9) phase_na(Fp, l, need_ctx); SEAM(); }
            if (EN(8) && RUN(sb + 6)) { PH; REP(8) phase_mla(Fp, need_ctx); }
            if (EN(10) && RUN(sb + 6)) { PH; REP(10) phase_ssd_out(Fp, l, need_ctx); SEAM(); }
            if (EN(10) && RUN(sb + 7)) { PH; phase_ssd_norm(Fp, l, need_ctx); SEAM(); }
            if (EN(11) && RUN(sb + 9)) { PH; pg8::ProbMerge S{Fp.wsb(WS_BR), Fp.wsb(WS_WBR), 3072, 1024, 1024, mrows / 256, 8, Fp.G, Fp.bid}; pg8::EpiMerge E{Fp.wsb(WS_GATE), U};
                REP(11) pg8::gemm_phase(Fp.lds, S, E, Fp.tid); SEAM(); }
            if (EN(12) && RUN(sb + 10)) { PH; pg8::ProbSplit S{U, Fp.wsb(WS_WOUT), DM, DM, DM, mrows / 256, Fp.G, Fp.bid};
                pg8::EpiResid E{{Fp.out, HC}, {Fp.out, HC}, mod, 5, 1.0f, Fp.wsf(WS_SST)};
                pg8::gemm_phase(Fp.lds, S, E, Fp.tid); SEAM(); }
        }
        {
            const int frows = (second && !need_ctx) ? NLAT : NROW;
            const int nbase = second ? 6 : 0;
            if (EN(13) && RUN(sb + 11)) { PH; const float* inl = (hl == 0) ? F.in[I_X] : Fp.out; const float* inc = (hl == 0) ? F.in[I_CTX] : HC; phase_norm(Fp, inl, inc, normg + (second ? 2 : 0) * DM, mod, nbase, MK_I8GU ? nullptr : U, frows, HC, hl == 0 ? nullptr : Fp.wsf(WS_SST), MK_I8GU ? (unsigned char*)U : nullptr, Fp.wsf(WS_RSC)); SEAM(); }
            if (EN(14) && RUN(sb + 12)) { PH; pg8::ProbStd S{U, Fp.wsb(second ? WS_WGU2 : WS_WGU1), DM, DM, MK_I8GU ? DM / 2 : DM, frows / 256, 44, Fp.G, Fp.bid};
                pg8::EpiSwiglu<MK_I8GU != 0> E{HID, Fp.wsf(WS_RSC), (const float*)(Fp.ws + WS_CMAX) + (size_t)l * NQCOL + (second ? 11264 : 0), Fp.lds};
                pg8::gemm_phase<pg8::EpiSwiglu<MK_I8GU != 0>, pg8::ProbStd, MK_I8GU ? 1 : 0>(Fp.lds, S, E, Fp.tid); SEAM(); }
            if (EN(15) && RUN(sb + 13)) { PH; const float* inl = (hl == 0) ? F.in[I_X] : Fp.out; const float* inc = (hl == 0) ? F.in[I_CTX] : HC; pg8::ProbSplit S{HID, Fp.wsb(second ? WS_WDN2 : WS_WDN1), DFF, DFF, DFF, frows / 256, Fp.G, Fp.bid};
                pg8::EpiResid E{{(float*)inl, (float*)inc}, {Fp.out, HC}, mod, nbase + 2, 0.5f, Fp.wsf(WS_SST)};
                pg8::gemm_phase(Fp.lds, S, E, Fp.tid); if (hl != 3) SEAM(); }
        }
    }
#undef RUN
#undef SEAM
}

extern "C" void kernel_launch(void* const* d_in, const int* in_sizes, int n_in, void* d_out, int out_size, void* d_ws, size_t ws_size, hipStream_t stream) {
    static int grid = 0;
    if (grid == 0) {
        if (n_in != 30 || in_sizes[0] != NLAT * DM || out_size != NLAT * DM || ws_size < WS_END) {
            fprintf(stderr, "kernel_launch: unexpected shapes (n_in %d in0 %d out %d ws %zu, need ws >= %zu); nothing launched\n", n_in, n_in > 0 ? in_sizes[0] : -1, out_size, ws_size, (size_t)WS_END); grid = -1; return; }
        int dev = 0, cus = 0, per_cu = 0;
        if (hipGetDevice(&dev) != hipSuccess || hipDeviceGetAttribute(&cus, hipDeviceAttributeMultiprocessorCount, dev) != hipSuccess) { grid = -1; return; }
        if (hipFuncSetAttribute((const void*)fwd_kernel, hipFuncAttributeMaxDynamicSharedMemorySize, LDS_BYTES) != hipSuccess) { fprintf(stderr, "kernel_launch: hipFuncSetAttribute failed\n"); grid = -1; return; }
        if (hipOccupancyMaxActiveBlocksPerMultiprocessor(&per_cu, (const void*)fwd_kernel, 512, LDS_BYTES) != hipSuccess || per_cu < 1) fprintf(stderr, "kernel_launch: occupancy query reports %d\n", per_cu);
        (void)hipGetLastError();
        if (cus < GRID) { fprintf(stderr, "kernel_launch: %d CUs < %d: the persistent grid would not be resident; nothing launched\n", cus, GRID); grid = -1; return; }
        grid = GRID;
    }
    if (grid < 0) return;
    if (hipMemsetAsync((char*)d_ws + WS_CTL, 0, CTL_ZERO_BYTES, stream) != hipSuccess) { fprintf(stderr, "kernel_launch: memset failed\n"); return; }
    Args a{};
    for (int i = 0; i < 30; ++i) a.in[i] = (const float*)d_in[i];
    a.out = (float*)d_out; a.ws = (unsigned char*)d_ws;
#if MK_PER_STEP
    for (int s = 0; s < NSTEPS; ++s) {
        if (s == 1) continue;
        const int hl = (s - 2) / 16, k = (s - 2) % 16;
        if (s >= 2) { if ((hl & 1) == 0 && k >= 1 && k <= 10) continue; if ((hl & 1) == 1 && k > 10 && false) continue; if (k > 13) continue; }
        a.st_lo = s; a.st_hi = s + 1;
        hipLaunchKernelGGL(fwd_kernel, dim3(grid), dim3(512), LDS_BYTES, stream, a);
    }
#else
    a.st_lo = 0; a.st_hi = NSTEPS;
    hipLaunchKernelGGL(fwd_kernel, dim3(grid), dim3(512), LDS_BYTES, stream, a);
#endif
    const hipError_t le = hipPeekAtLastError();
    if (le != hipSuccess) fprintf(stderr, "kernel_launch: launch failed: %s\n", hipGetErrorName(le));
}
```

```cpp
#include <hip/hip_runtime.h>
#include <cstdio>
#include <cstdint>

#ifndef MK_PER_STEP
#define MK_PER_STEP 0
#endif

#ifndef MK_I8GATE
#define MK_I8GATE 1
#endif
#ifndef MK_I8GU
#define MK_I8GU 1
#endif
#define LAS __attribute__((address_space(3)))
#define GAS __attribute__((address_space(1)))
typedef unsigned short bf16_t;
typedef short bf16x8 __attribute__((ext_vector_type(8)));
typedef short s16x4 __attribute__((ext_vector_type(4)));
typedef float f32x2 __attribute__((ext_vector_type(2)));
typedef float f32x4 __attribute__((ext_vector_type(4)));
typedef float f32x16 __attribute__((ext_vector_type(16)));
typedef unsigned u32x2 __attribute__((ext_vector_type(2)));
typedef unsigned u32x4 __attribute__((ext_vector_type(4)));
typedef int i32x4 __attribute__((ext_vector_type(4)));
typedef GAS unsigned gu32;

constexpr int DM = 2048, NB = 8, SEQ = 2048, CTX = 256, NLAT = NB * SEQ, NCTXR = NB * CTX, NROW = NLAT + NCTXR;
constexpr int DFF = 5632, NMOD = 9, DIN = 14432, DINP = 8448, NWIN = 14592;
constexpr int PC_Q = 0, PC_CKV = 1536, PC_Z = 2048, PC_XBC = 3072, PC_NAQ = 5120, PC_NAK = 6144, PC_NAV = 7168, PC_KR = 8192, PC_DT = 8256;
constexpr int GT0 = 33;
constexpr int KVROWS = CTX + SEQ;
constexpr int NCHUNK = 18;
constexpr float EPS = 1e-6f;
constexpr float LOG2E = 1.4426950408889634f;

constexpr size_t MiB = 1u << 20;
constexpr size_t WS_CTL = 0, CTL_ZERO_BYTES = 4 * MiB;
constexpr size_t WS_MOD = 1 * MiB;
constexpr size_t WS_ROPE = 4 * MiB;
constexpr size_t WS_CDEC = 4 * MiB + 65536;
constexpr size_t WS_DT = 5 * MiB;
constexpr size_t WS_HC = 8 * MiB;
constexpr size_t WS_WGU1 = 24 * MiB, WS_WDN1 = 68 * MiB, WS_WGU2 = 90 * MiB, WS_WDN2 = 134 * MiB, WS_WIN = 156 * MiB, WS_WUKV = 213 * MiB, WS_WBR = 215 * MiB, WS_WOUT = 227 * MiB;
constexpr size_t WS_U = 236 * MiB;
constexpr size_t WS_P = 308 * MiB;
constexpr size_t WS_GATE = 605 * MiB;
constexpr size_t WS_K = 821 * MiB;
constexpr size_t WS_V = 875 * MiB;
constexpr size_t WS_XBC = 911 * MiB;
constexpr size_t WS_SST = 983 * MiB;
constexpr size_t WS_BR = 1127 * MiB;
constexpr size_t WS_END = 1235 * MiB;
constexpr int CW_TMO = 0, CW_BAR = 4096, CW_Q = 16384;
constexpr size_t WS_GSS = 3 * MiB;
constexpr size_t WS_CMAX = 3 * MiB + 640 * 1024;
constexpr size_t WS_RSC = 4 * MiB + 131072;
constexpr size_t WS_U8M = WS_XBC;
constexpr int NQCOL = 28672;
constexpr size_t WS_SENT = WS_U;

constexpr int LDS_SCRATCH = 155648, MISC_OFF = LDS_SCRATCH, LDS_BYTES = 159744;

__device__ __forceinline__ float bf2f(unsigned short b) { return __uint_as_float(((unsigned)b) << 16); }
__device__ __forceinline__ unsigned pk2(float lo, float hi) { unsigned r; asm("v_cvt_pk_bf16_f32 %0, %1, %2" : "=v"(r) : "v"(lo), "v"(hi)); return r; }
__device__ __forceinline__ float lo16(unsigned w) { return __uint_as_float(w << 16); }
__device__ __forceinline__ float hi16(unsigned w) { return __uint_as_float(w & 0xffff0000u); }
__device__ __forceinline__ float fast_exp2(float x) { return __builtin_amdgcn_exp2f(x); }
__device__ __forceinline__ float fast_rcp(float x) { return __builtin_amdgcn_rcpf(x); }
__device__ __forceinline__ float sigmoidf_(float x) { return fast_rcp(1.0f + fast_exp2(-x * LOG2E)); }
__device__ __forceinline__ float siluf_(float x) { return x * sigmoidf_(x); }
__device__ __forceinline__ float wave_sum(float v) {
#pragma unroll
    for (int o = 1; o < 64; o <<= 1) v += __shfl_xor(v, o);
    return v;
}
#define LDS_WAIT() asm volatile("s_waitcnt lgkmcnt(0)" ::: "memory")
#define VM_WAIT() asm volatile("s_waitcnt vmcnt(0)" ::: "memory")

namespace pg8 {
constexpr int BM = 256, BK = 64, HALF = 128, HTB = HALF * BK * 2, STAGE_BYTES = 8 * HTB, NXCD = 8, WGM = 4;
__host__ __device__ __forceinline__ int lds_byte(int r, int c) { const int st = (r >> 4) * 2 + (c >> 5), rr = r & 15, cc = c & 31, ob = rr * 64 + cc * 2; return st * 1024 + (ob ^ (((ob >> 9) & 1) << 5)); }
__host__ __device__ __forceinline__ void stage_rc(int b, int& R, int& C) { const int st = b / 1024, sb = b % 1024, swz = sb ^ (((sb >> 9) & 1) << 5); R = (st >> 1) * 16 + swz / 64; C = (st & 1) * 32 + (swz % 64) / 2; }
__host__ __device__ __forceinline__ int perm32(int rho) { const int n = rho >> 4, i = rho & 15; return 8 * (i >> 2) + 4 * n + (i & 3); }
struct Unit { int pm, pn, sub; };
__device__ __forceinline__ unsigned cvt_pk_bf16(float lo, float hi) { unsigned r; asm volatile("v_cvt_pk_bf16_f32 %0, %1, %2" : "=v"(r) : "v"(lo), "v"(hi)); return r; }

__device__ __forceinline__ bool tile_of(long L, int nM, int nN, Unit& u) {
    const int nwg = nM * nN; if (L >= nwg) return false;
    int wgid = (int)L; { const int q = nwg / NXCD, r = nwg % NXCD, xcd = wgid % NXCD, off = wgid / NXCD; wgid = (xcd < r ? xcd * (q + 1) : r * (q + 1) + (xcd - r) * q) + off; }
    const int nig = WGM * nN, gid = wgid / nig, fm = gid * WGM, gsz = (nM - fm) < WGM ? (nM - fm) : WGM;
    u.pm = fm + ((wgid % nig) % gsz); u.pn = (wgid % nig) / gsz; u.sub = 0; return true;
}
struct ProbStd {
    const bf16_t* A; const bf16_t* Bt; int lda, ldb, K, nM, nN, G, c;
    __device__ __forceinline__ bool next(int i, Unit& u) const { return tile_of((long)i * G + c, nM, nN, u); }
    __device__ __forceinline__ const char* a_base(const Unit& u) const { return (const char*)(A + (size_t)u.pm * BM * lda); }
    __device__ __forceinline__ const char* b_base(const Unit& u) const { return (const char*)(Bt + (size_t)u.pn * BM * ldb); }
    __device__ __forceinline__ bool is_i8(const Unit&) const { return false; }
    __device__ __forceinline__ bool keep_acc(const Unit&) const { return false; }
    __device__ __forceinline__ int nt(const Unit&) const { return K / BK; }
};
struct ProbSplit {
    const bf16_t* A; const bf16_t* Bt; int lda, ldb, K, nM, G, c;
    __device__ __forceinline__ bool next(int i, Unit& u) const {
        if (i < 2) { const bool ok = tile_of((long)i * G + c, 64, 8, u); u.pm = 63 - u.pm; return ok; }
        if (i > 2 || nM == 64) return false;
        const int q = c >> 2; u.pm = 64 + (q >> 3); u.pn = q & 7; u.sub = 1 + (c & 3); return true; }
    __device__ __forceinline__ int nt(const Unit& u) const { return u.sub ? K / (4 * BK) : K / BK; }
    __device__ __forceinline__ const char* a_base(const Unit& u) const { return (const char*)(A + (size_t)u.pm * BM * lda + (u.sub ? (u.sub - 1) * (K / 4) : 0)); }
    __device__ __forceinline__ const char* b_base(const Unit& u) const { return (const char*)(Bt + (size_t)u.pn * BM * ldb + (u.sub ? (u.sub - 1) * (K / 4) : 0)); }
    __device__ __forceinline__ bool is_i8(const Unit&) const { return false; }
    __device__ __forceinline__ bool keep_acc(const Unit&) const { return false; }
};
struct ProbWin {
    const bf16_t* A; const bf16_t* Bt; int lda, ldb, K, full, G, c;
    __device__ __forceinline__ bool next(int i, Unit& u) const {
        const int L = i * G + c, per = full ? 33 : 19;
        Unit t; const bool lat = tile_of(L < 64 * 33 ? L : 0, 64, 33, t);
        const int r = L - 64 * 33, rr = r < 0 ? 0 : r, j = rr % per;
        const int cpn = full ? j : j + 6 + (j >= 2 ? 4 : 0) + (j >= 10 ? 4 : 0);
        const bool isl = L < 64 * 33;
        u.pm = isl ? t.pm : 64 + rr / per; u.pn = isl ? t.pn : cpn; u.sub = 0;
        return isl ? lat : (r < 8 * per); }
    __device__ __forceinline__ bool is_i8(const Unit&) const { return false; }
    __device__ __forceinline__ const char* a_base(const Unit& u) const { return (const char*)(A + (size_t)u.pm * BM * lda); }
    __device__ __forceinline__ const char* b_base(const Unit& u) const { return (const char*)(Bt + (size_t)u.pn * BM * ldb); }
    __device__ __forceinline__ bool keep_acc(const Unit&) const { return false; }
    __device__ __forceinline__ size_t a_kstep() const { return (size_t)BK * 2; }
    __device__ __forceinline__ int nt(const Unit&) const { return K / BK; }
};
struct ProbGate {
    const bf16_t* A8; const bf16_t* Bt; int lda, ldb, K, nM, G, c;
    __device__ __forceinline__ bool next(int i, Unit& u) const { const bool ok = tile_of((long)i * G + c, nM, 24, u); u.pn += GT0; return ok; }
    __device__ __forceinline__ bool is_i8(const Unit&) const { return true; }
    __device__ __forceinline__ const char* a_base(const Unit& u) const { return (const char*)(A8 + (size_t)u.pm * BM * lda); }
    __device__ __forceinline__ const char* b_base(const Unit& u) const { return (const char*)(Bt + (size_t)u.pn * BM * ldb); }
    __device__ __forceinline__ bool keep_acc(const Unit&) const { return false; }
    __device__ __forceinline__ size_t a_kstep() const { return (size_t)BK * 2; }
    __device__ __forceinline__ int nt(const Unit&) const { return K / BK; }
};
struct ProbWin57 {
    const bf16_t* A; const bf16_t* A8; const bf16_t* Bt; int lda, ldb, K, full, G, c;
    __device__ __forceinline__ bool next(int i, Unit& u) const {
        const int L = i * G + c, per = full ? 57 : 19;
        Unit t; const bool lat = tile_of(L < 64 * 57 ? L : 0, 64, 57, t);
        const int r = L - 64 * 57, rr = r < 0 ? 0 : r, j = rr % per;
        const int cpn = full ? j : j + 6 + (j >= 2 ? 4 : 0) + (j >= 10 ? 4 : 0);
        const bool isl = L < 64 * 57;
        u.pm = isl ? t.pm : 64 + rr / per; u.pn = isl ? t.pn : cpn; u.sub = 0;
        return isl ? lat : (r < 8 * per); }
    __device__ __forceinline__ const char* a_base(const Unit& u) const { return (const char*)((MK_I8GATE && u.pn >= GT0 ? A8 : A) + (size_t)u.pm * BM * lda); }
    __device__ __forceinline__ const char* b_base(const Unit& u) const { return (const char*)(Bt + (size_t)u.pn * BM * ldb); }
    __device__ __forceinline__ bool is_i8(const Unit& u) const { return MK_I8GATE && u.pn >= GT0; }
    __device__ __forceinline__ bool keep_acc(const Unit&) const { return false; }
    __device__ __forceinline__ int nt(const Unit& u) const { return (MK_I8GATE && u.pn >= GT0) ? K / (2 * BK) : K / BK; }
};
struct ProbMerge {
    const bf16_t* A; const bf16_t* Bt; int lda, ldb, K, nM, nN, G, c;
    __device__ __forceinline__ bool next(int i, Unit& u) const { const int t = i / 3; const bool ok = tile_of((long)t * G + c, nM, nN, u); u.sub = i - 3 * t; return ok; }
    __device__ __forceinline__ const char* a_base(const Unit& u) const { return (const char*)(A + (size_t)u.pm * BM * lda + u.sub * 1024); }
    __device__ __forceinline__ const char* b_base(const Unit& u) const { return (const char*)(Bt + (size_t)u.sub * DM * 1024 + (size_t)u.pn * BM * ldb); }
    __device__ __forceinline__ bool is_i8(const Unit&) const { return false; }
    __device__ __forceinline__ bool keep_acc(const Unit& u) const { return u.sub != 2; }
    __device__ __forceinline__ int nt(const Unit&) const { return K / BK; }
};

template <class Epi, class Prob, int MODE = 0>
__device__ __forceinline__ void gemm_phase(LAS unsigned char* lds, const Prob& S, const Epi& E, const int tid) {
    const int wid = __builtin_amdgcn_readfirstlane(tid >> 6), lane = tid & 63, wr = wid >> 2, wc = wid & 3, fr = lane & 15, fq = lane >> 4;
    unsigned voffA[2], voffB[2];
#pragma unroll
    for (int i = 0; i < 2; ++i) { int R, C; stage_rc(tid * 16 + i * 8192, R, C); const int Rb = Epi::PERM ? ((R & ~31) + perm32(R & 31)) : R;
        voffA[i] = (unsigned)(R * S.lda + C) * 2u; voffB[i] = (unsigned)(Rb * S.ldb + C) * 2u; }
    const size_t kstep = (size_t)(BK * 2);
    const size_t hstepA = (size_t)HALF * S.lda * 2, hstepB = (size_t)HALF * S.ldb * 2;
    const unsigned ldsw = (unsigned)wid * 1024u;
    constexpr unsigned STAGE_BYTES_ = 8u * HTB;
    const int aoff = lds_byte(wr * 64 + fr, fq * 8), boff = lds_byte(wc * 32 + fr, fq * 8);
#define PG8_SA(b, h) (((b) * 2 + (h)) * HTB)
#define PG8_SB(b, h) ((4 + (b) * 2 + (h)) * HTB)
#define PG8_STAGE(bufoff, gbase, voff) do { _Pragma("unroll") for (int _i = 0; _i < 2; ++_i) \
        __builtin_amdgcn_global_load_lds((const unsigned*)((const char*)(gbase) + (voff)[_i]), (LAS unsigned*)(lds + (bufoff) + ldsw + _i * 8192), 16, 0, 0); } while (0)
#define PG8_LDA(dst, b, h) do { _Pragma("unroll") for (int m = 0; m < 4; ++m) _Pragma("unroll") for (int k = 0; k < 2; ++k) dst[m][k] = *(const LAS bf16x8*)(lds + PG8_SA(b, h) + aoff + m * 2048 + k * 1024); } while (0)
#define PG8_LDB(dst, b, h) do { _Pragma("unroll") for (int n = 0; n < 2; ++n) _Pragma("unroll") for (int k = 0; k < 2; ++k) dst[n][k] = *(const LAS bf16x8*)(lds + PG8_SB(b, h) + boff + n * 2048 + k * 1024); } while (0)
#define PG8_MMA_I8(ai, bj, At, Bt) do { __builtin_amdgcn_s_setprio(1); _Pragma("unroll") for (int m = 0; m < 4; ++m) _Pragma("unroll") for (int n = 0; n < 2; ++n) _Pragma("unroll") for (int k = 0; k < 2; ++k) \
        acc[ai][bj][m][n] = __builtin_bit_cast(f32x4, __builtin_amdgcn_mfma_i32_16x16x64_i8(__builtin_bit_cast(i32x4, Bt[n][k]), __builtin_bit_cast(i32x4, At[m][k]), __builtin_bit_cast(i32x4, acc[ai][bj][m][n]), 0, 0, 0)); \
        __builtin_amdgcn_s_setprio(0); } while (0)
#define PG8_MMA_BF(ai, bj, At, Bt) do { __builtin_amdgcn_s_setprio(1); _Pragma("unroll") for (int m = 0; m < 4; ++m) _Pragma("unroll") for (int n = 0; n < 2; ++n) _Pragma("unroll") for (int k = 0; k < 2; ++k) \
        acc[ai][bj][m][n] = __builtin_amdgcn_mfma_f32_16x16x32_bf16(Bt[n][k], At[m][k], acc[ai][bj][m][n], 0, 0, 0); __builtin_amdgcn_s_setprio(0); } while (0)
#define PG8_WAIT_V(n) asm volatile("s_waitcnt vmcnt(" #n ")" ::: "memory")
#define PG8_WAIT_L(n) asm volatile("s_waitcnt lgkmcnt(" #n ")" ::: "memory")
#define PG8_BAR __builtin_amdgcn_s_barrier()
#define PG8_SCHED __builtin_amdgcn_sched_barrier(0)
#define PG8_KLOOP(MMAX) \
        for (int t = 0; t < nt; t += 2) { \
            const bool last = (t == nt - 2); \
            if (Epi::LDSSC && last) E.issue_scales(cur, lds + STAGE_BYTES_ + ldsw - (unsigned)wid * 256u, wr, wc, lane); \
            const char* a1 = cA + (size_t)(t + 1) * kstep; \
            const char* a2 = last ? nA : cA + (size_t)(t + 2) * kstep; const char* b2 = last ? nB : cB + (size_t)(t + 2) * kstep; \
            const char* a3 = a2 + kstep; const char* b3 = b2 + kstep; \
            PG8_LDB(B0, 0, 0); PG8_LDB(B1, 0, 1); PG8_SCHED; PG8_LDA(At, 0, 0); PG8_STAGE(PG8_SA(1, 1), a1 + hstepA, voffA); \
            PG8_WAIT_V(8); PG8_WAIT_L(0); PG8_BAR; MMAX(0, 0, At, B0); MMAX(0, 1, At, B1); PG8_BAR; PG8_SCHED; \
            PG8_LDA(At, 0, 1); PG8_STAGE(PG8_SB(0, 0), b2, voffB); PG8_STAGE(PG8_SB(0, 1), b2 + hstepB, voffB); PG8_STAGE(PG8_SA(0, 0), a2, voffA); \
            PG8_WAIT_V(8); PG8_WAIT_L(0); PG8_BAR; MMAX(1, 0, At, B0); MMAX(1, 1, At, B1); PG8_BAR; PG8_SCHED; \
            PG8_LDB(B0, 1, 0); PG8_LDB(B1, 1, 1); PG8_SCHED; PG8_LDA(At, 1, 0); PG8_STAGE(PG8_SA(0, 1), a2 + hstepA, voffA); \
            PG8_WAIT_V(8); PG8_WAIT_L(0); PG8_BAR; MMAX(0, 0, At, B0); MMAX(0, 1, At, B1); PG8_BAR; PG8_SCHED; \
            PG8_LDA(At, 1, 1); PG8_STAGE(PG8_SB(1, 0), b3, voffB); PG8_STAGE(PG8_SB(1, 1), b3 + hstepB, voffB); PG8_STAGE(PG8_SA(1, 0), a3, voffA); \
            PG8_WAIT_V(8); PG8_WAIT_L(0); PG8_BAR; MMAX(1, 0, At, B0); MMAX(1, 1, At, B1); PG8_BAR; PG8_SCHED; \
        }
    Unit cur, nxt; int ui = 0;
    if (!S.next(0, cur)) return;
    int nt = S.nt(cur); bool i8u = S.is_i8(cur); (void)i8u;
    f32x4 acc[2][2][4][2];
#pragma unroll
    for (int a = 0; a < 2; ++a)
#pragma unroll
        for (int b = 0; b < 2; ++b)
#pragma unroll
            for (int m = 0; m < 4; ++m)
#pragma unroll
                for (int n = 0; n < 2; ++n) acc[a][b][m][n] = (f32x4){0.f, 0.f, 0.f, 0.f};
    bf16x8 At[4][2], B0[2][2], B1[2][2];
    const char* cA = S.a_base(cur); const char* cB = S.b_base(cur);
    PG8_STAGE(PG8_SB(0, 0), cB, voffB); PG8_STAGE(PG8_SB(0, 1), cB + hstepB, voffB); PG8_STAGE(PG8_SA(0, 0), cA, voffA); PG8_STAGE(PG8_SA(0, 1), cA + hstepA, voffA);
    if (wr == 1) PG8_BAR;
    PG8_WAIT_V(2); PG8_BAR;
    PG8_STAGE(PG8_SB(1, 0), cB + kstep, voffB); PG8_STAGE(PG8_SA(1, 0), cA + kstep, voffA); PG8_STAGE(PG8_SB(1, 1), cB + hstepB + kstep, voffB);
    PG8_WAIT_V(6); PG8_BAR;
    for (;;) {
        const bool has_next = S.next(ui + 1, nxt);
        const char* nA = has_next ? S.a_base(nxt) : cA; const char* nB = has_next ? S.b_base(nxt) : cB;
        if (MODE == 1 || (MODE == 2 && i8u)) { PG8_KLOOP(PG8_MMA_I8) } else { PG8_KLOOP(PG8_MMA_BF) }
        if (wr == 0) PG8_BAR;
        E(acc, cur, wr, wc, fr, fq);
        if (!has_next) break;
        if (!S.keep_acc(cur)) {
#pragma unroll
            for (int a = 0; a < 2; ++a)
#pragma unroll
                for (int b = 0; b < 2; ++b)
#pragma unroll
                    for (int m = 0; m < 4; ++m)
#pragma unroll
                        for (int n = 0; n < 2; ++n) acc[a][b][m][n] = (f32x4){0.f, 0.f, 0.f, 0.f};
        }
        cur = nxt; cA = nA; cB = nB; ++ui; nt = S.nt(cur); i8u = S.is_i8(cur);
        if (wr == 1) PG8_BAR;
    }
    PG8_WAIT_V(0);
    PG8_BAR;
#undef PG8_SA
#undef PG8_SB
#undef PG8_STAGE
#undef PG8_LDA
#undef PG8_LDB
#undef PG8_MMA_I8
#undef PG8_MMA_BF
#undef PG8_KLOOP
#undef PG8_WAIT_V
#undef PG8_WAIT_L
#undef PG8_BAR
#undef PG8_SCHED
}

struct RowMap { float* lat; float* ctx;
    __device__ __forceinline__ float* tile(int pm) const { return pm < 64 ? lat + (size_t)pm * 256 * DM : ctx + (size_t)(pm - 64) * 256 * DM; } };

template <bool I8> struct EpiSwiglu {
    static constexpr bool PERM = true;
    static constexpr bool LDSSC = I8;
    bf16_t* O;
    const float* rsc; const float* cmax;
    LAS unsigned char* ldsb;
    __device__ __forceinline__ void issue_scales(const Unit& u, LAS unsigned char* slot, int wr, int wc, int lane) const {
        const float* rp = rsc + u.pm * BM + wr * 64 + lane;
        __builtin_amdgcn_global_load_lds((const unsigned*)rp, (LAS unsigned*)slot, 4, 0, 0);
        __builtin_amdgcn_global_load_lds((const unsigned*)(rp + HALF), (LAS unsigned*)(slot + 256), 4, 0, 0);
        __builtin_amdgcn_global_load_lds((const unsigned*)(cmax + u.pn * BM + (lane >> 5) * HALF + wc * 32 + (lane & 31)), (LAS unsigned*)(slot + 512), 4, 0, 0);
    }
    __device__ __forceinline__ void operator()(f32x4 (&acc)[2][2][4][2], const Unit& u, int wr, int wc, int fr, int fq) const {
        const int row0 = u.pm * BM + wr * 64 + fr, col0 = u.pn * 128 + wc * 32 + 8 * fq;
        const LAS float* sl = (const LAS float*)(ldsb + 8 * HTB + (wr * 4 + wc) * 768);
        f32x4 cs[2][2];
        if (I8) {
#pragma unroll
            for (int bj = 0; bj < 2; ++bj)
#pragma unroll
                for (int n = 0; n < 2; ++n) cs[bj][n] = *(const LAS f32x4*)(sl + 128 + bj * 32 + 8 * fq + 4 * n) * (1.0f / 127.0f);
        }
#pragma unroll
        for (int ai = 0; ai < 2; ++ai)
#pragma unroll
            for (int m = 0; m < 4; ++m) {
                f32x4 g0 = acc[ai][0][m][0], g1 = acc[ai][0][m][1], u0 = acc[ai][1][m][0], u1 = acc[ai][1][m][1], v0, v1;
                if (I8) { const float rs = sl[ai * 64 + 16 * m + fr];
                    const i32x4 ig0 = __builtin_bit_cast(i32x4, g0), ig1 = __builtin_bit_cast(i32x4, g1), iu0 = __builtin_bit_cast(i32x4, u0), iu1 = __builtin_bit_cast(i32x4, u1);
#pragma unroll
                    for (int j = 0; j < 4; ++j) { g0[j] = (float)ig0[j] * rs * cs[0][0][j]; g1[j] = (float)ig1[j] * rs * cs[0][1][j]; u0[j] = (float)iu0[j] * rs * cs[1][0][j]; u1[j] = (float)iu1[j] * rs * cs[1][1][j]; } }
#pragma unroll
                for (int j = 0; j < 4; ++j) { v0[j] = siluf_(g0[j]) * u0[j]; v1[j] = siluf_(g1[j]) * u1[j]; }
                u32x4 w; w.x = cvt_pk_bf16(v0[0], v0[1]); w.y = cvt_pk_bf16(v0[2], v0[3]); w.z = cvt_pk_bf16(v1[0], v1[1]); w.w = cvt_pk_bf16(v1[2], v1[3]);
                *(GAS u32x4*)((GAS bf16_t*)O + (size_t)(row0 + ai * HALF + m * 16) * DFF + col0) = w; }
    }
};
struct EpiResid {
    static constexpr bool LDSSC = false; __device__ __forceinline__ void issue_scales(const Unit&, LAS unsigned char*, int, int, int) const {}
    static constexpr bool PERM = false;
    RowMap base, out; const float* mod; int modidx; float mul; float* slab;
    __device__ __forceinline__ void operator()(f32x4 (&acc)[2][2][4][2], const Unit& u, int wr, int wc, int fr, int fq) const {
        const int r9 = u.pm < 64 ? (u.pm >> 3) : 8;
        const float* sc = mod + (size_t)r9 * (NMOD * DM) + modidx * DM;
        const int rloc = wr * 64 + fr, col0 = u.pn * BM + wc * 32 + 4 * fq;
        const float* bp = base.tile(u.pm); float* op = out.tile(u.pm);
        f32x4 sv[2][2];
#pragma unroll
        for (int bj = 0; bj < 2; ++bj)
#pragma unroll
            for (int n = 0; n < 2; ++n) sv[bj][n] = *(const f32x4*)(sc + col0 + bj * HALF + n * 16) * mul;
        const bool split = u.sub != 0;
        if (split) { op = slab + ((size_t)(u.sub - 1) * NCTXR + (size_t)(u.pm - 64) * 256) * DM; bp = op; }
        const GAS float* bpg = (const GAS float*)bp; GAS float* opg = (GAS float*)op;
#pragma unroll
        for (int ai = 0; ai < 2; ++ai)
#pragma unroll
            for (int mp = 0; mp < 2; ++mp) {
                f32x4 b[2][2][2];
#pragma unroll
                for (int mm = 0; mm < 2; ++mm) { const size_t off = (size_t)(rloc + ai * HALF + (2 * mp + mm) * 16) * DM + col0;
#pragma unroll
                    for (int bj = 0; bj < 2; ++bj)
#pragma unroll
                        for (int n = 0; n < 2; ++n) b[mm][bj][n] = split ? (f32x4){0.f, 0.f, 0.f, 0.f} : *(const GAS f32x4*)(bpg + off + bj * HALF + n * 16); }
#pragma unroll
                for (int mm = 0; mm < 2; ++mm) { const size_t off = (size_t)(rloc + ai * HALF + (2 * mp + mm) * 16) * DM + col0;
#pragma unroll
                    for (int bj = 0; bj < 2; ++bj)
#pragma unroll
                        for (int n = 0; n < 2; ++n) *(GAS f32x4*)(opg + off + bj * HALF + n * 16) = b[mm][bj][n] + sv[bj][n] * acc[ai][bj][2 * mp + mm][n]; }
            }
    }
};
struct EpiP {
    static constexpr bool LDSSC = false; __device__ __forceinline__ void issue_scales(const Unit&, LAS unsigned char*, int, int, int) const {}
    static constexpr bool PERM = true;
    bf16_t* O; int ldc;
    __device__ __forceinline__ void operator()(f32x4 (&acc)[2][2][4][2], const Unit& u, int wr, int wc, int fr, int fq) const {
        char* bu = (char*)(O + (size_t)(u.pm * BM + wr * 64) * ldc + u.pn * BM + wc * 32);
        const unsigned lo = (unsigned)(fr * ldc + 8 * fq) * 2u, s_m = (unsigned)(16 * ldc) * 2u, s_ai = (unsigned)(HALF * ldc) * 2u, s_bj = (unsigned)HALF * 2u;
#pragma unroll
        for (int ai = 0; ai < 2; ++ai)
#pragma unroll
            for (int m = 0; m < 4; ++m)
#pragma unroll
                for (int bj = 0; bj < 2; ++bj) { const f32x4 v0 = acc[ai][bj][m][0], v1 = acc[ai][bj][m][1];
                    u32x4 w; w.x = cvt_pk_bf16(v0[0], v0[1]); w.y = cvt_pk_bf16(v0[2], v0[3]); w.z = cvt_pk_bf16(v1[0], v1[1]); w.w = cvt_pk_bf16(v1[2], v1[3]);
                    *(u32x4*)(bu + (size_t)(ai * s_ai + m * s_m + bj * s_bj) + lo) = w; }
    }
};
struct EpiGate {
    static constexpr bool LDSSC = false; __device__ __forceinline__ void issue_scales(const Unit&, LAS unsigned char*, int, int, int) const {}
    static constexpr bool PERM = true;
    bf16_t* G; const float* rsc; const float* cmax;
    __device__ __forceinline__ void operator()(f32x4 (&acc)[2][2][4][2], const Unit& u, int wr, int wc, int fr, int fq) const {
        char* bu = (char*)(G + ((size_t)((u.pm * 24 + (u.pn - GT0)) * 8 + wr * 4 + wc) * 16) * 512);
        const unsigned lo = (unsigned)(fq * 16 + fr) * 16u;
        const float* cm = cmax + (u.pn - GT0) * BM + wc * 32 + 8 * fq;
        const float* rp = rsc + u.pm * BM + wr * 64 + fr;
        f32x4 cs[2][2];
#pragma unroll
        for (int bj = 0; bj < 2; ++bj) { cs[bj][0] = *(const f32x4*)(cm + bj * HALF) * (1.0f / 127.0f); cs[bj][1] = *(const f32x4*)(cm + bj * HALF + 4) * (1.0f / 127.0f); }
#pragma unroll
        for (int ai = 0; ai < 2; ++ai)
#pragma unroll
            for (int m = 0; m < 4; ++m) { const float rs = rp[ai * HALF + m * 16];
#pragma unroll
                for (int bj = 0; bj < 2; ++bj) { const i32x4 i0 = __builtin_bit_cast(i32x4, acc[ai][bj][m][0]), i1 = __builtin_bit_cast(i32x4, acc[ai][bj][m][1]); f32x4 v0, v1;
#pragma unroll
                    for (int j = 0; j < 4; ++j) { if (MK_I8GATE) { v0[j] = sigmoidf_((float)i0[j] * rs * cs[bj][0][j]); v1[j] = sigmoidf_((float)i1[j] * rs * cs[bj][1][j]); } else { v0[j] = sigmoidf_(acc[ai][bj][m][0][j]); v1[j] = sigmoidf_(acc[ai][bj][m][1][j]); } }
                    u32x4 w; w.x = cvt_pk_bf16(v0[0], v0[1]); w.y = cvt_pk_bf16(v0[2], v0[3]); w.z = cvt_pk_bf16(v1[0], v1[1]); w.w = cvt_pk_bf16(v1[2], v1[3]);
                    *(u32x4*)(bu + (size_t)(ai * 8 + m * 2 + bj) * 1024 + lo) = w; } }
    }
};
struct EpiP57 {
    static constexpr bool LDSSC = false; __device__ __forceinline__ void issue_scales(const Unit&, LAS unsigned char*, int, int, int) const {}
    static constexpr bool PERM = true;
    bf16_t* O; int ldc; bf16_t* G; const float* rsc; const float* cmax;
    __device__ __forceinline__ void operator()(f32x4 (&acc)[2][2][4][2], const Unit& u, int wr, int wc, int fr, int fq) const {
        const bool gate = u.pn >= GT0;
        char* bu = gate ? (char*)(G + ((size_t)((u.pm * 24 + (u.pn - GT0)) * 8 + wr * 4 + wc) * 16) * 512)
                        : (char*)(O + (size_t)(u.pm * BM + wr * 64) * ldc + u.pn * BM + wc * 32);
        const unsigned lo = gate ? (unsigned)(fq * 16 + fr) * 16u : (unsigned)(fr * ldc + 8 * fq) * 2u;
        const unsigned s_m = gate ? 2u * 1024u : (unsigned)(16 * ldc) * 2u, s_ai = gate ? 8u * 1024u : (unsigned)(HALF * ldc) * 2u, s_bj = gate ? 1024u : (unsigned)HALF * 2u;
        f32x4 cs[2][2];
        if (MK_I8GATE && gate) { const float* cm = cmax + (u.pn - GT0) * BM + wc * 32 + 8 * fq;
#pragma unroll
            for (int bj = 0; bj < 2; ++bj) { cs[bj][0] = *(const f32x4*)(cm + bj * HALF) * (1.0f / 127.0f); cs[bj][1] = *(const f32x4*)(cm + bj * HALF + 4) * (1.0f / 127.0f); } }
        const float* rp = rsc + u.pm * BM + wr * 64 + fr;
#pragma unroll
        for (int ai = 0; ai < 2; ++ai)
#pragma unroll
            for (int m = 0; m < 4; ++m) { float rs = 1.0f; if (MK_I8GATE && gate) rs = rp[ai * HALF + m * 16];
#pragma unroll
                for (int bj = 0; bj < 2; ++bj) { f32x4 v0 = acc[ai][bj][m][0], v1 = acc[ai][bj][m][1];
                    if (gate) {
                        if (MK_I8GATE) { const i32x4 i0 = __builtin_bit_cast(i32x4, v0), i1 = __builtin_bit_cast(i32x4, v1);
#pragma unroll
                            for (int j = 0; j < 4; ++j) { v0[j] = (float)i0[j] * rs * cs[bj][0][j]; v1[j] = (float)i1[j] * rs * cs[bj][1][j]; } }
#pragma unroll
                        for (int j = 0; j < 4; ++j) { v0[j] = sigmoidf_(v0[j]); v1[j] = sigmoidf_(v1[j]); } }
                    u32x4 w; w.x = cvt_pk_bf16(v0[0], v0[1]); w.y = cvt_pk_bf16(v0[2], v0[3]); w.z = cvt_pk_bf16(v1[0], v1[1]); w.w = cvt_pk_bf16(v1[2], v1[3]);
                    *(u32x4*)(bu + (size_t)(ai * s_ai + m * s_m + bj * s_bj) + lo) = w; } }
    }
};
struct EpiKV {
    static constexpr bool LDSSC = false; __device__ __forceinline__ void issue_scales(const Unit&, LAS unsigned char*, int, int, int) const {}
    static constexpr bool PERM = true;
    bf16_t* Kb; bf16_t* Vb;
    __device__ __forceinline__ void operator()(f32x4 (&acc)[2][2][4][2], const Unit& u, int wr, int wc, int fr, int fq) const {
        const int kv0 = u.pm < 64 ? (u.pm >> 3) * KVROWS + CTX + (u.pm & 7) * 256 : (u.pm - 64) * KVROWS;
        const bool isk = u.pn < 4;
        const int ld = isk ? 1536 : 1024, bjs = isk ? 192 : 128;
        bf16_t* dst = (isk ? Kb + u.pn * 384 : Vb + (u.pn - 4) * 256) + (size_t)(kv0 + wr * 64 + fr) * ld + wc * 32 + 8 * fq;
#pragma unroll
        for (int ai = 0; ai < 2; ++ai)
#pragma unroll
            for (int m = 0; m < 4; ++m)
#pragma unroll
                for (int bj = 0; bj < 2; ++bj) { const f32x4 v0 = acc[ai][bj][m][0], v1 = acc[ai][bj][m][1];
                    u32x4 w; w.x = cvt_pk_bf16(v0[0], v0[1]); w.y = cvt_pk_bf16(v0[2], v0[3]); w.z = cvt_pk_bf16(v1[0], v1[1]); w.w = cvt_pk_bf16(v1[2], v1[3]);
                    *(u32x4*)(dst + (size_t)(ai * HALF + m * 16) * ld + bj * bjs) = w; }
    }
};
struct EpiMerge {
    static constexpr bool LDSSC = false; __device__ __forceinline__ void issue_scales(const Unit&, LAS unsigned char*, int, int, int) const {}
    static constexpr bool PERM = true;
    const bf16_t* G; bf16_t* O;
    __device__ __forceinline__ void operator()(f32x4 (&acc)[2][2][4][2], const Unit& u, int wr, int wc, int fr, int fq) const {
        const int row0 = u.pm * BM + wr * 64 + fr, col0 = u.pn * BM + wc * 32 + 8 * fq;
        const bf16_t* gp = G + ((size_t)((u.pm * 24 + u.sub * 8 + u.pn) * 8 + wr * 4 + wc) * 16) * 512 + (fq * 16 + fr) * 8;
        constexpr size_t NEXTB = (size_t)8 * 8 * 16 * 512;
#pragma unroll
        for (int ai = 0; ai < 2; ++ai)
#pragma unroll
            for (int m = 0; m < 4; ++m) { const size_t row = (size_t)(row0 + ai * HALF + m * 16);
#pragma unroll
                for (int bj = 0; bj < 2; ++bj) {
                    const bf16_t* gq = gp + ((ai * 4 + m) * 2 + bj) * 512;
                    const u32x4 ga = *(const u32x4*)gq;
                    float f[8] = {lo16(ga.x), hi16(ga.x), lo16(ga.y), hi16(ga.y), lo16(ga.z), hi16(ga.z), lo16(ga.w), hi16(ga.w)};
                    if (u.sub != 2) { const u32x4 gb = *(const u32x4*)(gq + NEXTB);
                        const float d[8] = {lo16(gb.x), hi16(gb.x), lo16(gb.y), hi16(gb.y), lo16(gb.z), hi16(gb.z), lo16(gb.w), hi16(gb.w)};
#pragma unroll
                        for (int j = 0; j < 8; ++j) f[j] = f[j] * fast_rcp(fmaxf(d[j], 1e-20f)); }
                    f32x4 v0 = acc[ai][bj][m][0], v1 = acc[ai][bj][m][1];
#pragma unroll
                    for (int j = 0; j < 4; ++j) { v0[j] *= f[j]; v1[j] *= f[4 + j]; }
                    acc[ai][bj][m][0] = v0; acc[ai][bj][m][1] = v1;
                    if (u.sub == 2) { u32x4 w; w.x = cvt_pk_bf16(v0[0], v0[1]); w.y = cvt_pk_bf16(v0[2], v0[3]); w.z = cvt_pk_bf16(v1[0], v1[1]); w.w = cvt_pk_bf16(v1[2], v1[3]);
                        *(u32x4*)(O + row * DM + col0 + bj * HALF) = w; } } }
    }
};
}

#define XB_TMO      128
#define XB_XCNT(j)  (256  + 64 * (j))
#define XB_XSUB(j)  (1280 + 64 * (j))
#define XB_XGEN(j)  (2304 + 64 * (j))
#define XB_TOP      3328
#define XB_TOPGEN   3392
#define XCD_BAR_WORDS 3456
#define XB_SPIN_CAP (1u << 22)
__device__ __forceinline__ unsigned xb_ld(unsigned* p)              { return __hip_atomic_load(p, __ATOMIC_RELAXED, __HIP_MEMORY_SCOPE_AGENT); }
__device__ __forceinline__ unsigned xb_add(unsigned* p, unsigned v) { return __hip_atomic_fetch_add(p, v, __ATOMIC_RELAXED, __HIP_MEMORY_SCOPE_AGENT); }
__device__ __forceinline__ unsigned xb_xcc_id() { return (unsigned)__builtin_amdgcn_s_getreg((3 << 11) | 20) & 0xFu; }
#define XB_SPIN(cond, bar) do { unsigned _sp = 0; while (cond) { __builtin_amdgcn_s_sleep(1); \
    if ((++_sp & 255u) == 0u) { if (xb_ld(&(bar)[XB_TMO])) break; if (_sp > XB_SPIN_CAP) { atomicAdd(&(bar)[XB_TMO], 1u); break; } } } } while (0)
struct XcdBarrier { unsigned* bar; unsigned x; volatile LAS unsigned* st; };
__device__ __forceinline__ XcdBarrier xcd_barrier_post(unsigned* bar, volatile LAS unsigned* st) {
    XcdBarrier b; b.bar = bar; b.x = xb_xcc_id(); b.st = st;
    if (threadIdx.x == 0) (void)xb_add(&bar[XB_XCNT(b.x)], 1u);
    return b;
}
__device__ __forceinline__ void xcd_barrier_complete(unsigned* bar, unsigned x, unsigned& nloc, unsigned& nx) {
    const unsigned G = gridDim.x * gridDim.y * gridDim.z;
    unsigned sum, cnt, mine, sp = 0u;
    for (;;) {
        sum = 0u; cnt = 0u; mine = 0u;
#pragma unroll
        for (unsigned j = 0; j < 16; ++j) { const unsigned c = xb_ld(&bar[XB_XCNT(j)]); sum += c; cnt += (c > 0u) ? 1u : 0u; mine = (j == x) ? c : mine; }
        if (sum == G) break;
        __builtin_amdgcn_s_sleep(1);
        if ((++sp & 255u) == 0u) { if (xb_ld(&bar[XB_TMO])) break; if (sp > XB_SPIN_CAP) { atomicAdd(&bar[XB_TMO], 1u); break; } }
    }
    nloc = mine > 0u ? mine : 1u; nx = cnt > 0u ? cnt : 1u;
}
__device__ __forceinline__ void xcd_barrier(const XcdBarrier& b) {
    asm volatile("s_waitcnt vmcnt(0)" ::: "memory");
    __syncthreads();
    if (threadIdx.x == 0) {
        unsigned* bar = b.bar;
        __builtin_amdgcn_s_waitcnt(0);
        unsigned nloc = b.st[0], nx = b.st[1];
        if (nloc == 0u) { xcd_barrier_complete(bar, b.x, nloc, nx); b.st[0] = nloc; b.st[1] = nx; }
        const unsigned old = xb_add(&bar[XB_XSUB(b.x)], 1u);
        const unsigned gen = old / nloc;
        if (old + 1u == (gen + 1u) * nloc) {
            __builtin_amdgcn_fence(__ATOMIC_RELEASE, "agent");
            asm volatile("s_waitcnt vmcnt(0)" ::: "memory");
            const unsigned og = xb_add(&bar[XB_TOP], 1u);
            const unsigned tg = og / nx;
            if (og + 1u == (tg + 1u) * nx) xb_add(&bar[XB_TOPGEN], 1u);
            else XB_SPIN(xb_ld(&bar[XB_TOPGEN]) == tg, bar);
            __builtin_amdgcn_fence(__ATOMIC_ACQUIRE, "agent");
            xb_add(&bar[XB_XGEN(b.x)], 1u);
            asm volatile("s_waitcnt vmcnt(0)" ::: "memory");
        } else {
            XB_SPIN(xb_ld(&bar[XB_XGEN(b.x)]) == gen, bar);
            __builtin_amdgcn_fence(__ATOMIC_ACQUIRE, "agent");
            asm volatile("s_waitcnt vmcnt(0)" ::: "memory");
        }
    }
    __syncthreads();
}

struct Args { const float* in[30]; float* out; unsigned char* ws; int st_lo, st_hi; };
enum { I_X = 0, I_C, I_CTX, I_CCTX, I_WADA, I_BADA, I_NORMG, I_F1G, I_F1U, I_F1D, I_F2G, I_F2U, I_F2D, I_WIN, I_KVG, I_WUK, I_WUV, I_QG, I_KG, I_CONVW, I_CONVB, I_ALOG, I_DTB, I_SSDD, I_SSDG, I_NAQG, I_NAKG, I_RPB, I_WBR, I_WOUT };

constexpr int GRID = 256;
struct Frame {
    LAS unsigned char* lds; int tid, lane, wave, bid; static constexpr int G = GRID;
    const float* const* in; float* out; unsigned char* ws;
    __device__ __forceinline__ bf16_t* wsb(size_t off) const { return (bf16_t*)(ws + off); }
    __device__ __forceinline__ float* wsf(size_t off) const { return (float*)(ws + off); }
};

__device__ __forceinline__ int row_r9(int row) { return row < NLAT ? (row >> 11) : 8; }
__device__ __forceinline__ int row_kv(int row) { return row < NLAT ? (row >> 11) * KVROWS + CTX + (row & 2047) : ((row - NLAT) >> 8) * KVROWS + ((row - NLAT) & 255); }

__device__ __forceinline__ void transpose_item(const float* W, int N, int src_n0, bf16_t* WT, int ldt, int dst_n0, int k0, LAS float* scr, int lane) {
    if (src_n0 >= 0) {
        const GAS float* src = (const GAS float*)W + (size_t)(k0 + (lane >> 3)) * N + src_n0 + 4 * (lane & 7);
        f32x4 v[8];
#pragma unroll
        for (int i = 0; i < 8; ++i) v[i] = *(const GAS f32x4*)(src + (size_t)(8 * i) * N);
#pragma unroll
        for (int i = 0; i < 8; ++i) { LAS float* d = scr + (8 * i + (lane >> 3)) * 33 + 4 * (lane & 7); d[0] = v[i].x; d[1] = v[i].y; d[2] = v[i].z; d[3] = v[i].w; }
    } else {
#pragma unroll 8
        for (int i = 0; i < 32; ++i) { const int kk = 2 * i + (lane >> 5); scr[kk * 33 + (lane & 31)] = 0.f; }
    }
    LDS_WAIT(); asm volatile("" ::: "memory");
    const int c = lane & 7;
#pragma unroll
    for (int j = 0; j < 4; ++j) { const int n = (lane >> 3) + 8 * j; const LAS float* s = scr + (8 * c) * 33 + n;
        u32x4 o; o.x = pk2(s[0 * 33], s[1 * 33]); o.y = pk2(s[2 * 33], s[3 * 33]); o.z = pk2(s[4 * 33], s[5 * 33]); o.w = pk2(s[6 * 33], s[7 * 33]);
        *(GAS u32x4*)(WT + (size_t)(dst_n0 + n) * ldt + k0 + 8 * c) = o; }
    LDS_WAIT(); asm volatile("" ::: "memory");
}
__device__ __forceinline__ int win_src_col(int n) {
    if (n < 2048) return n;
    if (n < 5120) return n + 64;
    if (n < 8192) return n + 96;
    if (n < 8256) return n - 6144;
    if (n < 8288) return n - 3072;
    if (n < 8448) return -1;
    return n - 160;
}
__device__ __forceinline__ void absmax_item(const float* W, int N, int src_n0, unsigned* cmax, int k0, int lane) {
    float m = 0.f;
#pragma unroll 8
    for (int i = 0; i < 32; ++i) { const int kk = 2 * i + (lane >> 5); m = fmaxf(m, fabsf(W[(size_t)(k0 + kk) * N + src_n0 + (lane & 31)])); }
    m = fmaxf(m, __shfl_xor(m, 32));
    if (lane < 32) atomicMax(cmax + lane, __float_as_uint(m));
}
__device__ __forceinline__ void quant_item(const float* W, int N, int src_n0, unsigned char* WT8, int dst_n0, int k0, const unsigned* cmax, LAS float* scr, int lane) {
#pragma unroll 8
    for (int i = 0; i < 32; ++i) { const int kk = 2 * i + (lane >> 5); scr[kk * 33 + (lane & 31)] = W[(size_t)(k0 + kk) * N + src_n0 + (lane & 31)]; }
    LDS_WAIT(); asm volatile("" ::: "memory");
    const int c = lane & 3;
#pragma unroll
    for (int j = 0; j < 2; ++j) { const int n = (lane >> 2) + 16 * j; const float mx = __uint_as_float(cmax[n]), inv = mx > 0.f ? 127.0f / mx : 0.f;
        const LAS float* sp = scr + (16 * c) * 33 + n; unsigned w[4];
#pragma unroll
        for (int d = 0; d < 4; ++d) { unsigned x = 0;
#pragma unroll
            for (int e = 0; e < 4; ++e) { int q = __float2int_rn(sp[(4 * d + e) * 33] * inv); q = q > 127 ? 127 : (q < -127 ? -127 : q); x |= ((unsigned)q & 255u) << (8 * e); }
            w[d] = x; }
        *(GAS u32x4*)(WT8 + (size_t)(dst_n0 + n) * 4096 + k0 + 16 * c) = (u32x4){w[0], w[1], w[2], w[3]}; }
    LDS_WAIT(); asm volatile("" ::: "memory");
}
__device__ __forceinline__ void quant_block(const Frame& F, const float* W, int N, int src_n0, unsigned char* WT8, int dst_n0, float* cmax_out) {
    constexpr int QP = 4104;
    LAS unsigned char* LT = F.lds; LAS float* red = (LAS float*)(F.lds + 32 * QP); LAS float* cml = red + 256;
    int tq = F.tid; asm volatile("" : "+v"(tq));
    const int lane = tq & 63, n = lane & 31, kp = lane >> 5;
    __syncthreads();
    {
        (void)n; (void)kp;
        const int c4 = lane & 7, kr = lane >> 3;
        const GAS float* src = (const GAS float*)W + (size_t)(F.wave * 256 + kr) * N + src_n0 + 4 * c4;
        LAS unsigned char* lcol = LT + (4 * c4) * QP + (F.wave * 256 + kr) * 2;
        float m0 = 0.f, m1 = 0.f, m2 = 0.f, m3 = 0.f;
#pragma unroll 1
        for (int i0 = 0; i0 < 32; i0 += 16) { f32x4 v[16];
#pragma unroll
            for (int j = 0; j < 16; ++j) v[j] = *(const GAS f32x4*)(src + (size_t)(8 * (i0 + j)) * N);
#pragma unroll
            for (int j = 0; j < 16; ++j) { m0 = fmaxf(m0, fabsf(v[j].x)); m1 = fmaxf(m1, fabsf(v[j].y)); m2 = fmaxf(m2, fabsf(v[j].z)); m3 = fmaxf(m3, fabsf(v[j].w));
                LAS unsigned char* d = lcol + 16 * (i0 + j);
                *(LAS bf16_t*)(d) = (bf16_t)(pk2(v[j].x, v[j].x) & 0xffffu); *(LAS bf16_t*)(d + QP) = (bf16_t)(pk2(v[j].y, v[j].y) & 0xffffu);
                *(LAS bf16_t*)(d + 2 * QP) = (bf16_t)(pk2(v[j].z, v[j].z) & 0xffffu); *(LAS bf16_t*)(d + 3 * QP) = (bf16_t)(pk2(v[j].w, v[j].w) & 0xffffu); } }
#pragma unroll
        for (int o = 8; o < 64; o <<= 1) { m0 = fmaxf(m0, __shfl_xor(m0, o)); m1 = fmaxf(m1, __shfl_xor(m1, o)); m2 = fmaxf(m2, __shfl_xor(m2, o)); m3 = fmaxf(m3, __shfl_xor(m3, o)); }
        if (lane < 8) { LAS float* r = red + F.wave * 32 + 4 * lane; r[0] = m0; r[1] = m1; r[2] = m2; r[3] = m3; }
    }
    __syncthreads();
    if (tq < 32) { float mx = red[tq];
#pragma unroll
        for (int w = 1; w < 8; ++w) mx = fmaxf(mx, red[w * 32 + tq]);
        cml[tq] = mx; cmax_out[tq] = mx; }
    __syncthreads();
    {   const int nn = tq >> 4, c = tq & 15; const float mx = cml[nn], inv = mx > 0.f ? 127.0f / mx : 0.f;
        const LAS unsigned char* lr = LT + nn * QP; unsigned char* orow = WT8 + (size_t)(dst_n0 + nn) * 4096;
#pragma unroll
        for (int j = 0; j < 8; ++j) { const int k0 = (c + 16 * j) * 16; unsigned w4[4];
#pragma unroll
            for (int d = 0; d < 4; ++d) { const u32x2 pr = *(const LAS u32x2*)(lr + k0 * 2 + d * 8);
                int q0 = __float2int_rn(lo16(pr.x) * inv), q1 = __float2int_rn(hi16(pr.x) * inv), q2 = __float2int_rn(lo16(pr.y) * inv), q3 = __float2int_rn(hi16(pr.y) * inv);
                w4[d] = ((unsigned)q0 & 255u) | (((unsigned)q1 & 255u) << 8) | (((unsigned)q2 & 255u) << 16) | ((unsigned)q3 << 24); }
            *(GAS u32x4*)(orow + k0) = (u32x4){w4[0], w4[1], w4[2], w4[3]}; }
    }
}
__device__ __forceinline__ void phase_convert(const Frame& F, int l) {
    const int gw = F.bid * 8 + F.wave, NGW = F.G * 8;
    constexpr int I_GU = 32 * 352, I_DN = 88 * 64, I_IN = 32 * 456, I_UKV = 8 * 64, I_BR = 16 * 64, I_OUT = 32 * 64;
    constexpr int NITEMS = 2 * I_GU + 2 * I_DN + I_IN + I_UKV + 3 * I_BR + I_OUT;
    const size_t ffo = (size_t)l * DM * DFF;
    float* CM = (float*)(F.ws + WS_CMAX) + (size_t)l * NQCOL;
    {   constexpr int QB = (MK_I8GU ? 704 : 0) + (MK_I8GATE ? 192 : 0);
        for (int qi = F.bid; qi < QB; qi += F.G) { int r = qi;
            if (MK_I8GU && r < 704) { const int s = r >= 352 ? 1 : 0, nb = r - s * 352, pn = nb >> 3, jb = nb & 7;
                const float* W = F.in[(s ? I_F2G : I_F1G) + (jb >= 4 ? 1 : 0)] + ffo;
                quant_block(F, W, DFF, pn * 128 + (jb & 3) * 32, F.ws + (s ? WS_WGU2 : WS_WGU1), nb * 32, CM + s * 11264 + nb * 32); continue; }
            if (MK_I8GU) r -= 704;
            { const int nb = 264 + r;
              quant_block(F, F.in[I_WIN] + (size_t)l * DM * DIN, DIN, win_src_col(nb * 32), F.ws + WS_WIN, nb * 32, CM + 22528 + (nb - 264) * 32); } }
        __syncthreads();
    }
    LAS float* scr = (LAS float*)(F.lds + F.wave * 16384);
    for (int it = gw; it < NITEMS; it += NGW) {
        int r = it;
        if (r < 2 * I_GU) { if (MK_I8GU) continue; const int s = r >= I_GU; r -= s * I_GU; const int kb = r / 352, nb = r % 352, pn = nb >> 3, jb = nb & 7;
            const float* W = F.in[(s ? I_F2G : I_F1G) + (jb >= 4 ? 1 : 0)] + ffo;
            transpose_item(W, DFF, pn * 128 + (jb & 3) * 32, F.wsb(s ? WS_WGU2 : WS_WGU1), DM, nb * 32, kb * 64, scr, F.lane);
            continue; }
        r -= 2 * I_GU;
        if (r < 2 * I_DN) { const int s = r >= I_DN; r -= s * I_DN; const int kb = r / 64, nb = r % 64;
            transpose_item(F.in[s ? I_F2D : I_F1D] + ffo, DM, nb * 32, F.wsb(s ? WS_WDN2 : WS_WDN1), DFF, nb * 32, kb * 64, scr, F.lane); continue; }
        r -= 2 * I_DN;
        if (r < I_IN) { const int kb = r / 456, nb = r % 456;
            if (MK_I8GATE && nb >= 264) continue;
            transpose_item(F.in[I_WIN] + (size_t)l * DM * DIN, DIN, win_src_col(nb * 32), F.wsb(WS_WIN), DM, nb * 32, kb * 64, scr, F.lane);
            continue; }
        r -= I_IN;
        if (r < I_UKV) { const int kb = r / 64, nb = r % 64;
            transpose_item(F.in[nb < 32 ? I_WUK : I_WUV] + (size_t)l * 512 * 1024, 1024, (nb & 31) * 32, F.wsb(WS_WUKV), 512, nb * 32, kb * 64, scr, F.lane); continue; }
        r -= I_UKV;
        if (r < 3 * I_BR) { const int i = r / I_BR; r -= i * I_BR; const int kb = r / 64, nb = r % 64;
            transpose_item(F.in[I_WBR] + ((size_t)l * 3 + i) * 1024 * DM, DM, nb * 32, F.wsb(WS_WBR) + (size_t)i * DM * 1024, 1024, nb * 32, kb * 64, scr, F.lane); continue; }
        r -= 3 * I_BR;
        { const int kb = r / 64, nb = r % 64;
            transpose_item(F.in[I_WOUT] + (size_t)l * DM * DM, DM, nb * 32, F.wsb(WS_WOUT), DM, nb * 32, kb * 64, scr, F.lane); }
    }
}

__device__ __forceinline__ void phase_adaln(const Frame& F) {
    LAS float* sc = (LAS float*)F.lds;
    LAS float* red = (LAS float*)(F.lds + 16384);
    float* MOD = F.wsf(WS_MOD);
    if (F.bid == 0) {
        for (int i = F.tid; i < 1024; i += 512) { const int pos = i >> 4, f = i & 15;
            const float inv = fast_exp2(-(float)f * (13.287712379549449f / 16.0f)); const float ang = (float)pos * inv;
            ((f32x2*)F.wsf(WS_ROPE))[i] = (f32x2){cosf(ang), sinf(ang)}; }
    }
    for (int it = F.bid; it < 2 * 72 * 8; it += F.G) {
        const int l = it / 576, r0 = it % 576, cb = r0 >> 3, ks = r0 & 7, k0 = ks * 256, col0 = cb * 256;
        __syncthreads();
        for (int i = F.tid; i < 9 * 256; i += 512) { const int r = i >> 8, k = i & 255;
            const float c = r < 8 ? F.in[I_C][r * DM + k0 + k] : F.in[I_CCTX][k0 + k]; sc[i] = siluf_(c) ; }
        __syncthreads();
        const float* W = F.in[I_WADA] + ((size_t)l * DM + k0 + F.wave * 32) * (NMOD * DM) + col0 + 4 * F.lane;
        f32x4 acc[9];
#pragma unroll
        for (int r = 0; r < 9; ++r) acc[r] = (f32x4){0.f, 0.f, 0.f, 0.f};
#pragma unroll 4
        for (int kk = 0; kk < 32; ++kk) { const f32x4 w = *(const f32x4*)(W + (size_t)kk * (NMOD * DM));
#pragma unroll
            for (int r = 0; r < 9; ++r) acc[r] += w * sc[r * 256 + F.wave * 32 + kk]; }
#pragma unroll
        for (int r = 0; r < 9; ++r) *(LAS f32x4*)(red + (F.wave * 9 + r) * 256 + 4 * F.lane) = acc[r];
        __syncthreads();
        for (int i = F.tid; i < 9 * 256; i += 512) { float s = 0.f;
#pragma unroll
            for (int w = 0; w < 8; ++w) s += red[w * 2304 + i];
            const int r = i >> 8, j = col0 + (i & 255);
            if (ks == 0) s += F.in[I_BADA][(size_t)l * (NMOD * DM) + j];
            atomicAdd(MOD + ((size_t)l * 9 + r) * (NMOD * DM) + j, s); }
    }
}

__device__ __forceinline__ void phase_norm(const Frame& F, const float* lat, const float* ctx, const float* g, const float* mod, int base, bf16_t* U, int nrows, float* hcw, const float* slab, unsigned char* U8, float* rsc) {
    const int gw = F.bid * 8 + F.wave, NGW = F.G * 8;
    static_assert(NLAT == 8 * GRID * 8 && NCTXR == GRID * 8, "row deal of phase_norm");
    const int per = nrows > NLAT ? 9 : 8; (void)NGW;
    f32x4 ga[8], sh[8]; int cur = -1;
    for (int i = 0; i < per; ++i) {
        const int row = i < 8 ? gw * 8 + i : NLAT + gw;
        const int r9 = row_r9(row);
        if (r9 != cur) { cur = r9; const float* ms = mod + (size_t)r9 * (NMOD * DM) + base * DM;
#pragma unroll
            for (int j = 0; j < 8; ++j) { const int c = 4 * F.lane + 256 * j; const f32x4 gg = *(const f32x4*)(g + c), scl = *(const f32x4*)(ms + DM + c); sh[j] = *(const f32x4*)(ms + c); ga[j] = gg * (scl + 1.0f); } }
        const float* xr = row < NLAT ? lat + (size_t)row * DM : ctx + (size_t)(row - NLAT) * DM;
        f32x4 v[8]; float s = 0.f;
#pragma unroll
        for (int j = 0; j < 8; ++j) v[j] = *(const f32x4*)(xr + 4 * F.lane + 256 * j);
        if (row >= NLAT && hcw) {
            if (slab) {
#pragma unroll
                for (int q = 0; q < 4; ++q) { const float* sp = slab + ((size_t)q * NCTXR + (row - NLAT)) * DM + 4 * F.lane;
#pragma unroll
                    for (int j = 0; j < 8; ++j) v[j] += *(const f32x4*)(sp + 256 * j); } }
            float* hw = hcw + (size_t)(row - NLAT) * DM + 4 * F.lane;
#pragma unroll
            for (int j = 0; j < 8; ++j) *(f32x4*)(hw + 256 * j) = v[j];
        }
#pragma unroll
        for (int j = 0; j < 8; ++j) s += (v[j].x * v[j].x + v[j].y * v[j].y) + (v[j].z * v[j].z + v[j].w * v[j].w);
        const float rs = rsqrtf(wave_sum(s) * (1.0f / DM) + EPS);
        float amax = 0.f;
#pragma unroll
        for (int j = 0; j < 8; ++j) { v[j] = v[j] * rs * ga[j] + sh[j]; amax = fmaxf(fmaxf(amax, fmaxf(fabsf(v[j].x), fabsf(v[j].y))), fmaxf(fabsf(v[j].z), fabsf(v[j].w))); }
        if (U) { bf16_t* o = U + (size_t)row * DM;
#pragma unroll
            for (int j = 0; j < 8; ++j) { u32x2 w; w.x = pk2(v[j].x, v[j].y); w.y = pk2(v[j].z, v[j].w); *(u32x2*)(o + 4 * F.lane + 256 * j) = w; } }
        if (U8) {
#pragma unroll
            for (int o = 1; o < 64; o <<= 1) amax = fmaxf(amax, __shfl_xor(amax, o));
            const float inv = amax > 0.f ? 127.0f / amax : 0.f;
            unsigned* o8 = (unsigned*)(U8 + (size_t)row * 4096);
#pragma unroll
            for (int j = 0; j < 8; ++j) { const int q0 = __float2int_rn(v[j].x * inv), q1 = __float2int_rn(v[j].y * inv), q2 = __float2int_rn(v[j].z * inv), q3 = __float2int_rn(v[j].w * inv);
                o8[F.lane + 64 * j] = ((unsigned)q0 & 255u) | (((unsigned)q1 & 255u) << 8) | (((unsigned)q2 & 255u) << 16) | ((unsigned)q3 << 24); }
            if (F.lane == 0) rsc[row] = amax * (1.0f / 127.0f);
        }
    }
}

__device__ __forceinline__ void norm192_rope(float (&nope)[16], float (&x1)[4], float (&x2)[4], const float* g, const f32x2* rope, bool lat, int t, int p, float scale) {
    float ss = 0.f;
#pragma unroll
    for (int i = 0; i < 16; ++i) ss += nope[i] * nope[i];
#pragma unroll
    for (int i = 0; i < 4; ++i) ss += x1[i] * x1[i] + x2[i] * x2[i];
    ss += __shfl_xor(ss, 1); ss += __shfl_xor(ss, 2); ss += __shfl_xor(ss, 4);
    const float rs = rsqrtf(ss * (1.0f / 192.0f) + EPS);
    const int a = p >> 2, f0 = (p & 3) * 4;
#pragma unroll
    for (int i = 0; i < 16; ++i) nope[i] = nope[i] * rs * g[p * 16 + i] * scale;
#pragma unroll
    for (int i = 0; i < 4; ++i) { x1[i] = x1[i] * rs * g[128 + a * 32 + f0 + i]; x2[i] = x2[i] * rs * g[128 + a * 32 + 16 + f0 + i]; }
    if (lat) { const int pos = a == 0 ? (t >> 6) : (t & 63);
#pragma unroll
        for (int i = 0; i < 4; ++i) { const f32x2 cs = rope[pos * 16 + f0 + i]; const float y1 = x1[i] * cs.x - x2[i] * cs.y, y2 = x2[i] * cs.x + x1[i] * cs.y; x1[i] = y1; x2[i] = y2; } }
#pragma unroll
    for (int i = 0; i < 4; ++i) { x1[i] *= scale; x2[i] *= scale; }
}
__device__ __forceinline__ void ld16(const bf16_t* p, float (&v)[16]) { const u32x4 a = *(const u32x4*)p, b = *(const u32x4*)(p + 8);
    v[0] = lo16(a.x); v[1] = hi16(a.x); v[2] = lo16(a.y); v[3] = hi16(a.y); v[4] = lo16(a.z); v[5] = hi16(a.z); v[6] = lo16(a.w); v[7] = hi16(a.w);
    v[8] = lo16(b.x); v[9] = hi16(b.x); v[10] = lo16(b.y); v[11] = hi16(b.y); v[12] = lo16(b.z); v[13] = hi16(b.z); v[14] = lo16(b.w); v[15] = hi16(b.w); }
__device__ __forceinline__ void st16(bf16_t* p, const float (&v)[16]) { u32x4 a, b; a.x = pk2(v[0], v[1]); a.y = pk2(v[2], v[3]); a.z = pk2(v[4], v[5]); a.w = pk2(v[6], v[7]);
    b.x = pk2(v[8], v[9]); b.y = pk2(v[10], v[11]); b.z = pk2(v[12], v[13]); b.w = pk2(v[14], v[15]); *(u32x4*)p = a; *(u32x4*)(p + 8) = b; }
__device__ __forceinline__ void ld4(const bf16_t* p, float (&v)[4]) { const u32x2 a = *(const u32x2*)p; v[0] = lo16(a.x); v[1] = hi16(a.x); v[2] = lo16(a.y); v[3] = hi16(a.y); }
__device__ __forceinline__ void st4(bf16_t* p, const float (&v)[4]) { u32x2 a; a.x = pk2(v[0], v[1]); a.y = pk2(v[2], v[3]); *(u32x2*)p = a; }

__device__ __forceinline__ void norm192_rope_r(float (&nope)[16], float (&x1)[4], float (&x2)[4], const float (&gn)[16], const float (&g1)[4], const float (&g2)[4], const f32x2* rope, bool lat, int t, int p, float scale) {
    float ss = 0.f;
#pragma unroll
    for (int i = 0; i < 16; ++i) ss += nope[i] * nope[i];
#pragma unroll
    for (int i = 0; i < 4; ++i) ss += x1[i] * x1[i] + x2[i] * x2[i];
    ss += __shfl_xor(ss, 1); ss += __shfl_xor(ss, 2); ss += __shfl_xor(ss, 4);
    const float rs = rsqrtf(ss * (1.0f / 192.0f) + EPS) * scale;
    const int a = p >> 2, f0 = (p & 3) * 4;
#pragma unroll
    for (int i = 0; i < 16; ++i) nope[i] = nope[i] * rs * gn[i];
#pragma unroll
    for (int i = 0; i < 4; ++i) { x1[i] = x1[i] * rs * g1[i]; x2[i] = x2[i] * rs * g2[i]; }
    if (lat) { const int pos = a == 0 ? (t >> 6) : (t & 63);
#pragma unroll
        for (int i = 0; i < 4; ++i) { const f32x2 cs = rope[pos * 16 + f0 + i]; const float y1 = x1[i] * cs.x - x2[i] * cs.y, y2 = x2[i] * cs.x + x1[i] * cs.y; x1[i] = y1; x2[i] = y2; } }
}
__device__ __forceinline__ int row_seq(int row) { return row < NLAT ? (row >> 11) : 8 + ((row - NLAT) >> 8); }
__device__ __forceinline__ void phase_prep(const Frame& F, int l, bool need_ctx) {
    const int gw = F.bid * 8 + F.wave, NGW = F.G * 8;
    bf16_t* P = F.wsb(WS_P); bf16_t* XBC = F.wsb(WS_XBC); float* DT = F.wsf(WS_DT);
    const f32x2* rope = (const f32x2*)F.wsf(WS_ROPE);
    const int lane = F.lane, h = lane >> 3, p = lane & 7, a = p >> 2, f0 = (p & 3) * 4;
    {
        const float* qg = F.in[I_QG] + l * 192; const float* kvg = F.in[I_KVG] + l * 512; const float* naqg = F.in[I_NAQG] + l * 128; const float* nakg = F.in[I_NAKG] + l * 128;
        float gn[16], g1[4], g2[4], gkv[8], gq[16], gk[16];
#pragma unroll
        for (int i = 0; i < 16; ++i) { gn[i] = qg[p * 16 + i]; gq[i] = naqg[p * 16 + i]; gk[i] = nakg[p * 16 + i]; }
#pragma unroll
        for (int i = 0; i < 4; ++i) { g1[i] = qg[128 + a * 32 + f0 + i]; g2[i] = qg[128 + a * 32 + 16 + f0 + i]; }
#pragma unroll
        for (int i = 0; i < 8; ++i) gkv[i] = kvg[lane * 8 + i];
        const float dtb = lane < 32 ? F.in[I_DTB][l * 32 + lane] : 0.f;
        const int per = (NROW + NGW - 1) / NGW;
#pragma unroll 1
        for (int i = 0; i < per; ++i) {
            const int row = gw * per + i; if (row >= NROW) break;
            const bool lat = row < NLAT, doq = lat || need_ctx; const int t = lat ? (row & 2047) : ((row - NLAT) & 255);
            bf16_t* pr = P + (size_t)row * DINP;
            bf16_t* q = pr + PC_Q + h * 192; bf16_t* c = pr + PC_CKV + lane * 8; bf16_t* xq = pr + PC_NAQ + h * 128 + p * 16; bf16_t* xk = pr + PC_NAK + h * 128 + p * 16;
            float nope[16], x1[4], x2[4], vq[16], vk[16];
            if (doq) { ld16(q + p * 16, nope); ld4(q + 128 + a * 32 + f0, x1); ld4(q + 128 + a * 32 + 16 + f0, x2); ld16(xq, vq); }
            const u32x4 ca = *(const u32x4*)c; ld16(xk, vk);
            const float dtr = lane < 32 ? bf2f(pr[PC_DT + lane]) : 0.f;
            if (doq) {
                norm192_rope_r(nope, x1, x2, gn, g1, g2, rope, lat, t, p, 0.07216878364870322f * LOG2E);
                st16(q + p * 16, nope); st4(q + 128 + a * 32 + f0, x1); st4(q + 128 + a * 32 + 16 + f0, x2);
                float ss = 0.f;
#pragma unroll
                for (int j = 0; j < 16; ++j) ss += vq[j] * vq[j];
                ss += __shfl_xor(ss, 1); ss += __shfl_xor(ss, 2); ss += __shfl_xor(ss, 4);
                const float rs = rsqrtf(ss * (1.0f / 128.0f) + EPS) * (0.08838834764831845f * LOG2E);
#pragma unroll
                for (int j = 0; j < 16; ++j) vq[j] = vq[j] * rs * gq[j];
                st16(xq, vq);
            }
            {
                float v[8] = {lo16(ca.x), hi16(ca.x), lo16(ca.y), hi16(ca.y), lo16(ca.z), hi16(ca.z), lo16(ca.w), hi16(ca.w)}; float ss = 0.f;
#pragma unroll
                for (int j = 0; j < 8; ++j) ss += v[j] * v[j];
                const float rs = rsqrtf(wave_sum(ss) * (1.0f / 512.0f) + EPS);
#pragma unroll
                for (int j = 0; j < 8; ++j) v[j] = v[j] * rs * gkv[j];
                u32x4 o; o.x = pk2(v[0], v[1]); o.y = pk2(v[2], v[3]); o.z = pk2(v[4], v[5]); o.w = pk2(v[6], v[7]); *(u32x4*)c = o;
            }
            {
                float ss = 0.f;
#pragma unroll
                for (int j = 0; j < 16; ++j) ss += vk[j] * vk[j];
                ss += __shfl_xor(ss, 1); ss += __shfl_xor(ss, 2); ss += __shfl_xor(ss, 4);
                const float rs = rsqrtf(ss * (1.0f / 128.0f) + EPS);
#pragma unroll
                for (int j = 0; j < 16; ++j) vk[j] = vk[j] * rs * gk[j];
                st16(xk, vk);
            }
            if (lane < 32) { const float x = dtr + dtb; const float e = fast_exp2(x * LOG2E);
                DT[(size_t)row * 32 + lane] = x > 20.f ? x : (e < 1e-3f ? e * (1.0f - 0.5f * e) : __builtin_amdgcn_logf(1.0f + e) * 0.6931471805599453f); }
        }
    }
    {
        const float* cw = F.in[I_CONVW] + (size_t)l * 5 * 2048; const float* cbias = F.in[I_CONVB] + l * 2048;
#pragma unroll 1
        for (int it = gw; it < 1024 * 4; it += NGW) {
            int tl = lane; asm volatile("" : "+v"(tl));
            const int chunk = it >> 2, r0 = chunk * 18, ch0 = (it & 3) * 512 + tl * 8;
            float w[5][8], bs[8];
#pragma unroll
            for (int k = 0; k < 5; ++k) { const f32x4 w0 = *(const f32x4*)(cw + k * 2048 + ch0), w1 = *(const f32x4*)(cw + k * 2048 + ch0 + 4);
#pragma unroll
                for (int e = 0; e < 4; ++e) { w[k][e] = w0[e]; w[k][4 + e] = w1[e]; } }
            { const f32x4 b0 = *(const f32x4*)(cbias + ch0), b1 = *(const f32x4*)(cbias + ch0 + 4);
#pragma unroll
              for (int e = 0; e < 4; ++e) { bs[e] = b0[e]; bs[4 + e] = b1[e]; } }
            u32x4 raw[22];
#pragma unroll
            for (int i = 0; i < 22; ++i) { int rr = r0 - 2 + i; rr = rr < 0 ? 0 : (rr >= NROW ? NROW - 1 : rr); raw[i] = *(const u32x4*)(P + (size_t)rr * DINP + PC_XBC + ch0); }
            const bool uni = (r0 >= 2) && (r0 + 19 < NROW) && (row_seq(r0 - 2) == row_seq(r0 + 19));
#pragma unroll
            for (int j = 0; j < 18; ++j) {
                float o[8];
#pragma unroll
                for (int e = 0; e < 8; ++e) o[e] = bs[e];
                const int sj = row_seq(r0 + j);
#pragma unroll
                for (int k = 0; k < 5; ++k) {
                    const int src = r0 + j + k - 2;
                    const float m = uni ? 1.0f : ((src >= 0 && src < NROW && row_seq(src < 0 ? 0 : (src >= NROW ? NROW - 1 : src)) == sj) ? 1.0f : 0.0f);
                    const u32x4 a4 = raw[j + k];
                    const float x[8] = {lo16(a4.x), hi16(a4.x), lo16(a4.y), hi16(a4.y), lo16(a4.z), hi16(a4.z), lo16(a4.w), hi16(a4.w)};
#pragma unroll
                    for (int e = 0; e < 8; ++e) o[e] += (w[k][e] * m) * x[e];
                }
#pragma unroll
                for (int e = 0; e < 8; ++e) o[e] = siluf_(o[e]);
                u32x4 wv; wv.x = pk2(o[0], o[1]); wv.y = pk2(o[2], o[3]); wv.z = pk2(o[4], o[5]); wv.w = pk2(o[6], o[7]);
                *(u32x4*)(XBC + (size_t)(r0 + j) * 2048 + ch0) = wv;
            }
        }
    }
}

__device__ __forceinline__ void phase_knorm(const Frame& F, int l) {
    const int gw = F.bid * 8 + F.wave, NGW = F.G * 8, per = (NROW + NGW - 1) / NGW;
    const bf16_t* P = F.wsb(WS_P); bf16_t* Kb = F.wsb(WS_K); const f32x2* rope = (const f32x2*)F.wsf(WS_ROPE); const float* kg = F.in[I_KG] + l * 192;
    const int lane = F.lane, h = lane >> 3, p = lane & 7, a = p >> 2, f0 = (p & 3) * 4;
    static_assert(NROW == 9 * GRID * 8, "phase_knorm: 9 rows per wave, loaded 3 at a time");
#pragma unroll 1
    for (int i0 = 0; i0 < 9; i0 += 3) {
        u32x4 ra[3], rb[3]; u32x2 r1[3], r2[3];
#pragma unroll
        for (int j = 0; j < 3; ++j) { const int row = gw * per + i0 + j;
            const GAS bf16_t* k = (const GAS bf16_t*)Kb + (size_t)row_kv(row) * 1536 + h * 192 + p * 16; const GAS bf16_t* kr = (const GAS bf16_t*)P + (size_t)row * DINP + PC_KR + a * 32 + f0;
            ra[j] = *(const GAS u32x4*)k; rb[j] = *(const GAS u32x4*)(k + 8); r1[j] = *(const GAS u32x2*)kr; r2[j] = *(const GAS u32x2*)(kr + 16); }
#pragma unroll
        for (int j = 0; j < 3; ++j) { const int row = gw * per + i0 + j;
            const bool lat = row < NLAT; const int t = lat ? (row & 2047) : 0;
            bf16_t* k = Kb + (size_t)row_kv(row) * 1536 + h * 192;
            float nope[16], x1[4], x2[4];
            nope[0] = lo16(ra[j].x); nope[1] = hi16(ra[j].x); nope[2] = lo16(ra[j].y); nope[3] = hi16(ra[j].y); nope[4] = lo16(ra[j].z); nope[5] = hi16(ra[j].z); nope[6] = lo16(ra[j].w); nope[7] = hi16(ra[j].w);
            nope[8] = lo16(rb[j].x); nope[9] = hi16(rb[j].x); nope[10] = lo16(rb[j].y); nope[11] = hi16(rb[j].y); nope[12] = lo16(rb[j].z); nope[13] = hi16(rb[j].z); nope[14] = lo16(rb[j].w); nope[15] = hi16(rb[j].w);
            x1[0] = lo16(r1[j].x); x1[1] = hi16(r1[j].x); x1[2] = lo16(r1[j].y); x1[3] = hi16(r1[j].y); x2[0] = lo16(r2[j].x); x2[1] = hi16(r2[j].x); x2[2] = lo16(r2[j].y); x2[3] = hi16(r2[j].y);
            norm192_rope(nope, x1, x2, kg, rope, lat, t, p, 1.0f);
            st16(k + p * 16, nope); st4(k + 128 + a * 32 + f0, x1); st4(k + 128 + a * 32 + 16 + f0, x2); }
    }
}

namespace att {
#define SBAR() __builtin_amdgcn_sched_barrier(0)
constexpr int NW = 8, QBLK = 32, KVBLK = 64, DV = 128;
constexpr float THR2 = 11.5f;
__device__ __forceinline__ int crow(int r, int hi) { return (r & 3) + 8 * (r >> 2) + 4 * hi; }
__device__ __forceinline__ int v_st(int k, int c) { const int kk = (k & ~0xC) | ((k & 4) << 1) | ((k & 8) >> 1); return ((kk >> 3) * 4 + (c >> 5)) * 512 + ((kk & 7) * 32 + (c & 31)) * 2; }
__device__ __forceinline__ int v_rd_base(int lane) { return ((lane & 3) << 3) | (((lane >> 2) & 3) << 6) | (((lane >> 4) & 1) << 5) | (((lane >> 5) & 1) << 8); }
constexpr int v_rd_off(int d0, int ks, int half) { return d0 * 512 + ks * 4096 + half * 2048; }
template <int OFF> __device__ __forceinline__ s16x4 tr_read(int vb) { s16x4 r; asm volatile("ds_read_b64_tr_b16 %0, %1 offset:%2" : "=&v"(r) : "v"(vb), "i"(OFF) : "memory"); return r; }
template <int D0> __device__ __forceinline__ void pv_one(f32x16& od, int vb, bf16x8 pa0, bf16x8 pa1, bf16x8 pa2, bf16x8 pa3) {
    const s16x4 l0 = tr_read<v_rd_off(D0, 0, 0)>(vb), h0 = tr_read<v_rd_off(D0, 0, 1)>(vb), l1 = tr_read<v_rd_off(D0, 1, 0)>(vb), h1 = tr_read<v_rd_off(D0, 1, 1)>(vb);
    const s16x4 l2 = tr_read<v_rd_off(D0, 2, 0)>(vb), h2 = tr_read<v_rd_off(D0, 2, 1)>(vb), l3 = tr_read<v_rd_off(D0, 3, 0)>(vb), h3 = tr_read<v_rd_off(D0, 3, 1)>(vb);
    asm volatile("s_waitcnt lgkmcnt(0)" ::: "memory"); SBAR();
#define PKV(L, H) (bf16x8){L[0], L[1], L[2], L[3], H[0], H[1], H[2], H[3]}
    od = __builtin_amdgcn_mfma_f32_32x32x16_bf16(pa0, PKV(l0, h0), od, 0, 0, 0);
    od = __builtin_amdgcn_mfma_f32_32x32x16_bf16(pa1, PKV(l1, h1), od, 0, 0, 0);
    od = __builtin_amdgcn_mfma_f32_32x32x16_bf16(pa2, PKV(l2, h2), od, 0, 0, 0);
    od = __builtin_amdgcn_mfma_f32_32x32x16_bf16(pa3, PKV(l3, h3), od, 0, 0, 0);
#undef PKV
}
__device__ __forceinline__ void pv_d0(f32x16* o, int vb, bf16x8 pa0, bf16x8 pa1, bf16x8 pa2, bf16x8 pa3) {
    pv_one<0>(o[0], vb, pa0, pa1, pa2, pa3); pv_one<1>(o[1], vb, pa0, pa1, pa2, pa3); pv_one<2>(o[2], vb, pa0, pa1, pa2, pa3); pv_one<3>(o[3], vb, pa0, pa1, pa2, pa3);
}
struct NaMask { int bidx, wcol, rs, r, klo; const LAS float* tab; };
__device__ __forceinline__ void na_apply(f32x16& p0, f32x16& p1, const NaMask& M, int kr) {
    const bool rowok = (kr >= M.rs) && (kr < M.rs + 8);
    int dr = kr - M.r + 7; dr = dr < 0 ? 0 : (dr > 14 ? 14 : dr);
    const LAS float* tb = M.tab + dr * 32 + M.bidx;
#pragma unroll
    for (int r = 0; r < 16; ++r) { const int kc = (r & 3) + 8 * (r >> 2);
        const bool ok0 = rowok && ((unsigned)(kc + M.wcol) < 16u), ok1 = rowok && ((unsigned)(kc + 32 + M.wcol) < 16u);
        p0[r] = ok0 ? p0[r] + tb[kc] : -1e30f; p1[r] = ok1 ? p1[r] + tb[kc + 32] : -1e30f; }
}
__device__ __forceinline__ void partialSM(f32x16& p0, f32x16& p1, float& m_reg, float& mn, float& alpha) {
    float pmax = p0[0];
#pragma unroll
    for (int r = 1; r < 16; ++r) pmax = fmaxf(pmax, p0[r]);
#pragma unroll
    for (int r = 0; r < 16; ++r) pmax = fmaxf(pmax, p1[r]);
    { auto rr = __builtin_amdgcn_permlane32_swap(__float_as_uint(pmax), __float_as_uint(pmax), false, false);
      pmax = fmaxf(__uint_as_float(rr[0]), __uint_as_float(rr[1])); }
    if (__builtin_expect(__all(pmax - m_reg <= THR2), 1)) { mn = m_reg; alpha = 1.f; }
    else { mn = fmaxf(m_reg, pmax); alpha = fast_exp2(m_reg - mn); m_reg = mn; }
#pragma unroll
    for (int r = 0; r < 16; ++r) p0[r] = p0[r] - mn;
#pragma unroll
    for (int r = 0; r < 16; ++r) p1[r] = p1[r] - mn;
#pragma unroll
    for (int r = 0; r < 16; ++r) p0[r] = fast_exp2(p0[r]);
}
__device__ __forceinline__ void finishSM(f32x16& p0, f32x16& p1, float alpha, float& l_reg, bf16x8& pa0, bf16x8& pa1, bf16x8& pa2, bf16x8& pa3) {
#pragma unroll
    for (int r = 0; r < 16; ++r) p1[r] = fast_exp2(p1[r]);
    float ps = 0;
#pragma unroll
    for (int r = 0; r < 16; ++r) ps += p0[r];
#pragma unroll
    for (int r = 0; r < 16; ++r) ps += p1[r];
    { auto rr = __builtin_amdgcn_permlane32_swap(__float_as_uint(ps), __float_as_uint(ps), false, false);
      ps = __uint_as_float(rr[0]) + __uint_as_float(rr[1]); }
    l_reg = l_reg * alpha + ps;
#define PK4(P, BASE, OUT) do { unsigned a0 = pg8::cvt_pk_bf16(P[BASE + 0], P[BASE + 1]), a1 = pg8::cvt_pk_bf16(P[BASE + 2], P[BASE + 3]);   \
    unsigned b0 = pg8::cvt_pk_bf16(P[BASE + 4], P[BASE + 5]), b1 = pg8::cvt_pk_bf16(P[BASE + 6], P[BASE + 7]);                              \
    auto r0 = __builtin_amdgcn_permlane32_swap(a0, b0, false, false); auto r1 = __builtin_amdgcn_permlane32_swap(a1, b1, false, false); \
    u32x4 w = {r0[0], r1[0], r0[1], r1[1]}; OUT = *reinterpret_cast<bf16x8*>(&w); } while (0)
    PK4(p0, 0, pa0); PK4(p0, 8, pa1); PK4(p1, 0, pa2); PK4(p1, 8, pa3);
#undef PK4
}
struct Unit {
    const bf16_t* Q; long ldq;
    const bf16_t* K; const bf16_t* V; long ldk, ldv;
    bf16_t* O; long ldo;
    int NT, nct, rowC, rowL;
    __device__ __forceinline__ long trow(int j) const { return j < nct ? (long)rowC + 64 * j : (long)rowL + 64 * (j - nct); }
};
template <int DQK, bool NA>
__device__ __forceinline__ void attn_unit(const Unit& U, char* lds, const NaMask& M, const int tid) {
    constexpr int NQ = DQK / 16, KP = DQK * 2 + 16, SHM_K = KVBLK * KP, SHM_V = KVBLK * DV * 2;
    const int wid = tid >> 6, lane = tid & 63, r32 = lane & 31, hi = lane >> 5;
    char* V_lds = lds; char* K_lds = lds + 2 * SHM_V;
    constexpr int WSM_OFF = (2 * SHM_V + 2 * SHM_K) > 8 * 8704 ? (2 * SHM_V + 2 * SHM_K) : 8 * 8704;
    float* wsm = (float*)(lds + WSM_OFF) + wid * 64; float* li_l = wsm; float* al_l = wsm + 32;
    constexpr int NQR = (DQK == 192) ? 4 : 8, QLP = (NQ - NQR) * 32 + 16;
    float m_reg = -1e30f, l_reg = 0; f32x16 o[4] = {}; bf16x8 qr[NQR];
    const bf16_t* Qw = U.Q + (long)(wid * QBLK + r32) * U.ldq + hi * 8;
#pragma unroll
    for (int d0 = 0; d0 < NQR; ++d0) qr[d0] = *(const bf16x8*)(Qw + d0 * 16);
    char* Qrl = lds + WSM_OFF + 2048 + wid * (32 * QLP) + r32 * QLP + hi * 16;
    if (NQ > NQR) {
#pragma unroll
        for (int d0 = NQR; d0 < NQ; ++d0) *(bf16x8*)(Qrl + (d0 - NQR) * 32) = *(const bf16x8*)(Qw + d0 * 16);
    }
    const int sr = tid >> 4, sc = (tid & 15) * 8, vst0 = v_st(sr, sc), vst1 = v_st(32 + sr, sc);
    const int sr3 = tid >> 3, sc3 = 128 + (tid & 7) * 8;
    const int vb0 = (int)(uintptr_t)V_lds + v_rd_base(lane);
    bf16x8 vs0, vs1, ks0, ks1, ks2;
    const unsigned vo0 = (unsigned)(sr * U.ldv + sc) * 2u, vo1 = (unsigned)((32 + sr) * U.ldv + sc) * 2u, ko0 = (unsigned)(sr * U.ldk + sc) * 2u, ko1 = (unsigned)((32 + sr) * U.ldk + sc) * 2u, ko2 = (unsigned)(sr3 * U.ldk + sc3) * 2u;
#define KSWZ(row, colB) ((row) * KP + (colB))
#define SLOAD(j) do { const long _r = U.trow(j); const char* _vb = (const char*)(U.V + _r * U.ldv); const char* _kb = (const char*)(U.K + _r * U.ldk); \
    vs0 = *(const bf16x8*)(_vb + vo0); vs1 = *(const bf16x8*)(_vb + vo1); ks0 = *(const bf16x8*)(_kb + ko0); ks1 = *(const bf16x8*)(_kb + ko1); \
    if (DQK == 192) ks2 = *(const bf16x8*)(_kb + ko2); } while (0)
#define SWRITE(b) do { *(bf16x8*)(V_lds + (b) * SHM_V + vst0) = vs0; *(bf16x8*)(V_lds + (b) * SHM_V + vst1) = vs1; \
    *(bf16x8*)(K_lds + (b) * SHM_K + KSWZ(sr, sc * 2)) = ks0; *(bf16x8*)(K_lds + (b) * SHM_K + KSWZ(32 + sr, sc * 2)) = ks1; \
    if (DQK == 192) *(bf16x8*)(K_lds + (b) * SHM_K + KSWZ(sr3, sc3 * 2)) = ks2; } while (0)
#define QKT(P0, P1, b) do { P0 = f32x16{}; P1 = f32x16{}; const char* _Ks = K_lds + (b) * SHM_K; \
    _Pragma("unroll") for (int d0 = 0; d0 < NQ; ++d0) { const int cb = (d0 * 16 + hi * 8) * 2; \
      const bf16x8 b0 = *(const bf16x8*)(_Ks + KSWZ(r32, cb)); const bf16x8 b1 = *(const bf16x8*)(_Ks + KSWZ(32 + r32, cb)); \
      const bf16x8 qf = d0 < NQR ? qr[d0 < NQR ? d0 : 0] : *(const bf16x8*)(Qrl + (d0 - NQR) * 32); \
      P0 = __builtin_amdgcn_mfma_f32_32x32x16_bf16(b0, qf, P0, 0, 0, 0); P1 = __builtin_amdgcn_mfma_f32_32x32x16_bf16(b1, qf, P1, 0, 0, 0); } } while (0)
#define MASK(P0, P1, j) do { if (NA) { if ((j) >= U.nct) na_apply(P0, P1, M, M.klo + (j) - U.nct); } } while (0)
#define RESC(a) do { if (__any((a) < 1.f)) { if (hi == 0) al_l[r32] = (a); asm volatile("s_waitcnt lgkmcnt(0)" ::: "memory"); \
    _Pragma("unroll") for (int d = 0; d < 4; ++d) _Pragma("unroll") for (int r = 0; r < 16; ++r) o[d][r] *= al_l[crow(r, hi)]; } } while (0)
    f32x16 p0, p1; float mn, al; bf16x8 pa0, pa1, pa2, pa3; const int NT = U.NT;
    __syncthreads();
    SLOAD(0); asm volatile("s_waitcnt vmcnt(0)" ::: "memory"); SWRITE(0); __syncthreads();
#pragma unroll 1
    for (int j = 0; j < NT; ++j) {
        const int buf = j & 1;
        if (j + 1 < NT) SLOAD(j + 1);
        bool active = true;
        if (NA) { const int kr = M.klo + j - U.nct; active = (j < U.nct) || (kr >= M.rs && kr < M.rs + 8); }
        if (active) {
        SBAR(); QKT(p0, p1, buf); MASK(p0, p1, j);
        partialSM(p0, p1, m_reg, mn, al); RESC(al);
        finishSM(p0, p1, al, l_reg, pa0, pa1, pa2, pa3); SBAR();
        pv_d0(o, vb0 + buf * SHM_V, pa0, pa1, pa2, pa3);
        }
        if (j + 1 < NT) { asm volatile("s_waitcnt vmcnt(0)" ::: "memory"); SWRITE(buf ^ 1); }
        __syncthreads();
    }
    if (hi == 0) li_l[r32] = l_reg; asm volatile("s_waitcnt lgkmcnt(0)" ::: "memory");
    float rli[16];
#pragma unroll
    for (int r = 0; r < 16; ++r) rli[r] = fast_rcp(li_l[crow(r, hi)]);
    char* Ot = lds + wid * 8704;
#pragma unroll
    for (int r = 0; r < 16; ++r) { const int orow = crow(r, hi);
#pragma unroll
        for (int d0 = 0; d0 < 4; ++d0) { const float v = o[d0][r] * rli[r]; *(bf16_t*)(Ot + orow * 272 + (d0 * 32 + r32) * 2) = (bf16_t)(pk2(v, v) & 0xffffu); } }
    asm volatile("s_waitcnt lgkmcnt(0)" ::: "memory");
    char* Og = (char*)(U.O + (long)(wid * QBLK) * U.ldo);
#pragma unroll
    for (int k = 0; k < 8; ++k) { const int id = lane + 64 * k, row = id >> 4, ch = id & 15;
        *(u32x4*)(Og + (unsigned)(row * (int)U.ldo + ch * 8) * 2u) = *(const u32x4*)(Ot + row * 272 + ch * 16); }
#undef KSWZ
#undef SLOAD
#undef SWRITE
#undef QKT
#undef MASK
#undef RESC
}
}

__device__ __forceinline__ void phase_mla(const Frame& F, bool need_ctx) {
    const bf16_t* P = F.wsb(WS_P); const bf16_t* Kb = F.wsb(WS_K); const bf16_t* Vb = F.wsb(WS_V); bf16_t* BR = F.wsb(WS_BR);
    const int nunits = 512 + (need_ctx ? 64 : 0);
    att::NaMask M{};
    for (int u = F.bid; u < nunits; u += F.G) {
        att::Unit U; int b, h, qrow;
        if (u < 512) { b = u >> 6; h = (u >> 3) & 7; qrow = b * SEQ + (u & 7) * 256; U.NT = KVROWS / 64; }
        else { const int v = u - 512; b = v >> 3; h = v & 7; qrow = NLAT + b * CTX; U.NT = CTX / 64; }
        U.Q = P + (size_t)qrow * DINP + PC_Q + h * 192; U.ldq = DINP;
        U.K = Kb + (size_t)b * KVROWS * 1536 + h * 192; U.ldk = 1536; U.V = Vb + (size_t)b * KVROWS * 1024 + h * 128; U.ldv = 1024;
        U.O = BR + (size_t)qrow * 3072 + h * 128; U.ldo = 3072; U.nct = 0; U.rowC = 0; U.rowL = 0;
        att::attn_unit<192, false>(U, (char*)F.lds, M, F.tid);
    }
}
__device__ __forceinline__ void phase_na(const Frame& F, int l, bool need_ctx) {
    const bf16_t* P = F.wsb(WS_P); bf16_t* BR = F.wsb(WS_BR);
    LAS float* tab = (LAS float*)(F.lds + 131072);
    const int nunits = 512 + (need_ctx ? 64 : 0);
    for (int u = F.bid; u < nunits; u += F.G) {
        att::Unit U; att::NaMask M{}; int b, h, qrow;
        if (u < 512) { b = u >> 6; h = (u >> 3) & 7; const int rg = u & 7; qrow = b * SEQ + rg * 256;
            const int klo = rg == 0 ? 0 : (rg * 4 - 4 > 24 ? 24 : rg * 4 - 4), nr = (rg == 0 || rg == 7) ? 8 : 11;
            U.NT = 4 + nr + (nr & 1); U.nct = 4; U.rowC = NLAT + b * CTX; U.rowL = b * SEQ + klo * 64;
            const int r = rg * 4 + (F.wave >> 1), c = (F.wave & 1) * 32 + (F.lane & 31), hi = F.lane >> 5;
            const int rs = r - 4 < 0 ? 0 : (r - 4 > 24 ? 24 : r - 4), wsc = c - 8 < 0 ? 0 : (c - 8 > 48 ? 48 : c - 8);
            M.bidx = 4 * hi - c + 15; M.wcol = 4 * hi - wsc; M.rs = rs; M.r = r; M.klo = klo; M.tab = tab + 64;
        } else { const int v = u - 512; b = v >> 3; h = v & 7; qrow = NLAT + b * CTX; U.NT = 4; U.nct = 4; U.rowC = NLAT + b * CTX; U.rowL = 0; M.tab = tab + 64; }
        __syncthreads();
        for (int i = F.tid; i < 15 * 32; i += 512) { const int dr = i >> 5, dc = i & 31; tab[64 + i] = dc < 31 ? F.in[I_RPB][((size_t)(l * 8 + h) * 15 + dr) * 31 + dc] * LOG2E : 0.f; }
        U.Q = P + (size_t)qrow * DINP + PC_NAQ + h * 128; U.ldq = DINP;
        U.K = P + PC_NAK + h * 128; U.ldk = DINP; U.V = P + PC_NAV + h * 128; U.ldv = DINP;
        U.O = BR + (size_t)qrow * 3072 + 2048 + h * 128; U.ldo = 3072;
        att::attn_unit<128, true>(U, (char*)F.lds, M, F.tid);
    }
}

__device__ __forceinline__ bf16x8 frag_row(const LAS unsigned char* t, int pitch, int row0, int k0, int lane) {
    return *(const LAS bf16x8*)(t + (row0 + (lane & 31)) * pitch + (k0 + 8 * (lane >> 5)) * 2);
}
__device__ __forceinline__ s16x4 tr16(const LAS unsigned char* p) {
    typedef short v4i16 __attribute__((ext_vector_type(4)));
    return __builtin_bit_cast(s16x4, __builtin_amdgcn_ds_read_tr16_b64_v4i16((LAS v4i16*)p));
}
__device__ __forceinline__ bf16x8 frag_tr(const LAS unsigned char* t, int pitch, int k0, int col0, int lane) {
    const int h = lane >> 5, blk = (lane >> 4) & 1, q = (lane & 15) >> 2, p = lane & 3;
    const LAS unsigned char* a = t + (k0 + 8 * h + q) * pitch + (col0 + 16 * blk + 4 * p) * 2;
    const s16x4 lo = tr16(a), hi = tr16(a + 4 * pitch);
    return (bf16x8){lo[0], lo[1], lo[2], lo[3], hi[0], hi[1], hi[2], hi[3]};
}
__device__ __forceinline__ int chunk_row0(int b, int c) { return c < 2 ? NLAT + b * CTX + c * 128 : b * SEQ + (c - 2) * 128; }
__device__ __forceinline__ float chunk_cumsum(float d0, float d1, int lane, float& c0, float& c1) {
    float s = d0 + d1;
#pragma unroll
    for (int o = 1; o < 64; o <<= 1) { const float t = __shfl_up(s, o); if (lane >= o) s += t; }
    c1 = s; c0 = s - d1; return __shfl(s, 63);
}

__device__ __forceinline__ void phase_ssd_states(const Frame& F, int l) {
    constexpr int XP = 592, BP = 336;
    LAS unsigned char* Xs = F.lds; LAS unsigned char* Bm = F.lds + 128 * XP; LAS float* wts = (LAS float*)(F.lds + 128 * XP + 128 * BP);
    const bf16_t* XBC = F.wsb(WS_XBC); const float* DT = F.wsf(WS_DT); float* SST = F.wsf(WS_SST); float* CDEC = F.wsf(WS_CDEC);
    const int lane = F.lane, w = F.wave, d = w >> 2, hh = w & 3;
    for (int it = F.bid; it < NB * NCHUNK * 4; it += F.G) {
        const int b = it / (NCHUNK * 4), c = (it / 4) % NCHUNK, g = it & 3, row0 = chunk_row0(b, c), h = g * 4 + hh;
        __syncthreads();
        for (int i = F.tid; i < 128 * 32; i += 512) { const int r = i >> 5, ch = i & 31; *(LAS u32x4*)(Xs + r * XP + ch * 16) = *(const u32x4*)(XBC + (size_t)(row0 + r) * 2048 + g * 256 + ch * 8); }
        for (int i = F.tid; i < 128 * 16; i += 512) { const int r = i >> 4, ch = i & 15; *(LAS u32x4*)(Bm + r * BP + ch * 16) = *(const u32x4*)(XBC + (size_t)(row0 + r) * 2048 + 1024 + g * 128 + ch * 8); }
        {   const float a = -expf(F.in[I_ALOG][(l * 2 + d) * 16 + h]);
            const float dt0 = DT[(size_t)(row0 + 2 * lane) * 32 + d * 16 + h], dt1 = DT[(size_t)(row0 + 2 * lane + 1) * 32 + d * 16 + h];
            float c0, c1; const float tot = chunk_cumsum(dt0 * a, dt1 * a, lane, c0, c1);
            const float e0 = d == 0 ? tot - c0 : c0 - dt0 * a, e1 = d == 0 ? tot - c1 : c1 - dt1 * a;
            wts[w * 128 + 2 * lane] = dt0 * expf(e0); wts[w * 128 + 2 * lane + 1] = dt1 * expf(e1);
            if (lane == 0) CDEC[((b * 2 + d) * 16 + h) * NCHUNK + c] = expf(tot);
        }
        __syncthreads();
        bf16_t* dst = (bf16_t*)SST + ((size_t)((b * 2 + d) * 16 + h) * NCHUNK + c) * 8192;
        LAS unsigned char* wsc = F.lds + 122880 + w * 4096;
#pragma unroll 1
        for (int pt = 0; pt < 2; ++pt) {
            f32x16 acc[4] = {};
#pragma unroll 1
            for (int ks = 0; ks < 8; ++ks) {
                const f32x4 w0 = *(const LAS f32x4*)(wts + w * 128 + 16 * ks + 8 * (lane >> 5)), w1 = *(const LAS f32x4*)(wts + w * 128 + 16 * ks + 8 * (lane >> 5) + 4);
                const bf16x8 x = frag_tr(Xs, XP, 16 * ks, hh * 64 + 32 * pt, lane);
                u32x4 o; o.x = pk2(bf2f((unsigned short)x[0]) * w0[0], bf2f((unsigned short)x[1]) * w0[1]); o.y = pk2(bf2f((unsigned short)x[2]) * w0[2], bf2f((unsigned short)x[3]) * w0[3]);
                o.z = pk2(bf2f((unsigned short)x[4]) * w1[0], bf2f((unsigned short)x[5]) * w1[1]); o.w = pk2(bf2f((unsigned short)x[6]) * w1[2], bf2f((unsigned short)x[7]) * w1[3]);
                const bf16x8 a = __builtin_bit_cast(bf16x8, o);
#pragma unroll
                for (int nt = 0; nt < 4; ++nt) { const bf16x8 bb = frag_tr(Bm, BP, 16 * ks, 32 * nt, lane); acc[nt] = __builtin_amdgcn_mfma_f32_32x32x16_bf16(a, bb, acc[nt], 0, 0, 0); }
            }
            int le = lane; asm volatile("" : "+v"(le));
#pragma unroll
            for (int nh = 0; nh < 2; ++nh) {
#pragma unroll
                for (int q = 0; q < 2; ++q)
#pragma unroll
                    for (int r = 0; r < 16; ++r) { const float v = acc[2 * nh + q][r]; *(LAS bf16_t*)(wsc + att::crow(r, le >> 5) * 128 + (32 * q + (le & 31)) * 2) = (bf16_t)(pk2(v, v) & 0xffffu); }
                asm volatile("s_waitcnt lgkmcnt(0)" ::: "memory");
#pragma unroll
                for (int k = 0; k < 4; ++k) { const int id = le + 64 * k, row = id >> 3, ch = id & 7;
                    *(u32x4*)(dst + (size_t)(32 * pt + row) * 128 + 64 * nh + ch * 8) = *(const LAS u32x4*)(wsc + row * 128 + ch * 16); }
                asm volatile("s_waitcnt lgkmcnt(0)" ::: "memory");
            }
        }
    }
}
__device__ __forceinline__ void phase_ssd_scan(const Frame& F) {
    const u32x2* SST = (const u32x2*)F.wsf(WS_SST); const float* CDEC = F.wsf(WS_CDEC); u32x2* SENT = (u32x2*)F.wsb(WS_SENT);
    const int gt = F.bid * 512 + F.tid, NT = F.G * 512;
    for (int idx = gt; idx < 256 * 2048; idx += NT) {
        const int combo = idx >> 11, e4 = idx & 2047, d = (combo >> 4) & 1;
        const u32x2* base = SST + (size_t)combo * NCHUNK * 2048 + e4; u32x2* ob = SENT + (size_t)combo * NCHUNK * 2048 + e4; const float* cd = CDEC + combo * NCHUNK;
        u32x2 v[NCHUNK];
#pragma unroll
        for (int c = 0; c < NCHUNK; ++c) v[c] = base[(size_t)c * 2048];
        float z0; asm volatile("v_mov_b32 %0, 0" : "=v"(z0));
        f32x4 st = {z0, z0, z0, z0};
#pragma unroll
        for (int i = 0; i < NCHUNK; ++i) { const int cf = i, cb = i == 0 ? 1 : (i == 1 ? 0 : NCHUNK + 1 - i); const int cc = d == 0 ? cf : cb;
            u32x2 o; o.x = pk2(st.x, st.y); o.y = pk2(st.z, st.w); ob[(size_t)cc * 2048] = o;
            const f32x4 cs = {lo16(v[cc].x), hi16(v[cc].x), lo16(v[cc].y), hi16(v[cc].y)}; st = st * cd[cc] + cs; }
    }
}
__device__ __forceinline__ void phase_ssd_out(const Frame& F, int l, bool need_ctx) {
    constexpr int CP = 272, XHP = 144;
    LAS unsigned char* Cm = F.lds; LAS unsigned char* Bm = F.lds + 34816; LAS unsigned char* Mc = Bm; LAS unsigned char* Xh = F.lds + 69632;
    LAS unsigned char* Zh = F.lds + 88064; LAS unsigned char* Sf = F.lds + 106496; LAS unsigned char* Sb = F.lds + 123904;
    LAS float* arr = (LAS float*)(F.lds + 141312);
    const bf16_t* XBC = F.wsb(WS_XBC); const bf16_t* P = F.wsb(WS_P); const float* DT = F.wsf(WS_DT); const bf16_t* SENT = F.wsb(WS_SENT); bf16_t* BR = F.wsb(WS_BR);
    float* GSS = F.wsf(WS_GSS) + (size_t)l * NROW * 4;
    const int lane = F.lane, w = F.wave, hi = lane >> 5, c_lo = need_ctx ? 0 : 2, nch = NCHUNK - c_lo;
    const int lt = w >> 1, pt = w & 1;
#pragma unroll 1
    for (int it = F.bid; it < NB * nch * 16; it += F.G) {
        const int b = it / (nch * 16), c = c_lo + (it >> 4) % nch, h = it & 15, g = h >> 2, row0 = chunk_row0(b, c);
        int tq = F.tid; asm volatile("" : "+v"(tq));
        __syncthreads();
        {
            u32x4 vb[4], vc[4], vx[2], vz[2], vf[2], vs[2];
            const bf16_t* sf = SENT + ((size_t)((b * 2 + 0) * 16 + h) * NCHUNK + c) * 8192; const bf16_t* sb = SENT + ((size_t)((b * 2 + 1) * 16 + h) * NCHUNK + c) * 8192;
#pragma unroll
            for (int k = 0; k < 4; ++k) { const int i = tq + 512 * k, r = i >> 4, ch = i & 15; const bf16_t* src = XBC + (size_t)(row0 + r) * 2048 + 1024 + g * 128 + ch * 8; vb[k] = *(const u32x4*)src; vc[k] = *(const u32x4*)(src + 512); }
#pragma unroll
            for (int k = 0; k < 2; ++k) { const int i = tq + 512 * k, r = i >> 3, ch = i & 7; vx[k] = *(const u32x4*)(XBC + (size_t)(row0 + r) * 2048 + h * 64 + ch * 8); vz[k] = *(const u32x4*)(P + (size_t)(row0 + r) * DINP + PC_Z + h * 64 + ch * 8);
                vf[k] = *(const u32x4*)(sf + (size_t)i * 8); vs[k] = *(const u32x4*)(sb + (size_t)i * 8); }
#pragma unroll
            for (int k = 0; k < 4; ++k) { const int i = tq + 512 * k, r = i >> 4, ch = i & 15; *(LAS u32x4*)(Bm + r * CP + ch * 16) = vb[k]; *(LAS u32x4*)(Cm + r * CP + ch * 16) = vc[k]; }
#pragma unroll
            for (int k = 0; k < 2; ++k) { const int i = tq + 512 * k, r = i >> 3, ch = i & 7; *(LAS u32x4*)(Xh + r * XHP + ch * 16) = vx[k]; *(LAS u32x4*)(Zh + r * XHP + ch * 16) = vz[k];
                const int rs_ = i >> 4, cs_ = i & 15; *(LAS u32x4*)(Sf + rs_ * CP + cs_ * 16) = vf[k]; *(LAS u32x4*)(Sb + rs_ * CP + cs_ * 16) = vs[k]; }
        }
        if (w < 2) {
            const int d = w; const float a = -expf(F.in[I_ALOG][(l * 2 + d) * 16 + h]);
            const float dt0 = DT[(size_t)(row0 + 2 * lane) * 32 + d * 16 + h], dt1 = DT[(size_t)(row0 + 2 * lane + 1) * 32 + d * 16 + h];
            float c0, c1; const float tot = chunk_cumsum(dt0 * a, dt1 * a, lane, c0, c1);
            if (d == 1) { c0 = tot - c0 + dt0 * a; c1 = tot - c1 + dt1 * a; }
            LAS float* q = arr + d * 128 + 2 * lane;
            q[0] = c0 * LOG2E; q[1] = c1 * LOG2E; q[256] = dt0; q[257] = dt1; q[512] = fast_exp2(c0 * LOG2E); q[513] = fast_exp2(c1 * LOG2E);
        }
        __syncthreads();
        f32x16 cb[2] = {};
#pragma unroll 2
        for (int ks = 0; ks < 8; ++ks) { const bf16x8 a = frag_row(Cm, CP, 32 * lt, 16 * ks, lane);
#pragma unroll
            for (int i = 0; i < 2; ++i) { const bf16x8 bb = frag_row(Bm, CP, 32 * (2 * pt + i), 16 * ks, lane); cb[i] = __builtin_amdgcn_mfma_f32_32x32x16_bf16(a, bb, cb[i], 0, 0, 0); } }
        int lb = 32 * lt + 4 * hi, sb0 = 64 * pt + (lane & 31);
        asm volatile("" : "+v"(lb), "+v"(sb0));
        __syncthreads();
        const LAS float* aF = arr; const LAS float* rB = arr + 128;
#pragma unroll
        for (int i = 0; i < 2; ++i) { const int sidx = sb0 + 32 * i, dlt = sidx - lb;
            const float afs = aF[sidx], rbs = rB[sidx], dfs = aF[256 + sidx], dbs = rB[256 + sidx];
#pragma unroll
            for (int r = 0; r < 16; ++r) { const int cr = (r & 3) + 8 * (r >> 2), ll = lb + cr;
                const float f = dlt <= cr ? fast_exp2(aF[ll] - afs) * dfs : 0.f, bk = dlt >= cr ? fast_exp2(rB[ll] - rbs) * dbs : 0.f;
                const float m = cb[i][r] * (f + bk);
                *(LAS bf16_t*)(Mc + ll * CP + sidx * 2) = (bf16_t)(pk2(m, m) & 0xffffu); } }
        __syncthreads();
        f32x16 yd = {}, yf = {}, yb = {};
#pragma unroll 2
        for (int ks = 0; ks < 8; ++ks) {
            const bf16x8 am = frag_row(Mc, CP, 32 * lt, 16 * ks, lane), bx = frag_tr(Xh, XHP, 16 * ks, 32 * pt, lane);
            yd = __builtin_amdgcn_mfma_f32_32x32x16_bf16(am, bx, yd, 0, 0, 0);
            const bf16x8 ac = frag_row(Cm, CP, 32 * lt, 16 * ks, lane), bf = frag_row(Sf, CP, 32 * pt, 16 * ks, lane), bb = frag_row(Sb, CP, 32 * pt, 16 * ks, lane);
            yf = __builtin_amdgcn_mfma_f32_32x32x16_bf16(ac, bf, yf, 0, 0, 0);
            yb = __builtin_amdgcn_mfma_f32_32x32x16_bf16(ac, bb, yb, 0, 0, 0);
        }
        const float dsk = F.in[I_SSDD][l * 16 + h]; const int pcol = 32 * pt + (lane & 31);
#pragma unroll
        for (int r = 0; r < 16; ++r) { const int cr = (r & 3) + 8 * (r >> 2), ll = lb + cr;
            const float xs = bf2f(*(const LAS bf16_t*)(Xh + ll * XHP + pcol * 2));
            const float y = yd[r] + aF[512 + ll] * yf[r] + rB[512 + ll] * yb[r] + dsk * xs;
            LAS bf16_t* zp = (LAS bf16_t*)(Zh + ll * XHP + pcol * 2);
            const float v = y * siluf_(bf2f(*zp));
            *zp = (bf16_t)(pk2(v, v) & 0xffffu); }
        __syncthreads();
        {
            int tz = F.tid; asm volatile("" : "+v"(tz));
            const int r = tz >> 2, q4 = tz & 3; const LAS unsigned char* src = Zh + r * XHP + q4 * 32;
            const u32x4 a = *(const LAS u32x4*)src, b2 = *(const LAS u32x4*)(src + 16);
            bf16_t* dst = BR + (size_t)(row0 + r) * 3072 + 1024 + h * 64 + q4 * 16;
            *(u32x4*)dst = a; *(u32x4*)(dst + 8) = b2;
            float ss = 0.f;
            { const unsigned wv[8] = {a.x, a.y, a.z, a.w, b2.x, b2.y, b2.z, b2.w};
#pragma unroll
              for (int k = 0; k < 8; ++k) { const float x0 = lo16(wv[k]), x1 = hi16(wv[k]); ss += x0 * x0 + x1 * x1; } }
            ss += __shfl_xor(ss, 1); ss += __shfl_xor(ss, 2);
            if (q4 == 0) atomicAdd(GSS + (size_t)(row0 + r) * 4 + g, ss);
        }
    }
}
__device__ __forceinline__ void phase_ssd_norm(const Frame& F, int l, bool need_ctx) {
    bf16_t* BR = F.wsb(WS_BR); const float* GSS = F.wsf(WS_GSS) + (size_t)l * NROW * 4; const float* ng = F.in[I_SSDG] + l * 1024;
    const int gw = F.bid * 8 + F.wave, nrows = need_ctx ? NROW : NLAT, per = nrows / (GRID * 8), lane = F.lane;
    float gg[16];
#pragma unroll
    for (int i = 0; i < 16; ++i) gg[i] = ng[lane * 16 + i];
#pragma unroll 1
    for (int i0 = 0; i0 < per; i0 += 3) {
        u32x4 ra[3], rb[3]; float gs[3];
#pragma unroll
        for (int j = 0; j < 3; ++j) if (i0 + j < per) { const int row = gw * per + i0 + j; const GAS bf16_t* p = (const GAS bf16_t*)BR + (size_t)row * 3072 + 1024 + lane * 16;
            ra[j] = *(const GAS u32x4*)p; rb[j] = *(const GAS u32x4*)(p + 8); gs[j] = ((const GAS float*)GSS)[(size_t)row * 4 + (lane >> 4)]; }
#pragma unroll
        for (int j = 0; j < 3; ++j) if (i0 + j < per) { const int row = gw * per + i0 + j; bf16_t* p = BR + (size_t)row * 3072 + 1024 + lane * 16;
            const float rs = rsqrtf(gs[j] * (1.0f / 256.0f) + EPS);
            float v[16] = {lo16(ra[j].x), hi16(ra[j].x), lo16(ra[j].y), hi16(ra[j].y), lo16(ra[j].z), hi16(ra[j].z), lo16(ra[j].w), hi16(ra[j].w),
                           lo16(rb[j].x), hi16(rb[j].x), lo16(rb[j].y), hi16(rb[j].y), lo16(rb[j].z), hi16(rb[j].z), lo16(rb[j].w), hi16(rb[j].w)};
#pragma unroll
            for (int e = 0; e < 16; ++e) v[e] = v[e] * rs * gg[e];
            st16(p, v); }
    }
}

constexpr int NSTEPS = 2 + 4 * 16;
__global__ void __launch_bounds__(512, 2) fwd_kernel(Args args) {
    extern __shared__ __attribute__((aligned(16))) unsigned char lds_raw[];
    asm volatile("s_nop 0\n\ts_nop 0");
    Frame F; F.lds = (LAS unsigned char*)lds_raw; F.tid = threadIdx.x; F.lane = F.tid & 63; F.wave = __builtin_amdgcn_readfirstlane(F.tid >> 6); F.bid = blockIdx.x;
    F.in = args.in; F.out = args.out; F.ws = args.ws;
    volatile LAS unsigned* MISC = (volatile LAS unsigned*)(F.lds + MISC_OFF);
    for (int u = F.tid; u < (LDS_BYTES - MISC_OFF) / 4; u += 512) MISC[u] = 0u;
    __syncthreads();
    unsigned* ctl = (unsigned*)(F.ws + WS_CTL);
#if !MK_PER_STEP
    XcdBarrier bar = xcd_barrier_post(ctl + CW_BAR, MISC + 8);
#endif
    const int lo = args.st_lo, hi = args.st_hi;
#ifndef MK_PHASES
#define MK_PHASES 0xFFFFFFFFu
#endif
#define EN(k) (((MK_PHASES) >> (k)) & 1u)
#ifndef MK_DUPGU
#define MK_DUPGU 0
#endif
#ifndef MK_DUP
#define MK_DUP 0u
#endif
#define REP(k) for (int rep_ = 0; rep_ <= (int)(((MK_DUP) >> (k)) & 1u); ++rep_)
#define RUN(s) (lo <= (s) && (s) < hi)
#if MK_PER_STEP
#define SEAM() do { } while (0)
#else
#define SEAM() xcd_barrier(bar)
#endif
#define PH Frame Fp = F; { int t_; asm volatile("v_mbcnt_lo_u32_b32 %0, -1, 0\n\tv_mbcnt_hi_u32_b32 %0, -1, %0" : "=v"(t_)); t_ += F.wave << 6;     Fp.tid = t_; Fp.lane = t_ & 63; Fp.wave = __builtin_amdgcn_readfirstlane(t_ >> 6); \
    unsigned char* w_ = args.ws; asm volatile("" : "+s"(w_)); Fp.ws = w_; int b_ = blockIdx.x; asm volatile("" : "+s"(b_)); Fp.bid = b_; float* o_ = args.out; asm volatile("" : "+s"(o_)); Fp.out = o_; } \
    float* HC = Fp.wsf(WS_HC); bf16_t* U = Fp.wsb(WS_U); bf16_t* P = Fp.wsb(WS_P); bf16_t* HID = Fp.wsb(WS_P); const float* mod = Fp.wsf(WS_MOD) + (size_t)l * 9 * (NMOD * DM); \
    (void)HC; (void)U; (void)P; (void)HID; (void)mod;

    if (EN(0) && RUN(0)) { const int l = 0; PH; phase_adaln(Fp); }

#pragma unroll 1
    for (int hl = 0; hl < 4; ++hl) {
        const int l = hl >> 1, second = hl & 1, sb = 2 + 16 * hl;
        const bool need_ctx = (l == 0);
        const float* normg = F.in[I_NORMG] + (size_t)l * 3 * DM;
        if (!second) {
            if (EN(1) && RUN(sb + 0)) { PH; phase_convert(Fp, l); if (l == 0) SEAM(); }
        } else {
            const int mrows = need_ctx ? NROW : NLAT;
            if (EN(2) && RUN(sb + 0)) { PH; phase_norm(Fp, Fp.out, HC, normg + DM, mod, 3, U, NROW, HC, Fp.wsf(WS_SST), MK_I8GATE ? Fp.ws + WS_U8M : nullptr, Fp.wsf(WS_RSC)); SEAM(); }
            if (EN(3) && RUN(sb + 1)) { PH; pg8::ProbWin57 S{U, Fp.wsb(WS_U8M), Fp.wsb(WS_WIN), DM, DM, DM, need_ctx ? 1 : 0, Fp.G, Fp.bid};
                pg8::EpiP57 E{P, DINP, Fp.wsb(WS_GATE), Fp.wsf(WS_RSC), (const float*)(Fp.ws + WS_CMAX) + (size_t)l * NQCOL + 22528};
                pg8::gemm_phase<pg8::EpiP57, pg8::ProbWin57, MK_I8GATE ? 2 : 0>(Fp.lds, S, E, Fp.tid); SEAM(); }
            if (EN(4) && RUN(sb + 2)) { PH; phase_prep(Fp, l, need_ctx); SEAM(); }
            if (EN(5) && RUN(sb + 3)) { PH; pg8::ProbStd S{P + PC_CKV, Fp.wsb(WS_WUKV), DINP, 512, 512, NROW / 256, 8, Fp.G, Fp.bid}; pg8::EpiKV E{Fp.wsb(WS_K), Fp.wsb(WS_V)};
                pg8::gemm_phase(Fp.lds, S, E, Fp.tid); SEAM(); }
            if (EN(6) && RUN(sb + 4)) { PH; phase_knorm(Fp, l); REP(6) phase_ssd_states(Fp, l); SEAM(); }
            if (EN(7) && RUN(sb + 5)) { PH; phase_ssd_scan(Fp); }
            if (EN(9) && RUN(sb + 5)) { PH; REP(9) phase_na(Fp, l, need_ctx); SEAM(); }
            if (EN(8) && RUN(sb + 6)) { PH; REP(8) phase_mla(Fp, need_ctx); }
            if (EN(10) && RUN(sb + 6)) { PH; REP(10) phase_ssd_out(Fp, l, need_ctx); SEAM(); }
            if (EN(10) && RUN(sb + 7)) { PH; phase_ssd_norm(Fp, l, need_ctx); SEAM(); }
            if (EN(11) && RUN(sb + 9)) { PH; pg8::ProbMerge S{Fp.wsb(WS_BR), Fp.wsb(WS_WBR), 3072, 1024, 1024, mrows / 256, 8, Fp.G, Fp.bid}; pg8::EpiMerge E{Fp.wsb(WS_GATE), U};
                REP(11) pg8::gemm_phase(Fp.lds, S, E, Fp.tid); SEAM(); }
            if (EN(12) && RUN(sb + 10)) { PH; pg8::ProbSplit S{U, Fp.wsb(WS_WOUT), DM, DM, DM, mrows / 256, Fp.G, Fp.bid};
                pg8::EpiResid E{{Fp.out, HC}, {Fp.out, HC}, mod, 5, 1.0f, Fp.wsf(WS_SST)};
                pg8::gemm_phase(Fp.lds, S, E, Fp.tid); SEAM(); }
        }
        {
            const int frows = (second && !need_ctx) ? NLAT : NROW;
            const int nbase = second ? 6 : 0;
            if (EN(13) && RUN(sb + 11)) { PH; const float* inl = (hl == 0) ? F.in[I_X] : Fp.out; const float* inc = (hl == 0) ? F.in[I_CTX] : HC; phase_norm(Fp, inl, inc, normg + (second ? 2 : 0) * DM, mod, nbase, MK_I8GU ? nullptr : U, frows, HC, hl == 0 ? nullptr : Fp.wsf(WS_SST), MK_I8GU ? (unsigned char*)U : nullptr, Fp.wsf(WS_RSC)); SEAM(); }
            if (EN(14) && RUN(sb + 12)) { PH; pg8::ProbStd S{U, Fp.wsb(second ? WS_WGU2 : WS_WGU1), DM, DM, MK_I8GU ? DM / 2 : DM, frows / 256, 44, Fp.G, Fp.bid};
                pg8::EpiSwiglu<MK_I8GU != 0> E{HID, Fp.wsf(WS_RSC), (const float*)(Fp.ws + WS_CMAX) + (size_t)l * NQCOL + (second ? 11264 : 0), Fp.lds};
                pg8::gemm_phase<pg8::EpiSwiglu<MK_I8GU != 0>, pg8::ProbStd, MK_I8GU ? 1 : 0>(Fp.lds, S, E, Fp.tid); SEAM(); }
            if (EN(15) && RUN(sb + 13)) { PH; const float* inl = (hl == 0) ? F.in[I_X] : Fp.out; const float* inc = (hl == 0) ? F.in[I_CTX] : HC; pg8::ProbSplit S{HID, Fp.wsb(second ? WS_WDN2 : WS_WDN1), DFF, DFF, DFF, frows / 256, Fp.G, Fp.bid};
                pg8::EpiResid E{{(float*)inl, (float*)inc}, {Fp.out, HC}, mod, nbase + 2, 0.5f, Fp.wsf(WS_SST)};
                pg8::gemm_phase(Fp.lds, S, E, Fp.tid); if (hl != 3) SEAM(); }
        }
    }
#undef RUN
#undef SEAM
}

extern "C" void kernel_launch(void* const* d_in, const int* in_sizes, int n_in, void* d_out, int out_size, void* d_ws, size_t ws_size, hipStream_t stream) {
    static int grid = 0;
    if (grid == 0) {
        if (n_in != 30 || in_sizes[0] != NLAT * DM || out_size != NLAT * DM || ws_size < WS_END) {
            fprintf(stderr, "kernel_launch: unexpected shapes (n_in %d in0 %d out %d ws %zu, need ws >= %zu); nothing launched\n", n_in, n_in > 0 ? in_sizes[0] : -1, out_size, ws_size, (size_t)WS_END); grid = -1; return; }
        int dev = 0, cus = 0, per_cu = 0;
        if (hipGetDevice(&dev) != hipSuccess || hipDeviceGetAttribute(&cus, hipDeviceAttributeMultiprocessorCount, dev) != hipSuccess) { grid = -1; return; }
        if (hipFuncSetAttribute((const void*)fwd_kernel, hipFuncAttributeMaxDynamicSharedMemorySize, LDS_BYTES) != hipSuccess) { fprintf(stderr, "kernel_launch: hipFuncSetAttribute failed\n"); grid = -1; return; }
        if (hipOccupancyMaxActiveBlocksPerMultiprocessor(&per_cu, (const void*)fwd_kernel, 512, LDS_BYTES) != hipSuccess || per_cu < 1) fprintf(stderr, "kernel_launch: occupancy query reports %d\n", per_cu);
        (void)hipGetLastError();
        if (cus < GRID) { fprintf(stderr, "kernel_launch: %d CUs < %d: the persistent grid would not be resident; nothing launched\n", cus, GRID); grid = -1; return; }
        grid = GRID;
    }
    if (grid < 0) return;
    if (hipMemsetAsync((char*)d_ws + WS_CTL, 0, CTL_ZERO_BYTES, stream) != hipSuccess) { fprintf(stderr, "kernel_launch: memset failed\n"); return; }
    Args a{};
    for (int i = 0; i < 30; ++i) a.in[i] = (const float*)d_in[i];
    a.out = (float*)d_out; a.ws = (unsigned char*)d_ws;
#if MK_PER_STEP
    for (int s = 0; s < NSTEPS; ++s) {
        if (s == 1) continue;
        const int hl = (s - 2) / 16, k = (s - 2) % 16;
        if (s >= 2) { if ((hl & 1) == 0 && k >= 1 && k <= 10) continue; if ((hl & 1) == 1 && k > 10 && false) continue; if (k > 13) continue; }
        a.st_lo = s; a.st_hi = s + 1;
        hipLaunchKernelGGL(fwd_kernel, dim3(grid), dim3(512), LDS_BYTES, stream, a);
    }
#else
    a.st_lo = 0; a.st_hi = NSTEPS;
    hipLaunchKernelGGL(fwd_kernel, dim3(grid), dim3(512), LDS_BYTES, stream, a);
#endif
    const hipError_t le = hipPeekAtLastError();
    if (le != hipSuccess) fprintf(stderr, "kernel_launch: launch failed: %s\n", hipGetErrorName(le));
}
```

```cpp
#include <hip/hip_runtime.h>
#include <cstdio>
#include <cstdint>

#ifndef MK_PER_STEP
#define MK_PER_STEP 0
#endif

#ifndef MK_I8GATE
#define MK_I8GATE 1
#endif
#ifndef MK_I8GU
#define MK_I8GU 1
#endif
#define LAS __attribute__((address_space(3)))
#define GAS __attribute__((address_space(1)))
typedef unsigned short bf16_t;
typedef short bf16x8 __attribute__((ext_vector_type(8)));
typedef short s16x4 __attribute__((ext_vector_type(4)));
typedef float f32x2 __attribute__((ext_vector_type(2)));
typedef float f32x4 __attribute__((ext_vector_type(4)));
typedef float f32x16 __attribute__((ext_vector_type(16)));
typedef unsigned u32x2 __attribute__((ext_vector_type(2)));
typedef unsigned u32x4 __attribute__((ext_vector_type(4)));
typedef int i32x4 __attribute__((ext_vector_type(4)));
typedef GAS unsigned gu32;

constexpr int DM = 2048, NB = 8, SEQ = 2048, CTX = 256, NLAT = NB * SEQ, NCTXR = NB * CTX, NROW = NLAT + NCTXR;
constexpr int DFF = 5632, NMOD = 9, DIN = 14432, DINP = 8448, NWIN = 14592;
constexpr int PC_Q = 0, PC_CKV = 1536, PC_Z = 2048, PC_XBC = 3072, PC_NAQ = 5120, PC_NAK = 6144, PC_NAV = 7168, PC_KR = 8192, PC_DT = 8256;
constexpr int GT0 = 33;
constexpr int KVROWS = CTX + SEQ;
constexpr int NCHUNK = 18;
constexpr float EPS = 1e-6f;
constexpr float LOG2E = 1.4426950408889634f;

constexpr size_t MiB = 1u << 20;
constexpr size_t WS_CTL = 0, CTL_ZERO_BYTES = 4 * MiB;
constexpr size_t WS_MOD = 1 * MiB;
constexpr size_t WS_ROPE = 4 * MiB;
constexpr size_t WS_CDEC = 4 * MiB + 65536;
constexpr size_t WS_DT = 5 * MiB;
constexpr size_t WS_HC = 8 * MiB;
constexpr size_t WS_WGU1 = 24 * MiB, WS_WDN1 = 68 * MiB, WS_WGU2 = 90 * MiB, WS_WDN2 = 134 * MiB, WS_WIN = 156 * MiB, WS_WUKV = 213 * MiB, WS_WBR = 215 * MiB, WS_WOUT = 227 * MiB;
constexpr size_t WS_U = 236 * MiB;
constexpr size_t WS_P = 308 * MiB;
constexpr size_t WS_GATE = 605 * MiB;
constexpr size_t WS_K = 821 * MiB;
constexpr size_t WS_V = 875 * MiB;
constexpr size_t WS_XBC = 911 * MiB;
constexpr size_t WS_SST = 983 * MiB;
constexpr size_t WS_BR = 1127 * MiB;
constexpr size_t WS_END = 1235 * MiB;
constexpr int CW_TMO = 0, CW_BAR = 4096, CW_Q = 16384;
constexpr size_t WS_GSS = 3 * MiB;
constexpr size_t WS_CMAX = 3 * MiB + 640 * 1024;
constexpr size_t WS_RSC = 4 * MiB + 131072;
constexpr size_t WS_U8M = WS_XBC;
constexpr int NQCOL = 28672;
constexpr size_t WS_SENT = WS_U;

constexpr int LDS_SCRATCH = 155648, MISC_OFF = LDS_SCRATCH, LDS_BYTES = 159744;

__device__ __forceinline__ float bf2f(unsigned short b) { return __uint_as_float(((unsigned)b) << 16); }
__device__ __forceinline__ unsigned pk2(float lo, float hi) { unsigned r; asm("v_cvt_pk_bf16_f32 %0, %1, %2" : "=v"(r) : "v"(lo), "v"(hi)); return r; }
__device__ __forceinline__ float lo16(unsigned w) { return __uint_as_float(w << 16); }
__device__ __forceinline__ float hi16(unsigned w) { return __uint_as_float(w & 0xffff0000u); }
__device__ __forceinline__ float fast_exp2(float x) { return __builtin_amdgcn_exp2f(x); }
__device__ __forceinline__ float fast_rcp(float x) { return __builtin_amdgcn_rcpf(x); }
__device__ __forceinline__ float sigmoidf_(float x) { return fast_rcp(1.0f + fast_exp2(-x * LOG2E)); }
__device__ __forceinline__ float siluf_(float x) { return x * sigmoidf_(x); }
__device__ __forceinline__ float wave_sum(float v) {
#pragma unroll
    for (int o = 1; o < 64; o <<= 1) v += __shfl_xor(v, o);
    return v;
}
#define LDS_WAIT() asm volatile("s_waitcnt lgkmcnt(0)" ::: "memory")
#define VM_WAIT() asm volatile("s_waitcnt vmcnt(0)" ::: "memory")

namespace pg8 {
constexpr int BM = 256, BK = 64, HALF = 128, HTB = HALF * BK * 2, STAGE_BYTES = 8 * HTB, NXCD = 8, WGM = 4;
__host__ __device__ __forceinline__ int lds_byte(int r, int c) { const int st = (r >> 4) * 2 + (c >> 5), rr = r & 15, cc = c & 31, ob = rr * 64 + cc * 2; return st * 1024 + (ob ^ (((ob >> 9) & 1) << 5)); }
__host__ __device__ __forceinline__ void stage_rc(int b, int& R, int& C) { const int st = b / 1024, sb = b % 1024, swz = sb ^ (((sb >> 9) & 1) << 5); R = (st >> 1) * 16 + swz / 64; C = (st & 1) * 32 + (swz % 64) / 2; }
__host__ __device__ __forceinline__ int perm32(int rho) { const int n = rho >> 4, i = rho & 15; return 8 * (i >> 2) + 4 * n + (i & 3); }
struct Unit { int pm, pn, sub; };
__device__ __forceinline__ unsigned cvt_pk_bf16(float lo, float hi) { unsigned r; asm volatile("v_cvt_pk_bf16_f32 %0, %1, %2" : "=v"(r) : "v"(lo), "v"(hi)); return r; }

__device__ __forceinline__ bool tile_of(long L, int nM, int nN, Unit& u) {
    const int nwg = nM * nN; if (L >= nwg) return false;
    int wgid = (int)L; { const int q = nwg / NXCD, r = nwg % NXCD, xcd = wgid % NXCD, off = wgid / NXCD; wgid = (xcd < r ? xcd * (q + 1) : r * (q + 1) + (xcd - r) * q) + off; }
    const int nig = WGM * nN, gid = wgid / nig, fm = gid * WGM, gsz = (nM - fm) < WGM ? (nM - fm) : WGM;
    u.pm = fm + ((wgid % nig) % gsz); u.pn = (wgid % nig) / gsz; u.sub = 0; return true;
}
struct ProbStd {
    const bf16_t* A; const bf16_t* Bt; int lda, ldb, K, nM, nN, G, c;
    __device__ __forceinline__ bool next(int i, Unit& u) const { return tile_of((long)i * G + c, nM, nN, u); }
    __device__ __forceinline__ const char* a_base(const Unit& u) const { return (const char*)(A + (size_t)u.pm * BM * lda); }
    __device__ __forceinline__ const char* b_base(const Unit& u) const { return (const char*)(Bt + (size_t)u.pn * BM * ldb); }
    __device__ __forceinline__ bool is_i8(const Unit&) const { return false; }
    __device__ __forceinline__ bool keep_acc(const Unit&) const { return false; }
    __device__ __forceinline__ int nt(const Unit&) const { return K / BK; }
};
struct ProbSplit {
    const bf16_t* A; const bf16_t* Bt; int lda, ldb, K, nM, G, c;
    __device__ __forceinline__ bool next(int i, Unit& u) const {
        if (i < 2) { const bool ok = tile_of((long)i * G + c, 64, 8, u); u.pm = 63 - u.pm; return ok; }
        if (i > 2 || nM == 64) return false;
        const int q = c >> 2; u.pm = 64 + (q >> 3); u.pn = q & 7; u.sub = 1 + (c & 3); return true; }
    __device__ __forceinline__ int nt(const Unit& u) const { return u.sub ? K / (4 * BK) : K / BK; }
    __device__ __forceinline__ const char* a_base(const Unit& u) const { return (const char*)(A + (size_t)u.pm * BM * lda + (u.sub ? (u.sub - 1) * (K / 4) : 0)); }
    __device__ __forceinline__ const char* b_base(const Unit& u) const { return (const char*)(Bt + (size_t)u.pn * BM * ldb + (u.sub ? (u.sub - 1) * (K / 4) : 0)); }
    __device__ __forceinline__ bool is_i8(const Unit&) const { return false; }
    __device__ __forceinline__ bool keep_acc(const Unit&) const { return false; }
};
struct ProbWin {
    const bf16_t* A; const bf16_t* Bt; int lda, ldb, K, full, G, c;
    __device__ __forceinline__ bool next(int i, Unit& u) const {
        const int L = i * G + c, per = full ? 33 : 19;
        Unit t; const bool lat = tile_of(L < 64 * 33 ? L : 0, 64, 33, t);
        const int r = L - 64 * 33, rr = r < 0 ? 0 : r, j = rr % per;
        const int cpn = full ? j : j + 6 + (j >= 2 ? 4 : 0) + (j >= 10 ? 4 : 0);
        const bool isl = L < 64 * 33;
        u.pm = isl ? t.pm : 64 + rr / per; u.pn = isl ? t.pn : cpn; u.sub = 0;
        return isl ? lat : (r < 8 * per); }
    __device__ __forceinline__ bool is_i8(const Unit&) const { return false; }
    __device__ __forceinline__ const char* a_base(const Unit& u) const { return (const char*)(A + (size_t)u.pm * BM * lda); }
    __device__ __forceinline__ const char* b_base(const Unit& u) const { return (const char*)(Bt + (size_t)u.pn * BM * ldb); }
    __device__ __forceinline__ bool keep_acc(const Unit&) const { return false; }
    __device__ __forceinline__ size_t a_kstep() const { return (size_t)BK * 2; }
    __device__ __forceinline__ int nt(const Unit&) const { return K / BK; }
};
struct ProbGate {
    const bf16_t* A8; const bf16_t* Bt; int lda, ldb, K, nM, G, c;
    __device__ __forceinline__ bool next(int i, Unit& u) const { const bool ok = tile_of((long)i * G + c, nM, 24, u); u.pn += GT0; return ok; }
    __device__ __forceinline__ bool is_i8(const Unit&) const { return true; }
    __device__ __forceinline__ const char* a_base(const Unit& u) const { return (const char*)(A8 + (size_t)u.pm * BM * lda); }
    __device__ __forceinline__ const char* b_base(const Unit& u) const { return (const char*)(Bt + (size_t)u.pn * BM * ldb); }
    __device__ __forceinline__ bool keep_acc(const Unit&) const { return false; }
    __device__ __forceinline__ size_t a_kstep() const { return (size_t)BK * 2; }
    __device__ __forceinline__ int nt(const Unit&) const { return K / BK; }
};
struct ProbWin57 {
    const bf16_t* A; const bf16_t* A8; const bf16_t* Bt; int lda, ldb, K, full, G, c;
    __device__ __forceinline__ bool next(int i, Unit& u) const {
        const int L = i * G + c, per = full ? 57 : 19;
        Unit t; const bool lat = tile_of(L < 64 * 57 ? L : 0, 64, 57, t);
        const int r = L - 64 * 57, rr = r < 0 ? 0 : r, j = rr % per;
        const int cpn = full ? j : j + 6 + (j >= 2 ? 4 : 0) + (j >= 10 ? 4 : 0);
        const bool isl = L < 64 * 57;
        u.pm = isl ? t.pm : 64 + rr / per; u.pn = isl ? t.pn : cpn; u.sub = 0;
        return isl ? lat : (r < 8 * per); }
    __device__ __forceinline__ const char* a_base(const Unit& u) const { return (const char*)((MK_I8GATE && u.pn >= GT0 ? A8 : A) + (size_t)u.pm * BM * lda); }
    __device__ __forceinline__ const char* b_base(const Unit& u) const { return (const char*)(Bt + (size_t)u.pn * BM * ldb); }
    __device__ __forceinline__ bool is_i8(const Unit& u) const { return MK_I8GATE && u.pn >= GT0; }
    __device__ __forceinline__ bool keep_acc(const Unit&) const { return false; }
    __device__ __forceinline__ int nt(const Unit& u) const { return (MK_I8GATE && u.pn >= GT0) ? K / (2 * BK) : K / BK; }
};
struct ProbMerge {
    const bf16_t* A; const bf16_t* Bt; int lda, ldb, K, nM, nN, G, c;
    __device__ __forceinline__ bool next(int i, Unit& u) const { const int t = i / 3; const bool ok = tile_of((long)t * G + c, nM, nN, u); u.sub = i - 3 * t; return ok; }
    __device__ __forceinline__ const char* a_base(const Unit& u) const { return (const char*)(A + (size_t)u.pm * BM * lda + u.sub * 1024); }
    __device__ __forceinline__ const char* b_base(const Unit& u) const { return (const char*)(Bt + (size_t)u.sub * DM * 1024 + (size_t)u.pn * BM * ldb); }
    __device__ __forceinline__ bool is_i8(const Unit&) const { return false; }
    __device__ __forceinline__ bool keep_acc(const Unit& u) const { return u.sub != 2; }
    __device__ __forceinline__ int nt(const Unit&) const { return K / BK; }
};

template <class Epi, class Prob, int MODE = 0>
__device__ __forceinline__ void gemm_phase(LAS unsigned char* lds, const Prob& S, const Epi& E, const int tid) {
    const int wid = __builtin_amdgcn_readfirstlane(tid >> 6), lane = tid & 63, wr = wid >> 2, wc = wid & 3, fr = lane & 15, fq = lane >> 4;
    unsigned voffA[2], voffB[2];
#pragma unroll
    for (int i = 0; i < 2; ++i) { int R, C; stage_rc(tid * 16 + i * 8192, R, C); const int Rb = Epi::PERM ? ((R & ~31) + perm32(R & 31)) : R;
        voffA[i] = (unsigned)(R * S.lda + C) * 2u; voffB[i] = (unsigned)(Rb * S.ldb + C) * 2u; }
    const size_t kstep = (size_t)(BK * 2);
    const size_t hstepA = (size_t)HALF * S.lda * 2, hstepB = (size_t)HALF * S.ldb * 2;
    const unsigned ldsw = (unsigned)wid * 1024u;
    constexpr unsigned STAGE_BYTES_ = 8u * HTB;
    const int aoff = lds_byte(wr * 64 + fr, fq * 8), boff = lds_byte(wc * 32 + fr, fq * 8);
#define PG8_SA(b, h) (((b) * 2 + (h)) * HTB)
#define PG8_SB(b, h) ((4 + (b) * 2 + (h)) * HTB)
#define PG8_STAGE(bufoff, gbase, voff) do { _Pragma("unroll") for (int _i = 0; _i < 2; ++_i) \
        __builtin_amdgcn_global_load_lds((const unsigned*)((const char*)(gbase) + (voff)[_i]), (LAS unsigned*)(lds + (bufoff) + ldsw + _i * 8192), 16, 0, 0); } while (0)
#define PG8_LDA(dst, b, h) do { _Pragma("unroll") for (int m = 0; m < 4; ++m) _Pragma("unroll") for (int k = 0; k < 2; ++k) dst[m][k] = *(const LAS bf16x8*)(lds + PG8_SA(b, h) + aoff + m * 2048 + k * 1024); } while (0)
#define PG8_LDB(dst, b, h) do { _Pragma("unroll") for (int n = 0; n < 2; ++n) _Pragma("unroll") for (int k = 0; k < 2; ++k) dst[n][k] = *(const LAS bf16x8*)(lds + PG8_SB(b, h) + boff + n * 2048 + k * 1024); } while (0)
#define PG8_MMA_I8(ai, bj, At, Bt) do { __builtin_amdgcn_s_setprio(1); _Pragma("unroll") for (int m = 0; m < 4; ++m) _Pragma("unroll") for (int n = 0; n < 2; ++n) _Pragma("unroll") for (int k = 0; k < 2; ++k) \
        acc[ai][bj][m][n] = __builtin_bit_cast(f32x4, __builtin_amdgcn_mfma_i32_16x16x64_i8(__builtin_bit_cast(i32x4, Bt[n][k]), __builtin_bit_cast(i32x4, At[m][k]), __builtin_bit_cast(i32x4, acc[ai][bj][m][n]), 0, 0, 0)); \
        __builtin_amdgcn_s_setprio(0); } while (0)
#define PG8_MMA_BF(ai, bj, At, Bt) do { __builtin_amdgcn_s_setprio(1); _Pragma("unroll") for (int m = 0; m < 4; ++m) _Pragma("unroll") for (int n = 0; n < 2; ++n) _Pragma("unroll") for (int k = 0; k < 2; ++k) \
        acc[ai][bj][m][n] = __builtin_amdgcn_mfma_f32_16x16x32_bf16(Bt[n][k], At[m][k], acc[ai][bj][m][n], 0, 0, 0); __builtin_amdgcn_s_setprio(0); } while (0)
#define PG8_WAIT_V(n) asm volatile("s_waitcnt vmcnt(" #n ")" ::: "memory")
#define PG8_WAIT_L(n) asm volatile("s_waitcnt lgkmcnt(" #n ")" ::: "memory")
#define PG8_BAR __builtin_amdgcn_s_barrier()
#define PG8_SCHED __builtin_amdgcn_sched_barrier(0)
#define PG8_KLOOP(MMAX) \
        for (int t = 0; t < nt; t += 2) { \
            const bool last = (t == nt - 2); \
            if (Epi::LDSSC && last) E.issue_scales(cur, lds + STAGE_BYTES_ + ldsw - (unsigned)wid * 256u, wr, wc, lane); \
            const char* a1 = cA + (size_t)(t + 1) * kstep; \
            const char* a2 = last ? nA : cA + (size_t)(t + 2) * kstep; const char* b2 = last ? nB : cB + (size_t)(t + 2) * kstep; \
            const char* a3 = a2 + kstep; const char* b3 = b2 + kstep; \
            PG8_LDB(B0, 0, 0); PG8_LDB(B1, 0, 1); PG8_SCHED; PG8_LDA(At, 0, 0); PG8_STAGE(PG8_SA(1, 1), a1 + hstepA, voffA); \
            PG8_WAIT_V(8); PG8_WAIT_L(0); PG8_BAR; MMAX(0, 0, At, B0); MMAX(0, 1, At, B1); PG8_BAR; PG8_SCHED; \
            PG8_LDA(At, 0, 1); PG8_STAGE(PG8_SB(0, 0), b2, voffB); PG8_STAGE(PG8_SB(0, 1), b2 + hstepB, voffB); PG8_STAGE(PG8_SA(0, 0), a2, voffA); \
            PG8_WAIT_V(8); PG8_WAIT_L(0); PG8_BAR; MMAX(1, 0, At, B0); MMAX(1, 1, At, B1); PG8_BAR; PG8_SCHED; \
            PG8_LDB(B0, 1, 0); PG8_LDB(B1, 1, 1); PG8_SCHED; PG8_LDA(At, 1, 0); PG8_STAGE(PG8_SA(0, 1), a2 + hstepA, voffA); \
            PG8_WAIT_V(8); PG8_WAIT_L(0); PG8_BAR; MMAX(0, 0, At, B0); MMAX(0, 1, At, B1); PG8_BAR; PG8_SCHED; \
            PG8_LDA(At, 1, 1); PG8_STAGE(PG8_SB(1, 0), b3, voffB); PG8_STAGE(PG8_SB(1, 1), b3 + hstepB, voffB); PG8_STAGE(PG8_SA(1, 0), a3, voffA); \
            PG8_WAIT_V(8); PG8_WAIT_L(0); PG8_BAR; MMAX(1, 0, At, B0); MMAX(1, 1, At, B1); PG8_BAR; PG8_SCHED; \
        }
    Unit cur, nxt; int ui = 0;
    if (!S.next(0, cur)) return;
    int nt = S.nt(cur); bool i8u = S.is_i8(cur); (void)i8u;
    f32x4 acc[2][2][4][2];
#pragma unroll
    for (int a = 0; a < 2; ++a)
#pragma unroll
        for (int b = 0; b < 2; ++b)
#pragma unroll
            for (int m = 0; m < 4; ++m)
#pragma unroll
                for (int n = 0; n < 2; ++n) acc[a][b][m][n] = (f32x4){0.f, 0.f, 0.f, 0.f};
    bf16x8 At[4][2], B0[2][2], B1[2][2];
    const char* cA = S.a_base(cur); const char* cB = S.b_base(cur);
    PG8_STAGE(PG8_SB(0, 0), cB, voffB); PG8_STAGE(PG8_SB(0, 1), cB + hstepB, voffB); PG8_STAGE(PG8_SA(0, 0), cA, voffA); PG8_STAGE(PG8_SA(0, 1), cA + hstepA, voffA);
    if (wr == 1) PG8_BAR;
    PG8_WAIT_V(2); PG8_BAR;
    PG8_STAGE(PG8_SB(1, 0), cB + kstep, voffB); PG8_STAGE(PG8_SA(1, 0), cA + kstep, voffA); PG8_STAGE(PG8_SB(1, 1), cB + hstepB + kstep, voffB);
    PG8_WAIT_V(6); PG8_BAR;
    for (;;) {
        const bool has_next = S.next(ui + 1, nxt);
        const char* nA = has_next ? S.a_base(nxt) : cA; const char* nB = has_next ? S.b_base(nxt) : cB;
        if (MODE == 1 || (MODE == 2 && i8u)) { PG8_KLOOP(PG8_MMA_I8) } else { PG8_KLOOP(PG8_MMA_BF) }
        if (wr == 0) PG8_BAR;
        E(acc, cur, wr, wc, fr, fq);
        if (!has_next) break;
        if (!S.keep_acc(cur)) {
#pragma unroll
            for (int a = 0; a < 2; ++a)
#pragma unroll
                for (int b = 0; b < 2; ++b)
#pragma unroll
                    for (int m = 0; m < 4; ++m)
#pragma unroll
                        for (int n = 0; n < 2; ++n) acc[a][b][m][n] = (f32x4){0.f, 0.f, 0.f, 0.f};
        }
        cur = nxt; cA = nA; cB = nB; ++ui; nt = S.nt(cur); i8u = S.is_i8(cur);
        if (wr == 1) PG8_BAR;
    }
    PG8_WAIT_V(0);
    PG8_BAR;
#undef PG8_SA
#undef PG8_SB
#undef PG8_STAGE
#undef PG8_LDA
#undef PG8_LDB
#undef PG8_MMA_I8
#undef PG8_MMA_BF
#undef PG8_KLOOP
#undef PG8_WAIT_V
#undef PG8_WAIT_L
#undef PG8_BAR
#undef PG8_SCHED
}

struct RowMap { float* lat; float* ctx;
    __device__ __forceinline__ float* tile(int pm) const { return pm < 64 ? lat + (size_t)pm * 256 * DM : ctx + (size_t)(pm - 64) * 256 * DM; } };

template <bool I8> struct EpiSwiglu {
    static constexpr bool PERM = true;
    static constexpr bool LDSSC = I8;
    bf16_t* O;
    const float* rsc; const float* cmax;
    LAS unsigned char* ldsb;
    __device__ __forceinline__ void issue_scales(const Unit& u, LAS unsigned char* slot, int wr, int wc, int lane) const {
        const float* rp = rsc + u.pm * BM + wr * 64 + lane;
        __builtin_amdgcn_global_load_lds((const unsigned*)rp, (LAS unsigned*)slot, 4, 0, 0);
        __builtin_amdgcn_global_load_lds((const unsigned*)(rp + HALF), (LAS unsigned*)(slot + 256), 4, 0, 0);
        __builtin_amdgcn_global_load_lds((const unsigned*)(cmax + u.pn * BM + (lane >> 5) * HALF + wc * 32 + (lane & 31)), (LAS unsigned*)(slot + 512), 4, 0, 0);
    }
    __device__ __forceinline__ void operator()(f32x4 (&acc)[2][2][4][2], const Unit& u, int wr, int wc, int fr, int fq) const {
        const int row0 = u.pm * BM + wr * 64 + fr, col0 = u.pn * 128 + wc * 32 + 8 * fq;
        const LAS float* sl = (const LAS float*)(ldsb + 8 * HTB + (wr * 4 + wc) * 768);
        f32x4 cs[2][2];
        if (I8) {
#pragma unroll
            for (int bj = 0; bj < 2; ++bj)
#pragma unroll
                for (int n = 0; n < 2; ++n) cs[bj][n] = *(const LAS f32x4*)(sl + 128 + bj * 32 + 8 * fq + 4 * n) * (1.0f / 127.0f);
        }
#pragma unroll
        for (int ai = 0; ai < 2; ++ai)
#pragma unroll
            for (int m = 0; m < 4; ++m) {
                f32x4 g0 = acc[ai][0][m][0], g1 = acc[ai][0][m][1], u0 = acc[ai][1][m][0], u1 = acc[ai][1][m][1], v0, v1;
                if (I8) { const float rs = sl[ai * 64 + 16 * m + fr];
                    const i32x4 ig0 = __builtin_bit_cast(i32x4, g0), ig1 = __builtin_bit_cast(i32x4, g1), iu0 = __builtin_bit_cast(i32x4, u0), iu1 = __builtin_bit_cast(i32x4, u1);
#pragma unroll
                    for (int j = 0; j < 4; ++j) { g0[j] = (float)ig0[j] * rs * cs[0][0][j]; g1[j] = (float)ig1[j] * rs * cs[0][1][j]; u0[j] = (float)iu0[j] * rs * cs[1][0][j]; u1[j] = (float)iu1[j] * rs * cs[1][1][j]; } }
#pragma unroll
                for (int j = 0; j < 4; ++j) { v0[j] = siluf_(g0[j]) * u0[j]; v1[j] = siluf_(g1[j]) * u1[j]; }
                u32x4 w; w.x = cvt_pk_bf16(v0[0], v0[1]); w.y = cvt_pk_bf16(v0[2], v0[3]); w.z = cvt_pk_bf16(v1[0], v1[1]); w.w = cvt_pk_bf16(v1[2], v1[3]);
                *(GAS u32x4*)((GAS bf16_t*)O + (size_t)(row0 + ai * HALF + m * 16) * DFF + col0) = w; }
    }
};
struct EpiResid {
    static constexpr bool LDSSC = false; __device__ __forceinline__ void issue_scales(const Unit&, LAS unsigned char*, int, int, int) const {}
    static constexpr bool PERM = false;
    RowMap base, out; const float* mod; int modidx; float mul; float* slab;
    __device__ __forceinline__ void operator()(f32x4 (&acc)[2][2][4][2], const Unit& u, int wr, int wc, int fr, int fq) const {
        const int r9 = u.pm < 64 ? (u.pm >> 3) : 8;
        const float* sc = mod + (size_t)r9 * (NMOD * DM) + modidx * DM;
        const int rloc = wr * 64 + fr, col0 = u.pn * BM + wc * 32 + 4 * fq;
        const float* bp = base.tile(u.pm); float* op = out.tile(u.pm);
        f32x4 sv[2][2];
#pragma unroll
        for (int bj = 0; bj < 2; ++bj)
#pragma unroll
            for (int n = 0; n < 2; ++n) sv[bj][n] = *(const f32x4*)(sc + col0 + bj * HALF + n * 16) * mul;
        const bool split = u.sub != 0;
        if (split) { op = slab + ((size_t)(u.sub - 1) * NCTXR + (size_t)(u.pm - 64) * 256) * DM; bp = op; }
        const GAS float* bpg = (const GAS float*)bp; GAS float* opg = (GAS float*)op;
#pragma unroll
        for (int ai = 0; ai < 2; ++ai)
#pragma unroll
            for (int mp = 0; mp < 2; ++mp) {
                f32x4 b[2][2][2];
#pragma unroll
                for (int mm = 0; mm < 2; ++mm) { const size_t off = (size_t)(rloc + ai * HALF + (2 * mp + mm) * 16) * DM + col0;
#pragma unroll
                    for (int bj = 0; bj < 2; ++bj)
#pragma unroll
                        for (int n = 0; n < 2; ++n) b[mm][bj][n] = split ? (f32x4){0.f, 0.f, 0.f, 0.f} : *(const GAS f32x4*)(bpg + off + bj * HALF + n * 16); }
#pragma unroll
                for (int mm = 0; mm < 2; ++mm) { const size_t off = (size_t)(rloc + ai * HALF + (2 * mp + mm) * 16) * DM + col0;
#pragma unroll
                    for (int bj = 0; bj < 2; ++bj)
#pragma unroll
                        for (int n = 0; n < 2; ++n) *(GAS f32x4*)(opg + off + bj * HALF + n * 16) = b[mm][bj][n] + sv[bj][n] * acc[ai][bj][2 * mp + mm][n]; }
            }
    }
};
struct EpiP {
    static constexpr bool LDSSC = false; __device__ __forceinline__ void issue_scales(const Unit&, LAS unsigned char*, int, int, int) const {}
    static constexpr bool PERM = true;
    bf16_t* O; int ldc;
    __device__ __forceinline__ void operator()(f32x4 (&acc)[2][2][4][2], const Unit& u, int wr, int wc, int fr, int fq) const {
        char* bu = (char*)(O + (size_t)(u.pm * BM + wr * 64) * ldc + u.pn * BM + wc * 32);
        const unsigned lo = (unsigned)(fr * ldc + 8 * fq) * 2u, s_m = (unsigned)(16 * ldc) * 2u, s_ai = (unsigned)(HALF * ldc) * 2u, s_bj = (unsigned)HALF * 2u;
#pragma unroll
        for (int ai = 0; ai < 2; ++ai)
#pragma unroll
            for (int m = 0; m < 4; ++m)
#pragma unroll
                for (int bj = 0; bj < 2; ++bj) { const f32x4 v0 = acc[ai][bj][m][0], v1 = acc[ai][bj][m][1];
                    u32x4 w; w.x = cvt_pk_bf16(v0[0], v0[1]); w.y = cvt_pk_bf16(v0[2], v0[3]); w.z = cvt_pk_bf16(v1[0], v1[1]); w.w = cvt_pk_bf16(v1[2], v1[3]);
                    *(u32x4*)(bu + (size_t)(ai * s_ai + m * s_m + bj * s_bj) + lo) = w; }
    }
};
struct EpiGate {
    static constexpr bool LDSSC = false; __device__ __forceinline__ void issue_scales(const Unit&, LAS unsigned char*, int, int, int) const {}
    static constexpr bool PERM = true;
    bf16_t* G; const float* rsc; const float* cmax;
    __device__ __forceinline__ void operator()(f32x4 (&acc)[2][2][4][2], const Unit& u, int wr, int wc, int fr, int fq) const {
        char* bu = (char*)(G + ((size_t)((u.pm * 24 + (u.pn - GT0)) * 8 + wr * 4 + wc) * 16) * 512);
        const unsigned lo = (unsigned)(fq * 16 + fr) * 16u;
        const float* cm = cmax + (u.pn - GT0) * BM + wc * 32 + 8 * fq;
        const float* rp = rsc + u.pm * BM + wr * 64 + fr;
        f32x4 cs[2][2];
#pragma unroll
        for (int bj = 0; bj < 2; ++bj) { cs[bj][0] = *(const f32x4*)(cm + bj * HALF) * (1.0f / 127.0f); cs[bj][1] = *(const f32x4*)(cm + bj * HALF + 4) * (1.0f / 127.0f); }
#pragma unroll
        for (int ai = 0; ai < 2; ++ai)
#pragma unroll
            for (int m = 0; m < 4; ++m) { const float rs = rp[ai * HALF + m * 16];
#pragma unroll
                for (int bj = 0; bj < 2; ++bj) { const i32x4 i0 = __builtin_bit_cast(i32x4, acc[ai][bj][m][0]), i1 = __builtin_bit_cast(i32x4, acc[ai][bj][m][1]); f32x4 v0, v1;
#pragma unroll
                    for (int j = 0; j < 4; ++j) { if (MK_I8GATE) { v0[j] = sigmoidf_((float)i0[j] * rs * cs[bj][0][j]); v1[j] = sigmoidf_((float)i1[j] * rs * cs[bj][1][j]); } else { v0[j] = sigmoidf_(acc[ai][bj][m][0][j]); v1[j] = sigmoidf_(acc[ai][bj][m][1][j]); } }
                    u32x4 w; w.x = cvt_pk_bf16(v0[0], v0[1]); w.y = cvt_pk_bf16(v0[2], v0[3]); w.z = cvt_pk_bf16(v1[0], v1[1]); w.w = cvt_pk_bf16(v1[2], v1[3]);
                    *(u32x4*)(bu + (size_t)(ai * 8 + m * 2 + bj) * 1024 + lo) = w; } }
    }
};
struct EpiP57 {
    static constexpr bool LDSSC = false; __device__ __forceinline__ void issue_scales(const Unit&, LAS unsigned char*, int, int, int) const {}
    static constexpr bool PERM = true;
    bf16_t* O; int ldc; bf16_t* G; const float* rsc; const float* cmax;
    __device__ __forceinline__ void operator()(f32x4 (&acc)[2][2][4][2], const Unit& u, int wr, int wc, int fr, int fq) const {
        const bool gate = u.pn >= GT0;
        char* bu = gate ? (char*)(G + ((size_t)((u.pm * 24 + (u.pn - GT0)) * 8 + wr * 4 + wc) * 16) * 512)
                        : (char*)(O + (size_t)(u.pm * BM + wr * 64) * ldc + u.pn * BM + wc * 32);
        const unsigned lo = gate ? (unsigned)(fq * 16 + fr) * 16u : (unsigned)(fr * ldc + 8 * fq) * 2u;
        const unsigned s_m = gate ? 2u * 1024u : (unsigned)(16 * ldc) * 2u, s_ai = gate ? 8u * 1024u : (unsigned)(HALF * ldc) * 2u, s_bj = gate ? 1024u : (unsigned)HALF * 2u;
        f32x4 cs[2][2];
        if (MK_I8GATE && gate) { const float* cm = cmax + (u.pn - GT0) * BM + wc * 32 + 8 * fq;
#pragma unroll
            for (int bj = 0; bj < 2; ++bj) { cs[bj][0] = *(const f32x4*)(cm + bj * HALF) * (1.0f / 127.0f); cs[bj][1] = *(const f32x4*)(cm + bj * HALF + 4) * (1.0f / 127.0f); } }
        const float* rp = rsc + u.pm * BM + wr * 64 + fr;
#pragma unroll
        for (int ai = 0; ai < 2; ++ai)
#pragma unroll
            for (int m = 0; m < 4; ++m) { float rs = 1.0f; if (MK_I8GATE && gate) rs = rp[ai * HALF + m * 16];
#pragma unroll
                for (int bj = 0; bj < 2; ++bj) { f32x4 v0 = acc[ai][bj][m][0], v1 = acc[ai][bj][m][1];
                    if (gate) {
                        if (MK_I8GATE) { const i32x4 i0 = __builtin_bit_cast(i32x4, v0), i1 = __builtin_bit_cast(i32x4, v1);
#pragma unroll
                            for (int j = 0; j < 4; ++j) { v0[j] = (float)i0[j] * rs * cs[bj][0][j]; v1[j] = (float)i1[j] * rs * cs[bj][1][j]; } }
#pragma unroll
                        for (int j = 0; j < 4; ++j) { v0[j] = sigmoidf_(v0[j]); v1[j] = sigmoidf_(v1[j]); } }
                    u32x4 w; w.x = cvt_pk_bf16(v0[0], v0[1]); w.y = cvt_pk_bf16(v0[2], v0[3]); w.z = cvt_pk_bf16(v1[0], v1[1]); w.w = cvt_pk_bf16(v1[2], v1[3]);
                    *(u32x4*)(bu + (size_t)(ai * s_ai + m * s_m + bj * s_bj) + lo) = w; } }
    }
};
struct EpiKV {
    static constexpr bool LDSSC = false; __device__ __forceinline__ void issue_scales(const Unit&, LAS unsigned char*, int, int, int) const {}
    static constexpr bool PERM = true;
    bf16_t* Kb; bf16_t* Vb;
    __device__ __forceinline__ void operator()(f32x4 (&acc)[2][2][4][2], const Unit& u, int wr, int wc, int fr, int fq) const {
        const int kv0 = u.pm < 64 ? (u.pm >> 3) * KVROWS + CTX + (u.pm & 7) * 256 : (u.pm - 64) * KVROWS;
        const bool isk = u.pn < 4;
        const int ld = isk ? 1536 : 1024, bjs = isk ? 192 : 128;
        bf16_t* dst = (isk ? Kb + u.pn * 384 : Vb + (u.pn - 4) * 256) + (size_t)(kv0 + wr * 64 + fr) * ld + wc * 32 + 8 * fq;
#pragma unroll
        for (int ai = 0; ai < 2; ++ai)
#pragma unroll
            for (int m = 0; m < 4; ++m)
#pragma unroll
                for (int bj = 0; bj < 2; ++bj) { const f32x4 v0 = acc[ai][bj][m][0], v1 = acc[ai][bj][m][1];
                    u32x4 w; w.x = cvt_pk_bf16(v0[0], v0[1]); w.y = cvt_pk_bf16(v0[2], v0[3]); w.z = cvt_pk_bf16(v1[0], v1[1]); w.w = cvt_pk_bf16(v1[2], v1[3]);
                    *(u32x4*)(dst + (size_t)(ai * HALF + m * 16) * ld + bj * bjs) = w; }
    }
};
struct EpiMerge {
    static constexpr bool LDSSC = false; __device__ __forceinline__ void issue_scales(const Unit&, LAS unsigned char*, int, int, int) const {}
    static constexpr bool PERM = true;
    const bf16_t* G; bf16_t* O;
    __device__ __forceinline__ void operator()(f32x4 (&acc)[2][2][4][2], const Unit& u, int wr, int wc, int fr, int fq) const {
        const int row0 = u.pm * BM + wr * 64 + fr, col0 = u.pn * BM + wc * 32 + 8 * fq;
        const bf16_t* gp = G + ((size_t)((u.pm * 24 + u.sub * 8 + u.pn) * 8 + wr * 4 + wc) * 16) * 512 + (fq * 16 + fr) * 8;
        constexpr size_t NEXTB = (size_t)8 * 8 * 16 * 512;
#pragma unroll
        for (int ai = 0; ai < 2; ++ai)
#pragma unroll
            for (int m = 0; m < 4; ++m) { const size_t row = (size_t)(row0 + ai * HALF + m * 16);
#pragma unroll
                for (int bj = 0; bj < 2; ++bj) {
                    const bf16_t* gq = gp + ((ai * 4 + m) * 2 + bj) * 512;
                    const u32x4 ga = *(const u32x4*)gq;
                    float f[8] = {lo16(ga.x), hi16(ga.x), lo16(ga.y), hi16(ga.y), lo16(ga.z), hi16(ga.z), lo16(ga.w), hi16(ga.w)};
                    if (u.sub != 2) { const u32x4 gb = *(const u32x4*)(gq + NEXTB);
                        const float d[8] = {lo16(gb.x), hi16(gb.x), lo16(gb.y), hi16(gb.y), lo16(gb.z), hi16(gb.z), lo16(gb.w), hi16(gb.w)};
#pragma unroll
                        for (int j = 0; j < 8; ++j) f[j] = f[j] * fast_rcp(fmaxf(d[j], 1e-20f)); }
                    f32x4 v0 = acc[ai][bj][m][0], v1 = acc[ai][bj][m][1];
#pragma unroll
                    for (int j = 0; j < 4; ++j) { v0[j] *= f[j]; v1[j] *= f[4 + j]; }
                    acc[ai][bj][m][0] = v0; acc[ai][bj][m][1] = v1;
                    if (u.sub == 2) { u32x4 w; w.x = cvt_pk_bf16(v0[0], v0[1]); w.y = cvt_pk_bf16(v0[2], v0[3]); w.z = cvt_pk_bf16(v1[0], v1[1]); w.w = cvt_pk_bf16(v1[2], v1[3]);
                        *(u32x4*)(O + row * DM + col0 + bj * HALF) = w; } } }
    }
};
}

#define XB_TMO      128
#define XB_XCNT(j)  (256  + 64 * (j))
#define XB_XSUB(j)  (1280 + 64 * (j))
#define XB_XGEN(j)  (2304 + 64 * (j))
#define XB_TOP      3328
#define XB_TOPGEN   3392
#define XCD_BAR_WORDS 3456
#define XB_SPIN_CAP (1u << 22)
__device__ __forceinline__ unsigned xb_ld(unsigned* p)              { return __hip_atomic_load(p, __ATOMIC_RELAXED, __HIP_MEMORY_SCOPE_AGENT); }
__device__ __forceinline__ unsigned xb_add(unsigned* p, unsigned v) { return __hip_atomic_fetch_add(p, v, __ATOMIC_RELAXED, __HIP_MEMORY_SCOPE_AGENT); }
__device__ __forceinline__ unsigned xb_xcc_id() { return (unsigned)__builtin_amdgcn_s_getreg((3 << 11) | 20) & 0xFu; }
#define XB_SPIN(cond, bar) do { unsigned _sp = 0; while (cond) { __builtin_amdgcn_s_sleep(1); \
    if ((++_sp & 255u) == 0u) { if (xb_ld(&(bar)[XB_TMO])) break; if (_sp > XB_SPIN_CAP) { atomicAdd(&(bar)[XB_TMO], 1u); break; } } } } while (0)
struct XcdBarrier { unsigned* bar; unsigned x; volatile LAS unsigned* st; };
__device__ __forceinline__ XcdBarrier xcd_barrier_post(unsigned* bar, volatile LAS unsigned* st) {
    XcdBarrier b; b.bar = bar; b.x = xb_xcc_id(); b.st = st;
    if (threadIdx.x == 0) (void)xb_add(&bar[XB_XCNT(b.x)], 1u);
    return b;
}
__device__ __forceinline__ void xcd_barrier_complete(unsigned* bar, unsigned x, unsigned& nloc, unsigned& nx) {
    const unsigned G = gridDim.x * gridDim.y * gridDim.z;
    unsigned sum, cnt, mine, sp = 0u;
    for (;;) {
        sum = 0u; cnt = 0u; mine = 0u;
#pragma unroll
        for (unsigned j = 0; j < 16; ++j) { const unsigned c = xb_ld(&bar[XB_XCNT(j)]); sum += c; cnt += (c > 0u) ? 1u : 0u; mine = (j == x) ? c : mine; }
        if (sum == G) break;
        __builtin_amdgcn_s_sleep(1);
        if ((++sp & 255u) == 0u) { if (xb_ld(&bar[XB_TMO])) break; if (sp > XB_SPIN_CAP) { atomicAdd(&bar[XB_TMO], 1u); break; } }
    }
    nloc = mine > 0u ? mine : 1u; nx = cnt > 0u ? cnt : 1u;
}
__device__ __forceinline__ void xcd_barrier(const XcdBarrier& b) {
    asm volatile("s_waitcnt vmcnt(0)" ::: "memory");
    __syncthreads();
    if (threadIdx.x == 0) {
        unsigned* bar = b.bar;
        __builtin_amdgcn_s_waitcnt(0);
        unsigned nloc = b.st[0], nx = b.st[1];
        if (nloc == 0u) { xcd_barrier_complete(bar, b.x, nloc, nx); b.st[0] = nloc; b.st[1] = nx; }
        const unsigned old = xb_add(&bar[XB_XSUB(b.x)], 1u);
        const unsigned gen = old / nloc;
        if (old + 1u == (gen + 1u) * nloc) {
            __builtin_amdgcn_fence(__ATOMIC_RELEASE, "agent");
            asm volatile("s_waitcnt vmcnt(0)" ::: "memory");
            const unsigned og = xb_add(&bar[XB_TOP], 1u);
            const unsigned tg = og / nx;
            if (og + 1u == (tg + 1u) * nx) xb_add(&bar[XB_TOPGEN], 1u);
            else XB_SPIN(xb_ld(&bar[XB_TOPGEN]) == tg, bar);
            __builtin_amdgcn_fence(__ATOMIC_ACQUIRE, "agent");
            xb_add(&bar[XB_XGEN(b.x)], 1u);
            asm volatile("s_waitcnt vmcnt(0)" ::: "memory");
        } else {
            XB_SPIN(xb_ld(&bar[XB_XGEN(b.x)]) == gen, bar);
            __builtin_amdgcn_fence(__ATOMIC_ACQUIRE, "agent");
            asm volatile("s_waitcnt vmcnt(0)" ::: "memory");
        }
    }
    __syncthreads();
}

struct Args { const float* in[30]; float* out; unsigned char* ws; int st_lo, st_hi; };
enum { I_X = 0, I_C, I_CTX, I_CCTX, I_WADA, I_BADA, I_NORMG, I_F1G, I_F1U, I_F1D, I_F2G, I_F2U, I_F2D, I_WIN, I_KVG, I_WUK, I_WUV, I_QG, I_KG, I_CONVW, I_CONVB, I_ALOG, I_DTB, I_SSDD, I_SSDG, I_NAQG, I_NAKG, I_RPB, I_WBR, I_WOUT };

constexpr int GRID = 256;
struct Frame {
    LAS unsigned char* lds; int tid, lane, wave, bid; static constexpr int G = GRID;
    const float* const* in; float* out; unsigned char* ws;
    __device__ __forceinline__ bf16_t* wsb(size_t off) const { return (bf16_t*)(ws + off); }
    __device__ __forceinline__ float* wsf(size_t off) const { return (float*)(ws + off); }
};

__device__ __forceinline__ int row_r9(int row) { return row < NLAT ? (row >> 11) : 8; }
__device__ __forceinline__ int row_kv(int row) { return row < NLAT ? (row >> 11) * KVROWS + CTX + (row & 2047) : ((row - NLAT) >> 8) * KVROWS + ((row - NLAT) & 255); }

__device__ __forceinline__ void transpose_item(const float* W, int N, int src_n0, bf16_t* WT, int ldt, int dst_n0, int k0, LAS float* scr, int lane) {
    if (src_n0 >= 0) {
        const GAS float* src = (const GAS float*)W + (size_t)(k0 + (lane >> 3)) * N + src_n0 + 4 * (lane & 7);
        f32x4 v[8];
#pragma unroll
        for (int i = 0; i < 8; ++i) v[i] = *(const GAS f32x4*)(src + (size_t)(8 * i) * N);
#pragma unroll
        for (int i = 0; i < 8; ++i) { LAS float* d = scr + (8 * i + (lane >> 3)) * 33 + 4 * (lane & 7); d[0] = v[i].x; d[1] = v[i].y; d[2] = v[i].z; d[3] = v[i].w; }
    } else {
#pragma unroll 8
        for (int i = 0; i < 32; ++i) { const int kk = 2 * i + (lane >> 5); scr[kk * 33 + (lane & 31)] = 0.f; }
    }
    LDS_WAIT(); asm volatile("" ::: "memory");
    const int c = lane & 7;
#pragma unroll
    for (int j = 0; j < 4; ++j) { const int n = (lane >> 3) + 8 * j; const LAS float* s = scr + (8 * c) * 33 + n;
        u32x4 o; o.x = pk2(s[0 * 33], s[1 * 33]); o.y = pk2(s[2 * 33], s[3 * 33]); o.z = pk2(s[4 * 33], s[5 * 33]); o.w = pk2(s[6 * 33], s[7 * 33]);
        *(GAS u32x4*)(WT + (size_t)(dst_n0 + n) * ldt + k0 + 8 * c) = o; }
    LDS_WAIT(); asm volatile("" ::: "memory");
}
__device__ __forceinline__ int win_src_col(int n) {
    if (n < 2048) return n;
    if (n < 5120) return n + 64;
    if (n < 8192) return n + 96;
    if (n < 8256) return n - 6144;
    if (n < 8288) return n - 3072;
    if (n < 8448) return -1;
    return n - 160;
}
__device__ __forceinline__ void absmax_item(const float* W, int N, int src_n0, unsigned* cmax, int k0, int lane) {
    float m = 0.f;
#pragma unroll 8
    for (int i = 0; i < 32; ++i) { const int kk = 2 * i + (lane >> 5); m = fmaxf(m, fabsf(W[(size_t)(k0 + kk) * N + src_n0 + (lane & 31)])); }
    m = fmaxf(m, __shfl_xor(m, 32));
    if (lane < 32) atomicMax(cmax + lane, __float_as_uint(m));
}
__device__ __forceinline__ void quant_item(const float* W, int N, int src_n0, unsigned char* WT8, int dst_n0, int k0, const unsigned* cmax, LAS float* scr, int lane) {
#pragma unroll 8
    for (int i = 0; i < 32; ++i) { const int kk = 2 * i + (lane >> 5); scr[kk * 33 + (lane & 31)] = W[(size_t)(k0 + kk) * N + src_n0 + (lane & 31)]; }
    LDS_WAIT(); asm volatile("" ::: "memory");
    const int c = lane & 3;
#pragma unroll
    for (int j = 0; j < 2; ++j) { const int n = (lane >> 2) + 16 * j; const float mx = __uint_as_float(cmax[n]), inv = mx > 0.f ? 127.0f / mx : 0.f;
        const LAS float* sp = scr + (16 * c) * 33 + n; unsigned w[4];
#pragma unroll
        for (int d = 0; d < 4; ++d) { unsigned x = 0;
#pragma unroll
            for (int e = 0; e < 4; ++e) { int q = __float2int_rn(sp[(4 * d + e) * 33] * inv); q = q > 127 ? 127 : (q < -127 ? -127 : q); x |= ((unsigned)q & 255u) << (8 * e); }
            w[d] = x; }
        *(GAS u32x4*)(WT8 + (size_t)(dst_n0 + n) * 4096 + k0 + 16 * c) = (u32x4){w[0], w[1], w[2], w[3]}; }
    LDS_WAIT(); asm volatile("" ::: "memory");
}
__device__ __forceinline__ void quant_block(const Frame& F, const float* W, int N, int src_n0, unsigned char* WT8, int dst_n0, float* cmax_out) {
    constexpr int QP = 4104;
    LAS unsigned char* LT = F.lds; LAS float* red = (LAS float*)(F.lds + 32 * QP); LAS float* cml = red + 256;
    int tq = F.tid; asm volatile("" : "+v"(tq));
    const int lane = tq & 63, n = lane & 31, kp = lane >> 5;
    __syncthreads();
    {
        (void)n; (void)kp;
        const int c4 = lane & 7, kr = lane >> 3;
        const GAS float* src = (const GAS float*)W + (size_t)(F.wave * 256 + kr) * N + src_n0 + 4 * c4;
        LAS unsigned char* lcol = LT + (4 * c4) * QP + (F.wave * 256 + kr) * 2;
        float m0 = 0.f, m1 = 0.f, m2 = 0.f, m3 = 0.f;
#pragma unroll 1
        for (int i0 = 0; i0 < 32; i0 += 16) { f32x4 v[16];
#pragma unroll
            for (int j = 0; j < 16; ++j) v[j] = *(const GAS f32x4*)(src + (size_t)(8 * (i0 + j)) * N);
#pragma unroll
            for (int j = 0; j < 16; ++j) { m0 = fmaxf(m0, fabsf(v[j].x)); m1 = fmaxf(m1, fabsf(v[j].y)); m2 = fmaxf(m2, fabsf(v[j].z)); m3 = fmaxf(m3, fabsf(v[j].w));
                LAS unsigned char* d = lcol + 16 * (i0 + j);
                *(LAS bf16_t*)(d) = (bf16_t)(pk2(v[j].x, v[j].x) & 0xffffu); *(LAS bf16_t*)(d + QP) = (bf16_t)(pk2(v[j].y, v[j].y) & 0xffffu);
                *(LAS bf16_t*)(d + 2 * QP) = (bf16_t)(pk2(v[j].z, v[j].z) & 0xffffu); *(LAS bf16_t*)(d + 3 * QP) = (bf16_t)(pk2(v[j].w, v[j].w) & 0xffffu); } }
#pragma unroll
        for (int o = 8; o < 64; o <<= 1) { m0 = fmaxf(m0, __shfl_xor(m0, o)); m1 = fmaxf(m1, __shfl_xor(m1, o)); m2 = fmaxf(m2, __shfl_xor(m2, o)); m3 = fmaxf(m3, __shfl_xor(m3, o)); }
        if (lane < 8) { LAS float* r = red + F.wave * 32 + 4 * lane; r[0] = m0; r[1] = m1; r[2] = m2; r[3] = m3; }
    }
    __syncthreads();
    if (tq < 32) { float mx = red[tq];
#pragma unroll
        for (int w = 1; w < 8; ++w) mx = fmaxf(mx, red[w * 32 + tq]);
        cml[tq] = mx; cmax_out[tq] = mx; }
    __syncthreads();
    {   const int nn = tq >> 4, c = tq & 15; const float mx = cml[nn], inv = mx > 0.f ? 127.0f / mx : 0.f;
        const LAS unsigned char* lr = LT + nn * QP; unsigned char* orow = WT8 + (size_t)(dst_n0 + nn) * 4096;
#pragma unroll
        for (int j = 0; j < 8; ++j) { const int k0 = (c + 16 * j) * 16; unsigned w4[4];
#pragma unroll
            for (int d = 0; d < 4; ++d) { const u32x2 pr = *(const LAS u32x2*)(lr + k0 * 2 + d * 8);
                int q0 = __float2int_rn(lo16(pr.x) * inv), q1 = __float2int_rn(hi16(pr.x) * inv), q2 = __float2int_rn(lo16(pr.y) * inv), q3 = __float2int_rn(hi16(pr.y) * inv);
                w4[d] = ((unsigned)q0 & 255u) | (((unsigned)q1 & 255u) << 8) | (((unsigned)q2 & 255u) << 16) | ((unsigned)q3 << 24); }
            *(GAS u32x4*)(orow + k0) = (u32x4){w4[0], w4[1], w4[2], w4[3]}; }
    }
}
__device__ __forceinline__ void phase_convert(const Frame& F, int l) {
    const int gw = F.bid * 8 + F.wave, NGW = F.G * 8;
    constexpr int I_GU = 32 * 352, I_DN = 88 * 64, I_IN = 32 * 456, I_UKV = 8 * 64, I_BR = 16 * 64, I_OUT = 32 * 64;
    constexpr int NITEMS = 2 * I_GU + 2 * I_DN + I_IN + I_UKV + 3 * I_BR + I_OUT;
    const size_t ffo = (size_t)l * DM * DFF;
    float* CM = (float*)(F.ws + WS_CMAX) + (size_t)l * NQCOL;
    {   constexpr int QB = (MK_I8GU ? 704 : 0) + (MK_I8GATE ? 192 : 0);
        for (int qi = F.bid; qi < QB; qi += F.G) { int r = qi;
            if (MK_I8GU && r < 704) { const int s = r >= 352 ? 1 : 0, nb = r - s * 352, pn = nb >> 3, jb = nb & 7;
                const float* W = F.in[(s ? I_F2G : I_F1G) + (jb >= 4 ? 1 : 0)] + ffo;
                quant_block(F, W, DFF, pn * 128 + (jb & 3) * 32, F.ws + (s ? WS_WGU2 : WS_WGU1), nb * 32, CM + s * 11264 + nb * 32); continue; }
            if (MK_I8GU) r -= 704;
            { const int nb = 264 + r;
              quant_block(F, F.in[I_WIN] + (size_t)l * DM * DIN, DIN, win_src_col(nb * 32), F.ws + WS_WIN, nb * 32, CM + 22528 + (nb - 264) * 32); } }
        __syncthreads();
    }
    LAS float* scr = (LAS float*)(F.lds + F.wave * 16384);
    for (int it = gw; it < NITEMS; it += NGW) {
        int r = it;
        if (r < 2 * I_GU) { if (MK_I8GU) continue; const int s = r >= I_GU; r -= s * I_GU; const int kb = r / 352, nb = r % 352, pn = nb >> 3, jb = nb & 7;
            const float* W = F.in[(s ? I_F2G : I_F1G) + (jb >= 4 ? 1 : 0)] + ffo;
            transpose_item(W, DFF, pn * 128 + (jb & 3) * 32, F.wsb(s ? WS_WGU2 : WS_WGU1), DM, nb * 32, kb * 64, scr, F.lane);
            continue; }
        r -= 2 * I_GU;
        if (r < 2 * I_DN) { const int s = r >= I_DN; r -= s * I_DN; const int kb = r / 64, nb = r % 64;
            transpose_item(F.in[s ? I_F2D : I_F1D] + ffo, DM, nb * 32, F.wsb(s ? WS_WDN2 : WS_WDN1), DFF, nb * 32, kb * 64, scr, F.lane); continue; }
        r -= 2 * I_DN;
        if (r < I_IN) { const int kb = r / 456, nb = r % 456;
            if (MK_I8GATE && nb >= 264) continue;
            transpose_item(F.in[I_WIN] + (size_t)l * DM * DIN, DIN, win_src_col(nb * 32), F.wsb(WS_WIN), DM, nb * 32, kb * 64, scr, F.lane);
            continue; }
        r -= I_IN;
        if (r < I_UKV) { const int kb = r / 64, nb = r % 64;
            transpose_item(F.in[nb < 32 ? I_WUK : I_WUV] + (size_t)l * 512 * 1024, 1024, (nb & 31) * 32, F.wsb(WS_WUKV), 512, nb * 32, kb * 64, scr, F.lane); continue; }
        r -= I_UKV;
        if (r < 3 * I_BR) { const int i = r / I_BR; r -= i * I_BR; const int kb = r / 64, nb = r % 64;
            transpose_item(F.in[I_WBR] + ((size_t)l * 3 + i) * 1024 * DM, DM, nb * 32, F.wsb(WS_WBR) + (size_t)i * DM * 1024, 1024, nb * 32, kb * 64, scr, F.lane); continue; }
        r -= 3 * I_BR;
        { const int kb = r / 64, nb = r % 64;
            transpose_item(F.in[I_WOUT] + (size_t)l * DM * DM, DM, nb * 32, F.wsb(WS_WOUT), DM, nb * 32, kb * 64, scr, F.lane); }
    }
}

__device__ __forceinline__ void phase_adaln(const Frame& F) {
    LAS float* sc = (LAS float*)F.lds;
    LAS float* red = (LAS float*)(F.lds + 16384);
    float* MOD = F.wsf(WS_MOD);
    if (F.bid == 0) {
        for (int i = F.tid; i < 1024; i += 512) { const int pos = i >> 4, f = i & 15;
            const float inv = fast_exp2(-(float)f * (13.287712379549449f / 16.0f)); const float ang = (float)pos * inv;
            ((f32x2*)F.wsf(WS_ROPE))[i] = (f32x2){cosf(ang), sinf(ang)}; }
    }
    for (int it = F.bid; it < 2 * 72 * 8; it += F.G) {
        const int l = it / 576, r0 = it % 576, cb = r0 >> 3, ks = r0 & 7, k0 = ks * 256, col0 = cb * 256;
        __syncthreads();
        for (int i = F.tid; i < 9 * 256; i += 512) { const int r = i >> 8, k = i & 255;
            const float c = r < 8 ? F.in[I_C][r * DM + k0 + k] : F.in[I_CCTX][k0 + k]; sc[i] = siluf_(c) ; }
        __syncthreads();
        const float* W = F.in[I_WADA] + ((size_t)l * DM + k0 + F.wave * 32) * (NMOD * DM) + col0 + 4 * F.lane;
        f32x4 acc[9];
#pragma unroll
        for (int r = 0; r < 9; ++r) acc[r] = (f32x4){0.f, 0.f, 0.f, 0.f};
#pragma unroll 4
        for (int kk = 0; kk < 32; ++kk) { const f32x4 w = *(const f32x4*)(W + (size_t)kk * (NMOD * DM));
#pragma unroll
            for (int r = 0; r < 9; ++r) acc[r] += w * sc[r * 256 + F.wave * 32 + kk]; }
#pragma unroll
        for (int r = 0; r < 9; ++r) *(LAS f32x4*)(red + (F.wave * 9 + r) * 256 + 4 * F.lane) = acc[r];
        __syncthreads();
        for (int i = F.tid; i < 9 * 256; i += 512) { float s = 0.f;
#pragma unroll
            for (int w = 0; w < 8; ++w) s += red[w * 2304 + i];
            const int r = i >> 8, j = col0 + (i & 255);
            if (ks == 0) s += F.in[I_BADA][(size_t)l * (NMOD * DM) + j];
            atomicAdd(MOD + ((size_t)l * 9 + r) * (NMOD * DM) + j, s); }
    }
}

__device__ __forceinline__ void phase_norm(const Frame& F, const float* lat, const float* ctx, const float* g, const float* mod, int base, bf16_t* U, int nrows, float* hcw, const float* slab, unsigned char* U8, float* rsc) {
    const int gw = F.bid * 8 + F.wave, NGW = F.G * 8;
    static_assert(NLAT == 8 * GRID * 8 && NCTXR == GRID * 8, "row deal of phase_norm");
    const int per = nrows > NLAT ? 9 : 8; (void)NGW;
    f32x4 ga[8], sh[8], nv[8]; int cur = -1;
#pragma unroll
    for (int j = 0; j < 8; ++j) nv[j] = (f32x4){0.f, 0.f, 0.f, 0.f};
    for (int i = 0; i < per; ++i) {
        const int row = i < 8 ? gw * 8 + i : NLAT + gw;
        const int r9 = row_r9(row);
        if (r9 != cur) { cur = r9; const float* ms = mod + (size_t)r9 * (NMOD * DM) + base * DM;
#pragma unroll
            for (int j = 0; j < 8; ++j) { const int c = 4 * F.lane + 256 * j; const f32x4 gg = *(const f32x4*)(g + c), scl = *(const f32x4*)(ms + DM + c); sh[j] = *(const f32x4*)(ms + c); ga[j] = gg * (scl + 1.0f); } }
        f32x4 v[8]; float s = 0.f;
        if (i == 0) { const GAS float* xr = (const GAS float*)(row < NLAT ? lat + (size_t)row * DM : ctx + (size_t)(row - NLAT) * DM);
#pragma unroll
            for (int j = 0; j < 8; ++j) nv[j] = *(const GAS f32x4*)(xr + 4 * F.lane + 256 * j); }
#pragma unroll
        for (int j = 0; j < 8; ++j) v[j] = nv[j];
        if (i + 1 < per) { const int nrow = i + 1 < 8 ? gw * 8 + i + 1 : NLAT + gw;
            const GAS float* xr = (const GAS float*)(nrow < NLAT ? lat + (size_t)nrow * DM : ctx + (size_t)(nrow - NLAT) * DM);
#pragma unroll
            for (int j = 0; j < 8; ++j) nv[j] = *(const GAS f32x4*)(xr + 4 * F.lane + 256 * j); }
        if (row >= NLAT && hcw) {
            if (slab) {
#pragma unroll
                for (int q = 0; q < 4; ++q) { const float* sp = slab + ((size_t)q * NCTXR + (row - NLAT)) * DM + 4 * F.lane;
#pragma unroll
                    for (int j = 0; j < 8; ++j) v[j] += *(const f32x4*)(sp + 256 * j); } }
            float* hw = hcw + (size_t)(row - NLAT) * DM + 4 * F.lane;
#pragma unroll
            for (int j = 0; j < 8; ++j) *(f32x4*)(hw + 256 * j) = v[j];
        }
#pragma unroll
        for (int j = 0; j < 8; ++j) s += (v[j].x * v[j].x + v[j].y * v[j].y) + (v[j].z * v[j].z + v[j].w * v[j].w);
        const float rs = rsqrtf(wave_sum(s) * (1.0f / DM) + EPS);
        float amax = 0.f;
#pragma unroll
        for (int j = 0; j < 8; ++j) { v[j] = v[j] * rs * ga[j] + sh[j]; amax = fmaxf(fmaxf(amax, fmaxf(fabsf(v[j].x), fabsf(v[j].y))), fmaxf(fabsf(v[j].z), fabsf(v[j].w))); }
        if (U) { bf16_t* o = U + (size_t)row * DM;
#pragma unroll
            for (int j = 0; j < 8; ++j) { u32x2 w; w.x = pk2(v[j].x, v[j].y); w.y = pk2(v[j].z, v[j].w); *(u32x2*)(o + 4 * F.lane + 256 * j) = w; } }
        if (U8) {
#pragma unroll
            for (int o = 1; o < 64; o <<= 1) amax = fmaxf(amax, __shfl_xor(amax, o));
            const float inv = amax > 0.f ? 127.0f / amax : 0.f;
            unsigned* o8 = (unsigned*)(U8 + (size_t)row * 4096);
#pragma unroll
            for (int j = 0; j < 8; ++j) { const int q0 = __float2int_rn(v[j].x * inv), q1 = __float2int_rn(v[j].y * inv), q2 = __float2int_rn(v[j].z * inv), q3 = __float2int_rn(v[j].w * inv);
                o8[F.lane + 64 * j] = ((unsigned)q0 & 255u) | (((unsigned)q1 & 255u) << 8) | (((unsigned)q2 & 255u) << 16) | ((unsigned)q3 << 24); }
            if (F.lane == 0) rsc[row] = amax * (1.0f / 127.0f);
        }
    }
}

__device__ __forceinline__ void norm192_rope(float (&nope)[16], float (&x1)[4], float (&x2)[4], const float* g, const f32x2* rope, bool lat, int t, int p, float scale) {
    float ss = 0.f;
#pragma unroll
    for (int i = 0; i < 16; ++i) ss += nope[i] * nope[i];
#pragma unroll
    for (int i = 0; i < 4; ++i) ss += x1[i] * x1[i] + x2[i] * x2[i];
    ss += __shfl_xor(ss, 1); ss += __shfl_xor(ss, 2); ss += __shfl_xor(ss, 4);
    const float rs = rsqrtf(ss * (1.0f / 192.0f) + EPS);
    const int a = p >> 2, f0 = (p & 3) * 4;
#pragma unroll
    for (int i = 0; i < 16; ++i) nope[i] = nope[i] * rs * g[p * 16 + i] * scale;
#pragma unroll
    for (int i = 0; i < 4; ++i) { x1[i] = x1[i] * rs * g[128 + a * 32 + f0 + i]; x2[i] = x2[i] * rs * g[128 + a * 32 + 16 + f0 + i]; }
    if (lat) { const int pos = a == 0 ? (t >> 6) : (t & 63);
#pragma unroll
        for (int i = 0; i < 4; ++i) { const f32x2 cs = rope[pos * 16 + f0 + i]; const float y1 = x1[i] * cs.x - x2[i] * cs.y, y2 = x2[i] * cs.x + x1[i] * cs.y; x1[i] = y1; x2[i] = y2; } }
#pragma unroll
    for (int i = 0; i < 4; ++i) { x1[i] *= scale; x2[i] *= scale; }
}
__device__ __forceinline__ void ld16(const bf16_t* p, float (&v)[16]) { const u32x4 a = *(const u32x4*)p, b = *(const u32x4*)(p + 8);
    v[0] = lo16(a.x); v[1] = hi16(a.x); v[2] = lo16(a.y); v[3] = hi16(a.y); v[4] = lo16(a.z); v[5] = hi16(a.z); v[6] = lo16(a.w); v[7] = hi16(a.w);
    v[8] = lo16(b.x); v[9] = hi16(b.x); v[10] = lo16(b.y); v[11] = hi16(b.y); v[12] = lo16(b.z); v[13] = hi16(b.z); v[14] = lo16(b.w); v[15] = hi16(b.w); }
__device__ __forceinline__ void st16(bf16_t* p, const float (&v)[16]) { u32x4 a, b; a.x = pk2(v[0], v[1]); a.y = pk2(v[2], v[3]); a.z = pk2(v[4], v[5]); a.w = pk2(v[6], v[7]);
    b.x = pk2(v[8], v[9]); b.y = pk2(v[10], v[11]); b.z = pk2(v[12], v[13]); b.w = pk2(v[14], v[15]); *(u32x4*)p = a; *(u32x4*)(p + 8) = b; }
__device__ __forceinline__ void ld4(const bf16_t* p, float (&v)[4]) { const u32x2 a = *(const u32x2*)p; v[0] = lo16(a.x); v[1] = hi16(a.x); v[2] = lo16(a.y); v[3] = hi16(a.y); }
__device__ __forceinline__ void st4(bf16_t* p, const float (&v)[4]) { u32x2 a; a.x = pk2(v[0], v[1]); a.y = pk2(v[2], v[3]); *(u32x2*)p = a; }

__device__ __forceinline__ void norm192_rope_r(float (&nope)[16], float (&x1)[4], float (&x2)[4], const float (&gn)[16], const float (&g1)[4], const float (&g2)[4], const f32x2* rope, bool lat, int t, int p, float scale) {
    float ss = 0.f;
#pragma unroll
    for (int i = 0; i < 16; ++i) ss += nope[i] * nope[i];
#pragma unroll
    for (int i = 0; i < 4; ++i) ss += x1[i] * x1[i] + x2[i] * x2[i];
    ss += __shfl_xor(ss, 1); ss += __shfl_xor(ss, 2); ss += __shfl_xor(ss, 4);
    const float rs = rsqrtf(ss * (1.0f / 192.0f) + EPS) * scale;
    const int a = p >> 2, f0 = (p & 3) * 4;
#pragma unroll
    for (int i = 0; i < 16; ++i) nope[i] = nope[i] * rs * gn[i];
#pragma unroll
    for (int i = 0; i < 4; ++i) { x1[i] = x1[i] * rs * g1[i]; x2[i] = x2[i] * rs * g2[i]; }
    if (lat) { const int pos = a == 0 ? (t >> 6) : (t & 63);
#pragma unroll
        for (int i = 0; i < 4; ++i) { const f32x2 cs = rope[pos * 16 + f0 + i]; const float y1 = x1[i] * cs.x - x2[i] * cs.y, y2 = x2[i] * cs.x + x1[i] * cs.y; x1[i] = y1; x2[i] = y2; } }
}
__device__ __forceinline__ int row_seq(int row) { return row < NLAT ? (row >> 11) : 8 + ((row - NLAT) >> 8); }
__device__ __forceinline__ void phase_prep(const Frame& F, int l, bool need_ctx) {
    const int gw = F.bid * 8 + F.wave, NGW = F.G * 8;
    bf16_t* P = F.wsb(WS_P); bf16_t* XBC = F.wsb(WS_XBC); float* DT = F.wsf(WS_DT);
    const f32x2* rope = (const f32x2*)F.wsf(WS_ROPE);
    const int lane = F.lane, h = lane >> 3, p = lane & 7, a = p >> 2, f0 = (p & 3) * 4;
    {
        const float* qg = F.in[I_QG] + l * 192; const float* kvg = F.in[I_KVG] + l * 512; const float* naqg = F.in[I_NAQG] + l * 128; const float* nakg = F.in[I_NAKG] + l * 128;
        float gn[16], g1[4], g2[4], gkv[8], gq[16], gk[16];
#pragma unroll
        for (int i = 0; i < 16; ++i) { gn[i] = qg[p * 16 + i]; gq[i] = naqg[p * 16 + i]; gk[i] = nakg[p * 16 + i]; }
#pragma unroll
        for (int i = 0; i < 4; ++i) { g1[i] = qg[128 + a * 32 + f0 + i]; g2[i] = qg[128 + a * 32 + 16 + f0 + i]; }
#pragma unroll
        for (int i = 0; i < 8; ++i) gkv[i] = kvg[lane * 8 + i];
        const float dtb = lane < 32 ? F.in[I_DTB][l * 32 + lane] : 0.f;
        const int per = (NROW + NGW - 1) / NGW;
#pragma unroll 1
        for (int i = 0; i < per; ++i) {
            const int row = gw * per + i; if (row >= NROW) break;
            const bool lat = row < NLAT, doq = lat || need_ctx; const int t = lat ? (row & 2047) : ((row - NLAT) & 255);
            bf16_t* pr = P + (size_t)row * DINP;
            bf16_t* q = pr + PC_Q + h * 192; bf16_t* c = pr + PC_CKV + lane * 8; bf16_t* xq = pr + PC_NAQ + h * 128 + p * 16; bf16_t* xk = pr + PC_NAK + h * 128 + p * 16;
            float nope[16], x1[4], x2[4], vq[16], vk[16];
            if (doq) { ld16(q + p * 16, nope); ld4(q + 128 + a * 32 + f0, x1); ld4(q + 128 + a * 32 + 16 + f0, x2); ld16(xq, vq); }
            const u32x4 ca = *(const u32x4*)c; ld16(xk, vk);
            const float dtr = lane < 32 ? bf2f(pr[PC_DT + lane]) : 0.f;
            if (doq) {
                norm192_rope_r(nope, x1, x2, gn, g1, g2, rope, lat, t, p, 0.07216878364870322f * LOG2E);
                st16(q + p * 16, nope); st4(q + 128 + a * 32 + f0, x1); st4(q + 128 + a * 32 + 16 + f0, x2);
                float ss = 0.f;
#pragma unroll
                for (int j = 0; j < 16; ++j) ss += vq[j] * vq[j];
                ss += __shfl_xor(ss, 1); ss += __shfl_xor(ss, 2); ss += __shfl_xor(ss, 4);
                const float rs = rsqrtf(ss * (1.0f / 128.0f) + EPS) * (0.08838834764831845f * LOG2E);
#pragma unroll
                for (int j = 0; j < 16; ++j) vq[j] = vq[j] * rs * gq[j];
                st16(xq, vq);
            }
            {
                float v[8] = {lo16(ca.x), hi16(ca.x), lo16(ca.y), hi16(ca.y), lo16(ca.z), hi16(ca.z), lo16(ca.w), hi16(ca.w)}; float ss = 0.f;
#pragma unroll
                for (int j = 0; j < 8; ++j) ss += v[j] * v[j];
                const float rs = rsqrtf(wave_sum(ss) * (1.0f / 512.0f) + EPS);
#pragma unroll
                for (int j = 0; j < 8; ++j) v[j] = v[j] * rs * gkv[j];
                u32x4 o; o.x = pk2(v[0], v[1]); o.y = pk2(v[2], v[3]); o.z = pk2(v[4], v[5]); o.w = pk2(v[6], v[7]); *(u32x4*)c = o;
            }
            {
                float ss = 0.f;
#pragma unroll
                for (int j = 0; j < 16; ++j) ss += vk[j] * vk[j];
                ss += __shfl_xor(ss, 1); ss += __shfl_xor(ss, 2); ss += __shfl_xor(ss, 4);
                const float rs = rsqrtf(ss * (1.0f / 128.0f) + EPS);
#pragma unroll
                for (int j = 0; j < 16; ++j) vk[j] = vk[j] * rs * gk[j];
                st16(xk, vk);
            }
            if (lane < 32) { const float x = dtr + dtb; const float e = fast_exp2(x * LOG2E);
                DT[(size_t)row * 32 + lane] = x > 20.f ? x : (e < 1e-3f ? e * (1.0f - 0.5f * e) : __builtin_amdgcn_logf(1.0f + e) * 0.6931471805599453f); }
        }
    }
    {
        const float* cw = F.in[I_CONVW] + (size_t)l * 5 * 2048; const float* cbias = F.in[I_CONVB] + l * 2048;
#pragma unroll 1
        for (int it = gw; it < 1024 * 4; it += NGW) {
            int tl = lane; asm volatile("" : "+v"(tl));
            const int chunk = it >> 2, r0 = chunk * 18, ch0 = (it & 3) * 512 + tl * 8;
            float w[5][8], bs[8];
#pragma unroll
            for (int k = 0; k < 5; ++k) { const f32x4 w0 = *(const f32x4*)(cw + k * 2048 + ch0), w1 = *(const f32x4*)(cw + k * 2048 + ch0 + 4);
#pragma unroll
                for (int e = 0; e < 4; ++e) { w[k][e] = w0[e]; w[k][4 + e] = w1[e]; } }
            { const f32x4 b0 = *(const f32x4*)(cbias + ch0), b1 = *(const f32x4*)(cbias + ch0 + 4);
#pragma unroll
              for (int e = 0; e < 4; ++e) { bs[e] = b0[e]; bs[4 + e] = b1[e]; } }
            u32x4 raw[22];
#pragma unroll
            for (int i = 0; i < 22; ++i) { int rr = r0 - 2 + i; rr = rr < 0 ? 0 : (rr >= NROW ? NROW - 1 : rr); raw[i] = *(const u32x4*)(P + (size_t)rr * DINP + PC_XBC + ch0); }
            const bool uni = (r0 >= 2) && (r0 + 19 < NROW) && (row_seq(r0 - 2) == row_seq(r0 + 19));
#pragma unroll
            for (int j = 0; j < 18; ++j) {
                float o[8];
#pragma unroll
                for (int e = 0; e < 8; ++e) o[e] = bs[e];
                const int sj = row_seq(r0 + j);
#pragma unroll
                for (int k = 0; k < 5; ++k) {
                    const int src = r0 + j + k - 2;
                    const float m = uni ? 1.0f : ((src >= 0 && src < NROW && row_seq(src < 0 ? 0 : (src >= NROW ? NROW - 1 : src)) == sj) ? 1.0f : 0.0f);
                    const u32x4 a4 = raw[j + k];
                    const float x[8] = {lo16(a4.x), hi16(a4.x), lo16(a4.y), hi16(a4.y), lo16(a4.z), hi16(a4.z), lo16(a4.w), hi16(a4.w)};
#pragma unroll
                    for (int e = 0; e < 8; ++e) o[e] += (w[k][e] * m) * x[e];
                }
#pragma unroll
                for (int e = 0; e < 8; ++e) o[e] = siluf_(o[e]);
                u32x4 wv; wv.x = pk2(o[0], o[1]); wv.y = pk2(o[2], o[3]); wv.z = pk2(o[4], o[5]); wv.w = pk2(o[6], o[7]);
                *(u32x4*)(XBC + (size_t)(r0 + j) * 2048 + ch0) = wv;
            }
        }
    }
}

__device__ __forceinline__ void phase_knorm(const Frame& F, int l) {
    const int gw = F.bid * 8 + F.wave, NGW = F.G * 8, per = (NROW + NGW - 1) / NGW;
    const bf16_t* P = F.wsb(WS_P); bf16_t* Kb = F.wsb(WS_K); const f32x2* rope = (const f32x2*)F.wsf(WS_ROPE); const float* kg = F.in[I_KG] + l * 192;
    const int lane = F.lane, h = lane >> 3, p = lane & 7, a = p >> 2, f0 = (p & 3) * 4;
    static_assert(NROW == 9 * GRID * 8, "phase_knorm: 9 rows per wave, loaded 3 at a time");
#pragma unroll 1
    for (int i0 = 0; i0 < 9; i0 += 3) {
        u32x4 ra[3], rb[3]; u32x2 r1[3], r2[3];
#pragma unroll
        for (int j = 0; j < 3; ++j) { const int row = gw * per + i0 + j;
            const GAS bf16_t* k = (const GAS bf16_t*)Kb + (size_t)row_kv(row) * 1536 + h * 192 + p * 16; const GAS bf16_t* kr = (const GAS bf16_t*)P + (size_t)row * DINP + PC_KR + a * 32 + f0;
            ra[j] = *(const GAS u32x4*)k; rb[j] = *(const GAS u32x4*)(k + 8); r1[j] = *(const GAS u32x2*)kr; r2[j] = *(const GAS u32x2*)(kr + 16); }
#pragma unroll
        for (int j = 0; j < 3; ++j) { const int row = gw * per + i0 + j;
            const bool lat = row < NLAT; const int t = lat ? (row & 2047) : 0;
            bf16_t* k = Kb + (size_t)row_kv(row) * 1536 + h * 192;
            float nope[16], x1[4], x2[4];
            nope[0] = lo16(ra[j].x); nope[1] = hi16(ra[j].x); nope[2] = lo16(ra[j].y); nope[3] = hi16(ra[j].y); nope[4] = lo16(ra[j].z); nope[5] = hi16(ra[j].z); nope[6] = lo16(ra[j].w); nope[7] = hi16(ra[j].w);
            nope[8] = lo16(rb[j].x); nope[9] = hi16(rb[j].x); nope[10] = lo16(rb[j].y); nope[11] = hi16(rb[j].y); nope[12] = lo16(rb[j].z); nope[13] = hi16(rb[j].z); nope[14] = lo16(rb[j].w); nope[15] = hi16(rb[j].w);
            x1[0] = lo16(r1[j].x); x1[1] = hi16(r1[j].x); x1[2] = lo16(r1[j].y); x1[3] = hi16(r1[j].y); x2[0] = lo16(r2[j].x); x2[1] = hi16(r2[j].x); x2[2] = lo16(r2[j].y); x2[3] = hi16(r2[j].y);
            norm192_rope(nope, x1, x2, kg, rope, lat, t, p, 1.0f);
            st16(k + p * 16, nope); st4(k + 128 + a * 32 + f0, x1); st4(k + 128 + a * 32 + 16 + f0, x2); }
    }
}

namespace att {
#define SBAR() __builtin_amdgcn_sched_barrier(0)
constexpr int NW = 8, QBLK = 32, KVBLK = 64, DV = 128;
constexpr float THR2 = 11.5f;
__device__ __forceinline__ int crow(int r, int hi) { return (r & 3) + 8 * (r >> 2) + 4 * hi; }
__device__ __forceinline__ int v_st(int k, int c) { const int kk = (k & ~0xC) | ((k & 4) << 1) | ((k & 8) >> 1); return ((kk >> 3) * 4 + (c >> 5)) * 512 + ((kk & 7) * 32 + (c & 31)) * 2; }
__device__ __forceinline__ int v_rd_base(int lane) { return ((lane & 3) << 3) | (((lane >> 2) & 3) << 6) | (((lane >> 4) & 1) << 5) | (((lane >> 5) & 1) << 8); }
constexpr int v_rd_off(int d0, int ks, int half) { return d0 * 512 + ks * 4096 + half * 2048; }
template <int OFF> __device__ __forceinline__ s16x4 tr_read(int vb) { s16x4 r; asm volatile("ds_read_b64_tr_b16 %0, %1 offset:%2" : "=&v"(r) : "v"(vb), "i"(OFF) : "memory"); return r; }
template <int D0> __device__ __forceinline__ void pv_one(f32x16& od, int vb, bf16x8 pa0, bf16x8 pa1, bf16x8 pa2, bf16x8 pa3) {
    const s16x4 l0 = tr_read<v_rd_off(D0, 0, 0)>(vb), h0 = tr_read<v_rd_off(D0, 0, 1)>(vb), l1 = tr_read<v_rd_off(D0, 1, 0)>(vb), h1 = tr_read<v_rd_off(D0, 1, 1)>(vb);
    const s16x4 l2 = tr_read<v_rd_off(D0, 2, 0)>(vb), h2 = tr_read<v_rd_off(D0, 2, 1)>(vb), l3 = tr_read<v_rd_off(D0, 3, 0)>(vb), h3 = tr_read<v_rd_off(D0, 3, 1)>(vb);
    asm volatile("s_waitcnt lgkmcnt(0)" ::: "memory"); SBAR();
#define PKV(L, H) (bf16x8){L[0], L[1], L[2], L[3], H[0], H[1], H[2], H[3]}
    od = __builtin_amdgcn_mfma_f32_32x32x16_bf16(pa0, PKV(l0, h0), od, 0, 0, 0);
    od = __builtin_amdgcn_mfma_f32_32x32x16_bf16(pa1, PKV(l1, h1), od, 0, 0, 0);
    od = __builtin_amdgcn_mfma_f32_32x32x16_bf16(pa2, PKV(l2, h2), od, 0, 0, 0);
    od = __builtin_amdgcn_mfma_f32_32x32x16_bf16(pa3, PKV(l3, h3), od, 0, 0, 0);
#undef PKV
}
__device__ __forceinline__ void pv_d0(f32x16* o, int vb, bf16x8 pa0, bf16x8 pa1, bf16x8 pa2, bf16x8 pa3) {
    pv_one<0>(o[0], vb, pa0, pa1, pa2, pa3); pv_one<1>(o[1], vb, pa0, pa1, pa2, pa3); pv_one<2>(o[2], vb, pa0, pa1, pa2, pa3); pv_one<3>(o[3], vb, pa0, pa1, pa2, pa3);
}
struct NaMask { int bidx, wcol, rs, r, klo; const LAS float* tab; };
__device__ __forceinline__ void na_apply(f32x16& p0, f32x16& p1, const NaMask& M, int kr) {
    const bool rowok = (kr >= M.rs) && (kr < M.rs + 8);
    int dr = kr - M.r + 7; dr = dr < 0 ? 0 : (dr > 14 ? 14 : dr);
    const LAS float* tb = M.tab + dr * 32 + M.bidx;
#pragma unroll
    for (int r = 0; r < 16; ++r) { const int kc = (r & 3) + 8 * (r >> 2);
        const bool ok0 = rowok && ((unsigned)(kc + M.wcol) < 16u), ok1 = rowok && ((unsigned)(kc + 32 + M.wcol) < 16u);
        p0[r] = ok0 ? p0[r] + tb[kc] : -1e30f; p1[r] = ok1 ? p1[r] + tb[kc + 32] : -1e30f; }
}
__device__ __forceinline__ void partialSM(f32x16& p0, f32x16& p1, float& m_reg, float& mn, float& alpha) {
    float pmax = p0[0];
#pragma unroll
    for (int r = 1; r < 16; ++r) pmax = fmaxf(pmax, p0[r]);
#pragma unroll
    for (int r = 0; r < 16; ++r) pmax = fmaxf(pmax, p1[r]);
    { auto rr = __builtin_amdgcn_permlane32_swap(__float_as_uint(pmax), __float_as_uint(pmax), false, false);
      pmax = fmaxf(__uint_as_float(rr[0]), __uint_as_float(rr[1])); }
    if (__builtin_expect(__all(pmax - m_reg <= THR2), 1)) { mn = m_reg; alpha = 1.f; }
    else { mn = fmaxf(m_reg, pmax); alpha = fast_exp2(m_reg - mn); m_reg = mn; }
#pragma unroll
    for (int r = 0; r < 16; ++r) p0[r] = p0[r] - mn;
#pragma unroll
    for (int r = 0; r < 16; ++r) p1[r] = p1[r] - mn;
#pragma unroll
    for (int r = 0; r < 16; ++r) p0[r] = fast_exp2(p0[r]);
}
__device__ __forceinline__ void finishSM(f32x16& p0, f32x16& p1, float alpha, float& l_reg, bf16x8& pa0, bf16x8& pa1, bf16x8& pa2, bf16x8& pa3) {
#pragma unroll
    for (int r = 0; r < 16; ++r) p1[r] = fast_exp2(p1[r]);
    float ps = 0;
#pragma unroll
    for (int r = 0; r < 16; ++r) ps += p0[r];
#pragma unroll
    for (int r = 0; r < 16; ++r) ps += p1[r];
    { auto rr = __builtin_amdgcn_permlane32_swap(__float_as_uint(ps), __float_as_uint(ps), false, false);
      ps = __uint_as_float(rr[0]) + __uint_as_float(rr[1]); }
    l_reg = l_reg * alpha + ps;
#define PK4(P, BASE, OUT) do { unsigned a0 = pg8::cvt_pk_bf16(P[BASE + 0], P[BASE + 1]), a1 = pg8::cvt_pk_bf16(P[BASE + 2], P[BASE + 3]);   \
    unsigned b0 = pg8::cvt_pk_bf16(P[BASE + 4], P[BASE + 5]), b1 = pg8::cvt_pk_bf16(P[BASE + 6], P[BASE + 7]);                              \
    auto r0 = __builtin_amdgcn_permlane32_swap(a0, b0, false, false); auto r1 = __builtin_amdgcn_permlane32_swap(a1, b1, false, false); \
    u32x4 w = {r0[0], r1[0], r0[1], r1[1]}; OUT = *reinterpret_cast<bf16x8*>(&w); } while (0)
    PK4(p0, 0, pa0); PK4(p0, 8, pa1); PK4(p1, 0, pa2); PK4(p1, 8, pa3);
#undef PK4
}
struct Unit {
    const bf16_t* Q; long ldq;
    const bf16_t* K; const bf16_t* V; long ldk, ldv;
    bf16_t* O; long ldo;
    int NT, nct, rowC, rowL;
    __device__ __forceinline__ long trow(int j) const { return j < nct ? (long)rowC + 64 * j : (long)rowL + 64 * (j - nct); }
};
template <int DQK, bool NA>
__device__ __forceinline__ void attn_unit(const Unit& U, char* lds, const NaMask& M, const int tid) {
    constexpr int NQ = DQK / 16, KP = DQK * 2 + 16, SHM_K = KVBLK * KP, SHM_V = KVBLK * DV * 2;
    const int wid = tid >> 6, lane = tid & 63, r32 = lane & 31, hi = lane >> 5;
    char* V_lds = lds; char* K_lds = lds + 2 * SHM_V;
    constexpr int WSM_OFF = (2 * SHM_V + 2 * SHM_K) > 8 * 8704 ? (2 * SHM_V + 2 * SHM_K) : 8 * 8704;
    float* wsm = (float*)(lds + WSM_OFF) + wid * 64; float* li_l = wsm; float* al_l = wsm + 32;
    constexpr int NQR = (DQK == 192) ? 4 : 8, QLP = (NQ - NQR) * 32 + 16;
    float m_reg = -1e30f, l_reg = 0; f32x16 o[4] = {}; bf16x8 qr[NQR];
    const bf16_t* Qw = U.Q + (long)(wid * QBLK + r32) * U.ldq + hi * 8;
#pragma unroll
    for (int d0 = 0; d0 < NQR; ++d0) qr[d0] = *(const bf16x8*)(Qw + d0 * 16);
    char* Qrl = lds + WSM_OFF + 2048 + wid * (32 * QLP) + r32 * QLP + hi * 16;
    if (NQ > NQR) {
#pragma unroll
        for (int d0 = NQR; d0 < NQ; ++d0) *(bf16x8*)(Qrl + (d0 - NQR) * 32) = *(const bf16x8*)(Qw + d0 * 16);
    }
    const int sr = tid >> 4, sc = (tid & 15) * 8, vst0 = v_st(sr, sc), vst1 = v_st(32 + sr, sc);
    const int sr3 = tid >> 3, sc3 = 128 + (tid & 7) * 8;
    const int vb0 = (int)(uintptr_t)V_lds + v_rd_base(lane);
    bf16x8 vs0, vs1, ks0, ks1, ks2;
    const unsigned vo0 = (unsigned)(sr * U.ldv + sc) * 2u, vo1 = (unsigned)((32 + sr) * U.ldv + sc) * 2u, ko0 = (unsigned)(sr * U.ldk + sc) * 2u, ko1 = (unsigned)((32 + sr) * U.ldk + sc) * 2u, ko2 = (unsigned)(sr3 * U.ldk + sc3) * 2u;
#define KSWZ(row, colB) ((row) * KP + (colB))
#define SLOAD(j) do { const long _r = U.trow(j); const char* _vb = (const char*)(U.V + _r * U.ldv); const char* _kb = (const char*)(U.K + _r * U.ldk); \
    vs0 = *(const bf16x8*)(_vb + vo0); vs1 = *(const bf16x8*)(_vb + vo1); ks0 = *(const bf16x8*)(_kb + ko0); ks1 = *(const bf16x8*)(_kb + ko1); \
    if (DQK == 192) ks2 = *(const bf16x8*)(_kb + ko2); } while (0)
#define SWRITE(b) do { *(bf16x8*)(V_lds + (b) * SHM_V + vst0) = vs0; *(bf16x8*)(V_lds + (b) * SHM_V + vst1) = vs1; \
    *(bf16x8*)(K_lds + (b) * SHM_K + KSWZ(sr, sc * 2)) = ks0; *(bf16x8*)(K_lds + (b) * SHM_K + KSWZ(32 + sr, sc * 2)) = ks1; \
    if (DQK == 192) *(bf16x8*)(K_lds + (b) * SHM_K + KSWZ(sr3, sc3 * 2)) = ks2; } while (0)
#define QKT(P0, P1, b) do { P0 = f32x16{}; P1 = f32x16{}; const char* _Ks = K_lds + (b) * SHM_K; \
    _Pragma("unroll") for (int d0 = 0; d0 < NQ; ++d0) { const int cb = (d0 * 16 + hi * 8) * 2; \
      const bf16x8 b0 = *(const bf16x8*)(_Ks + KSWZ(r32, cb)); const bf16x8 b1 = *(const bf16x8*)(_Ks + KSWZ(32 + r32, cb)); \
      const bf16x8 qf = d0 < NQR ? qr[d0 < NQR ? d0 : 0] : *(const bf16x8*)(Qrl + (d0 - NQR) * 32); \
      P0 = __builtin_amdgcn_mfma_f32_32x32x16_bf16(b0, qf, P0, 0, 0, 0); P1 = __builtin_amdgcn_mfma_f32_32x32x16_bf16(b1, qf, P1, 0, 0, 0); } } while (0)
#define MASK(P0, P1, j) do { if (NA) { if ((j) >= U.nct) na_apply(P0, P1, M, M.klo + (j) - U.nct); } } while (0)
#define RESC(a) do { if (__any((a) < 1.f)) { if (hi == 0) al_l[r32] = (a); asm volatile("s_waitcnt lgkmcnt(0)" ::: "memory"); \
    _Pragma("unroll") for (int d = 0; d < 4; ++d) _Pragma("unroll") for (int r = 0; r < 16; ++r) o[d][r] *= al_l[crow(r, hi)]; } } while (0)
    f32x16 p0, p1; float mn, al; bf16x8 pa0, pa1, pa2, pa3; const int NT = U.NT;
    __syncthreads();
    SLOAD(0); asm volatile("s_waitcnt vmcnt(0)" ::: "memory"); SWRITE(0); __syncthreads();
#pragma unroll 1
    for (int j = 0; j < NT; ++j) {
        const int buf = j & 1;
        if (j + 1 < NT) SLOAD(j + 1);
        bool active = true;
        if (NA) { const int kr = M.klo + j - U.nct; active = (j < U.nct) || (kr >= M.rs && kr < M.rs + 8); }
        if (active) {
        SBAR(); QKT(p0, p1, buf); MASK(p0, p1, j);
        partialSM(p0, p1, m_reg, mn, al); RESC(al);
        finishSM(p0, p1, al, l_reg, pa0, pa1, pa2, pa3); SBAR();
        pv_d0(o, vb0 + buf * SHM_V, pa0, pa1, pa2, pa3);
        }
        if (j + 1 < NT) { asm volatile("s_waitcnt vmcnt(0)" ::: "memory"); SWRITE(buf ^ 1); }
        __syncthreads();
    }
    if (hi == 0) li_l[r32] = l_reg; asm volatile("s_waitcnt lgkmcnt(0)" ::: "memory");
    float rli[16];
#pragma unroll
    for (int r = 0; r < 16; ++r) rli[r] = fast_rcp(li_l[crow(r, hi)]);
    char* Ot = lds + wid * 8704;
#pragma unroll
    for (int r = 0; r < 16; ++r) { const int orow = crow(r, hi);
#pragma unroll
        for (int d0 = 0; d0 < 4; ++d0) { const float v = o[d0][r] * rli[r]; *(bf16_t*)(Ot + orow * 272 + (d0 * 32 + r32) * 2) = (bf16_t)(pk2(v, v) & 0xffffu); } }
    asm volatile("s_waitcnt lgkmcnt(0)" ::: "memory");
    char* Og = (char*)(U.O + (long)(wid * QBLK) * U.ldo);
#pragma unroll
    for (int k = 0; k < 8; ++k) { const int id = lane + 64 * k, row = id >> 4, ch = id & 15;
        *(u32x4*)(Og + (unsigned)(row * (int)U.ldo + ch * 8) * 2u) = *(const u32x4*)(Ot + row * 272 + ch * 16); }
#undef KSWZ
#undef SLOAD
#undef SWRITE
#undef QKT
#undef MASK
#undef RESC
}
}

__device__ __forceinline__ void phase_mla(const Frame& F, bool need_ctx) {
    const bf16_t* P = F.wsb(WS_P); const bf16_t* Kb = F.wsb(WS_K); const bf16_t* Vb = F.wsb(WS_V); bf16_t* BR = F.wsb(WS_BR);
    const int nunits = 512 + (need_ctx ? 64 : 0);
    att::NaMask M{};
    for (int u = F.bid; u < nunits; u += F.G) {
        att::Unit U; int b, h, qrow;
        if (u < 512) { b = u >> 6; h = (u >> 3) & 7; qrow = b * SEQ + (u & 7) * 256; U.NT = KVROWS / 64; }
        else { const int v = u - 512; b = v >> 3; h = v & 7; qrow = NLAT + b * CTX; U.NT = CTX / 64; }
        U.Q = P + (size_t)qrow * DINP + PC_Q + h * 192; U.ldq = DINP;
        U.K = Kb + (size_t)b * KVROWS * 1536 + h * 192; U.ldk = 1536; U.V = Vb + (size_t)b * KVROWS * 1024 + h * 128; U.ldv = 1024;
        U.O = BR + (size_t)qrow * 3072 + h * 128; U.ldo = 3072; U.nct = 0; U.rowC = 0; U.rowL = 0;
        att::attn_unit<192, false>(U, (char*)F.lds, M, F.tid);
    }
}
__device__ __forceinline__ void phase_na(const Frame& F, int l, bool need_ctx) {
    const bf16_t* P = F.wsb(WS_P); bf16_t* BR = F.wsb(WS_BR);
    LAS float* tab = (LAS float*)(F.lds + 131072);
    const int nunits = 512 + (need_ctx ? 64 : 0);
    for (int u = F.bid; u < nunits; u += F.G) {
        att::Unit U; att::NaMask M{}; int b, h, qrow;
        if (u < 512) { b = u >> 6; h = (u >> 3) & 7; const int rg = u & 7; qrow = b * SEQ + rg * 256;
            const int klo = rg == 0 ? 0 : (rg * 4 - 4 > 24 ? 24 : rg * 4 - 4), nr = (rg == 0 || rg == 7) ? 8 : 11;
            U.NT = 4 + nr + (nr & 1); U.nct = 4; U.rowC = NLAT + b * CTX; U.rowL = b * SEQ + klo * 64;
            const int r = rg * 4 + (F.wave >> 1), c = (F.wave & 1) * 32 + (F.lane & 31), hi = F.lane >> 5;
            const int rs = r - 4 < 0 ? 0 : (r - 4 > 24 ? 24 : r - 4), wsc = c - 8 < 0 ? 0 : (c - 8 > 48 ? 48 : c - 8);
            M.bidx = 4 * hi - c + 15; M.wcol = 4 * hi - wsc; M.rs = rs; M.r = r; M.klo = klo; M.tab = tab + 64;
        } else { const int v = u - 512; b = v >> 3; h = v & 7; qrow = NLAT + b * CTX; U.NT = 4; U.nct = 4; U.rowC = NLAT + b * CTX; U.rowL = 0; M.tab = tab + 64; }
        __syncthreads();
        for (int i = F.tid; i < 15 * 32; i += 512) { const int dr = i >> 5, dc = i & 31; tab[64 + i] = dc < 31 ? F.in[I_RPB][((size_t)(l * 8 + h) * 15 + dr) * 31 + dc] * LOG2E : 0.f; }
        U.Q = P + (size_t)qrow * DINP + PC_NAQ + h * 128; U.ldq = DINP;
        U.K = P + PC_NAK + h * 128; U.ldk = DINP; U.V = P + PC_NAV + h * 128; U.ldv = DINP;
        U.O = BR + (size_t)qrow * 3072 + 2048 + h * 128; U.ldo = 3072;
        att::attn_unit<128, true>(U, (char*)F.lds, M, F.tid);
    }
}

__device__ __forceinline__ bf16x8 frag_row(const LAS unsigned char* t, int pitch, int row0, int k0, int lane) {
    return *(const LAS bf16x8*)(t + (row0 + (lane & 31)) * pitch + (k0 + 8 * (lane >> 5)) * 2);
}
__device__ __forceinline__ s16x4 tr16(const LAS unsigned char* p) {
    typedef short v4i16 __attribute__((ext_vector_type(4)));
    return __builtin_bit_cast(s16x4, __builtin_amdgcn_ds_read_tr16_b64_v4i16((LAS v4i16*)p));
}
__device__ __forceinline__ bf16x8 frag_tr(const LAS unsigned char* t, int pitch, int k0, int col0, int lane) {
    const int h = lane >> 5, blk = (lane >> 4) & 1, q = (lane & 15) >> 2, p = lane & 3;
    const LAS unsigned char* a = t + (k0 + 8 * h + q) * pitch + (col0 + 16 * blk + 4 * p) * 2;
    const s16x4 lo = tr16(a), hi = tr16(a + 4 * pitch);
    return (bf16x8){lo[0], lo[1], lo[2], lo[3], hi[0], hi[1], hi[2], hi[3]};
}
__device__ __forceinline__ int chunk_row0(int b, int c) { return c < 2 ? NLAT + b * CTX + c * 128 : b * SEQ + (c - 2) * 128; }
__device__ __forceinline__ float chunk_cumsum(float d0, float d1, int lane, float& c0, float& c1) {
    float s = d0 + d1;
#pragma unroll
    for (int o = 1; o < 64; o <<= 1) { const float t = __shfl_up(s, o); if (lane >= o) s += t; }
    c1 = s; c0 = s - d1; return __shfl(s, 63);
}

__device__ __forceinline__ void phase_ssd_states(const Frame& F, int l) {
    constexpr int XP = 592, BP = 336;
    LAS unsigned char* Xs = F.lds; LAS unsigned char* Bm = F.lds + 128 * XP; LAS float* wts = (LAS float*)(F.lds + 128 * XP + 128 * BP);
    const bf16_t* XBC = F.wsb(WS_XBC); const float* DT = F.wsf(WS_DT); float* SST = F.wsf(WS_SST); float* CDEC = F.wsf(WS_CDEC);
    const int lane = F.lane, w = F.wave, d = w >> 2, hh = w & 3;
    for (int it = F.bid; it < NB * NCHUNK * 4; it += F.G) {
        const int b = it / (NCHUNK * 4), c = (it / 4) % NCHUNK, g = it & 3, row0 = chunk_row0(b, c), h = g * 4 + hh;
        __syncthreads();
        for (int i = F.tid; i < 128 * 32; i += 512) { const int r = i >> 5, ch = i & 31; *(LAS u32x4*)(Xs + r * XP + ch * 16) = *(const u32x4*)(XBC + (size_t)(row0 + r) * 2048 + g * 256 + ch * 8); }
        for (int i = F.tid; i < 128 * 16; i += 512) { const int r = i >> 4, ch = i & 15; *(LAS u32x4*)(Bm + r * BP + ch * 16) = *(const u32x4*)(XBC + (size_t)(row0 + r) * 2048 + 1024 + g * 128 + ch * 8); }
        {   const float a = -expf(F.in[I_ALOG][(l * 2 + d) * 16 + h]);
            const float dt0 = DT[(size_t)(row0 + 2 * lane) * 32 + d * 16 + h], dt1 = DT[(size_t)(row0 + 2 * lane + 1) * 32 + d * 16 + h];
            float c0, c1; const float tot = chunk_cumsum(dt0 * a, dt1 * a, lane, c0, c1);
            const float e0 = d == 0 ? tot - c0 : c0 - dt0 * a, e1 = d == 0 ? tot - c1 : c1 - dt1 * a;
            wts[w * 128 + 2 * lane] = dt0 * expf(e0); wts[w * 128 + 2 * lane + 1] = dt1 * expf(e1);
            if (lane == 0) CDEC[((b * 2 + d) * 16 + h) * NCHUNK + c] = expf(tot);
        }
        __syncthreads();
        bf16_t* dst = (bf16_t*)SST + ((size_t)((b * 2 + d) * 16 + h) * NCHUNK + c) * 8192;
        LAS unsigned char* wsc = F.lds + 122880 + w * 4096;
#pragma unroll 1
        for (int pt = 0; pt < 2; ++pt) {
            f32x16 acc[4] = {};
#pragma unroll 1
            for (int ks = 0; ks < 8; ++ks) {
                const f32x4 w0 = *(const LAS f32x4*)(wts + w * 128 + 16 * ks + 8 * (lane >> 5)), w1 = *(const LAS f32x4*)(wts + w * 128 + 16 * ks + 8 * (lane >> 5) + 4);
                const bf16x8 x = frag_tr(Xs, XP, 16 * ks, hh * 64 + 32 * pt, lane);
                u32x4 o; o.x = pk2(bf2f((unsigned short)x[0]) * w0[0], bf2f((unsigned short)x[1]) * w0[1]); o.y = pk2(bf2f((unsigned short)x[2]) * w0[2], bf2f((unsigned short)x[3]) * w0[3]);
                o.z = pk2(bf2f((unsigned short)x[4]) * w1[0], bf2f((unsigned short)x[5]) * w1[1]); o.w = pk2(bf2f((unsigned short)x[6]) * w1[2], bf2f((unsigned short)x[7]) * w1[3]);
                const bf16x8 a = __builtin_bit_cast(bf16x8, o);
#pragma unroll
                for (int nt = 0; nt < 4; ++nt) { const bf16x8 bb = frag_tr(Bm, BP, 16 * ks, 32 * nt, lane); acc[nt] = __builtin_amdgcn_mfma_f32_32x32x16_bf16(a, bb, acc[nt], 0, 0, 0); }
            }
            int le = lane; asm volatile("" : "+v"(le));
#pragma unroll
            for (int nh = 0; nh < 2; ++nh) {
#pragma unroll
                for (int q = 0; q < 2; ++q)
#pragma unroll
                    for (int r = 0; r < 16; ++r) { const float v = acc[2 * nh + q][r]; *(LAS bf16_t*)(wsc + att::crow(r, le >> 5) * 128 + (32 * q + (le & 31)) * 2) = (bf16_t)(pk2(v, v) & 0xffffu); }
                asm volatile("s_waitcnt lgkmcnt(0)" ::: "memory");
#pragma unroll
                for (int k = 0; k < 4; ++k) { const int id = le + 64 * k, row = id >> 3, ch = id & 7;
                    *(u32x4*)(dst + (size_t)(32 * pt + row) * 128 + 64 * nh + ch * 8) = *(const LAS u32x4*)(wsc + row * 128 + ch * 16); }
                asm volatile("s_waitcnt lgkmcnt(0)" ::: "memory");
            }
        }
    }
}
__device__ __forceinline__ void phase_ssd_scan(const Frame& F) {
    const u32x2* SST = (const u32x2*)F.wsf(WS_SST); const float* CDEC = F.wsf(WS_CDEC); u32x2* SENT = (u32x2*)F.wsb(WS_SENT);
    const int gt = F.bid * 512 + F.tid, NT = F.G * 512;
    for (int idx = gt; idx < 256 * 2048; idx += NT) {
        const int combo = idx >> 11, e4 = idx & 2047, d = (combo >> 4) & 1;
        const u32x2* base = SST + (size_t)combo * NCHUNK * 2048 + e4; u32x2* ob = SENT + (size_t)combo * NCHUNK * 2048 + e4; const float* cd = CDEC + combo * NCHUNK;
        u32x2 v[NCHUNK];
#pragma unroll
        for (int c = 0; c < NCHUNK; ++c) v[c] = base[(size_t)c * 2048];
        float z0; asm volatile("v_mov_b32 %0, 0" : "=v"(z0));
        f32x4 st = {z0, z0, z0, z0};
#pragma unroll
        for (int i = 0; i < NCHUNK; ++i) { const int cf = i, cb = i == 0 ? 1 : (i == 1 ? 0 : NCHUNK + 1 - i); const int cc = d == 0 ? cf : cb;
            u32x2 o; o.x = pk2(st.x, st.y); o.y = pk2(st.z, st.w); ob[(size_t)cc * 2048] = o;
            const f32x4 cs = {lo16(v[cc].x), hi16(v[cc].x), lo16(v[cc].y), hi16(v[cc].y)}; st = st * cd[cc] + cs; }
    }
}
__device__ __forceinline__ void phase_ssd_out(const Frame& F, int l, bool need_ctx) {
    constexpr int CP = 272, XHP = 144;
    LAS unsigned char* Cm = F.lds; LAS unsigned char* Bm = F.lds + 34816; LAS unsigned char* Mc = Bm; LAS unsigned char* Xh = F.lds + 69632;
    LAS unsigned char* Zh = F.lds + 88064; LAS unsigned char* Sf = F.lds + 106496; LAS unsigned char* Sb = F.lds + 123904;
    LAS float* arr = (LAS float*)(F.lds + 141312);
    const bf16_t* XBC = F.wsb(WS_XBC); const bf16_t* P = F.wsb(WS_P); const float* DT = F.wsf(WS_DT); const bf16_t* SENT = F.wsb(WS_SENT); bf16_t* BR = F.wsb(WS_BR);
    float* GSS = F.wsf(WS_GSS) + (size_t)l * NROW * 4;
    const int lane = F.lane, w = F.wave, hi = lane >> 5, c_lo = need_ctx ? 0 : 2, nch = NCHUNK - c_lo;
    const int lt = w >> 1, pt = w & 1;
#pragma unroll 1
    for (int it = F.bid; it < NB * nch * 16; it += F.G) {
        const int b = it / (nch * 16), c = c_lo + (it >> 4) % nch, h = it & 15, g = h >> 2, row0 = chunk_row0(b, c);
        int tq = F.tid; asm volatile("" : "+v"(tq));
        __syncthreads();
        {
            u32x4 vb[4], vc[4], vx[2], vz[2], vf[2], vs[2];
            const bf16_t* sf = SENT + ((size_t)((b * 2 + 0) * 16 + h) * NCHUNK + c) * 8192; const bf16_t* sb = SENT + ((size_t)((b * 2 + 1) * 16 + h) * NCHUNK + c) * 8192;
#pragma unroll
            for (int k = 0; k < 4; ++k) { const int i = tq + 512 * k, r = i >> 4, ch = i & 15; const bf16_t* src = XBC + (size_t)(row0 + r) * 2048 + 1024 + g * 128 + ch * 8; vb[k] = *(const u32x4*)src; vc[k] = *(const u32x4*)(src + 512); }
#pragma unroll
            for (int k = 0; k < 2; ++k) { const int i = tq + 512 * k, r = i >> 3, ch = i & 7; vx[k] = *(const u32x4*)(XBC + (size_t)(row0 + r) * 2048 + h * 64 + ch * 8); vz[k] = *(const u32x4*)(P + (size_t)(row0 + r) * DINP + PC_Z + h * 64 + ch * 8);
                vf[k] = *(const u32x4*)(sf + (size_t)i * 8); vs[k] = *(const u32x4*)(sb + (size_t)i * 8); }
#pragma unroll
            for (int k = 0; k < 4; ++k) { const int i = tq + 512 * k, r = i >> 4, ch = i & 15; *(LAS u32x4*)(Bm + r * CP + ch * 16) = vb[k]; *(LAS u32x4*)(Cm + r * CP + ch * 16) = vc[k]; }
#pragma unroll
            for (int k = 0; k < 2; ++k) { const int i = tq + 512 * k, r = i >> 3, ch = i & 7; *(LAS u32x4*)(Xh + r * XHP + ch * 16) = vx[k]; *(LAS u32x4*)(Zh + r * XHP + ch * 16) = vz[k];
                const int rs_ = i >> 4, cs_ = i & 15; *(LAS u32x4*)(Sf + rs_ * CP + cs_ * 16) = vf[k]; *(LAS u32x4*)(Sb + rs_ * CP + cs_ * 16) = vs[k]; }
        }
        if (w < 2) {
            const int d = w; const float a = -expf(F.in[I_ALOG][(l * 2 + d) * 16 + h]);
            const float dt0 = DT[(size_t)(row0 + 2 * lane) * 32 + d * 16 + h], dt1 = DT[(size_t)(row0 + 2 * lane + 1) * 32 + d * 16 + h];
            float c0, c1; const float tot = chunk_cumsum(dt0 * a, dt1 * a, lane, c0, c1);
            if (d == 1) { c0 = tot - c0 + dt0 * a; c1 = tot - c1 + dt1 * a; }
            LAS float* q = arr + d * 128 + 2 * lane;
            q[0] = c0 * LOG2E; q[1] = c1 * LOG2E; q[256] = dt0; q[257] = dt1; q[512] = fast_exp2(c0 * LOG2E); q[513] = fast_exp2(c1 * LOG2E);
        }
        __syncthreads();
        f32x16 cb[2] = {};
#pragma unroll 2
        for (int ks = 0; ks < 8; ++ks) { const bf16x8 a = frag_row(Cm, CP, 32 * lt, 16 * ks, lane);
#pragma unroll
            for (int i = 0; i < 2; ++i) { const bf16x8 bb = frag_row(Bm, CP, 32 * (2 * pt + i), 16 * ks, lane); cb[i] = __builtin_amdgcn_mfma_f32_32x32x16_bf16(a, bb, cb[i], 0, 0, 0); } }
        int lb = 32 * lt + 4 * hi, sb0 = 64 * pt + (lane & 31);
        asm volatile("" : "+v"(lb), "+v"(sb0));
        __syncthreads();
        const LAS float* aF = arr; const LAS float* rB = arr + 128;
#pragma unroll
        for (int i = 0; i < 2; ++i) { const int sidx = sb0 + 32 * i, dlt = sidx - lb;
            const float afs = aF[sidx], rbs = rB[sidx], dfs = aF[256 + sidx], dbs = rB[256 + sidx];
#pragma unroll
            for (int r = 0; r < 16; ++r) { const int cr = (r & 3) + 8 * (r >> 2), ll = lb + cr;
                const float f = dlt <= cr ? fast_exp2(aF[ll] - afs) * dfs : 0.f, bk = dlt >= cr ? fast_exp2(rB[ll] - rbs) * dbs : 0.f;
                const float m = cb[i][r] * (f + bk);
                *(LAS bf16_t*)(Mc + ll * CP + sidx * 2) = (bf16_t)(pk2(m, m) & 0xffffu); } }
        __syncthreads();
        f32x16 yd = {}, yf = {}, yb = {};
#pragma unroll 2
        for (int ks = 0; ks < 8; ++ks) {
            const bf16x8 am = frag_row(Mc, CP, 32 * lt, 16 * ks, lane), bx = frag_tr(Xh, XHP, 16 * ks, 32 * pt, lane);
            yd = __builtin_amdgcn_mfma_f32_32x32x16_bf16(am, bx, yd, 0, 0, 0);
            const bf16x8 ac = frag_row(Cm, CP, 32 * lt, 16 * ks, lane), bf = frag_row(Sf, CP, 32 * pt, 16 * ks, lane), bb = frag_row(Sb, CP, 32 * pt, 16 * ks, lane);
            yf = __builtin_amdgcn_mfma_f32_32x32x16_bf16(ac, bf, yf, 0, 0, 0);
            yb = __builtin_amdgcn_mfma_f32_32x32x16_bf16(ac, bb, yb, 0, 0, 0);
        }
        const float dsk = F.in[I_SSDD][l * 16 + h]; const int pcol = 32 * pt + (lane & 31);
#pragma unroll
        for (int r = 0; r < 16; ++r) { const int cr = (r & 3) + 8 * (r >> 2), ll = lb + cr;
            const float xs = bf2f(*(const LAS bf16_t*)(Xh + ll * XHP + pcol * 2));
            const float y = yd[r] + aF[512 + ll] * yf[r] + rB[512 + ll] * yb[r] + dsk * xs;
            LAS bf16_t* zp = (LAS bf16_t*)(Zh + ll * XHP + pcol * 2);
            const float v = y * siluf_(bf2f(*zp));
            *zp = (bf16_t)(pk2(v, v) & 0xffffu); }
        __syncthreads();
        {
            int tz = F.tid; asm volatile("" : "+v"(tz));
            const int r = tz >> 2, q4 = tz & 3; const LAS unsigned char* src = Zh + r * XHP + q4 * 32;
            const u32x4 a = *(const LAS u32x4*)src, b2 = *(const LAS u32x4*)(src + 16);
            bf16_t* dst = BR + (size_t)(row0 + r) * 3072 + 1024 + h * 64 + q4 * 16;
            *(u32x4*)dst = a; *(u32x4*)(dst + 8) = b2;
            float ss = 0.f;
            { const unsigned wv[8] = {a.x, a.y, a.z, a.w, b2.x, b2.y, b2.z, b2.w};
#pragma unroll
              for (int k = 0; k < 8; ++k) { const float x0 = lo16(wv[k]), x1 = hi16(wv[k]); ss += x0 * x0 + x1 * x1; } }
            ss += __shfl_xor(ss, 1); ss += __shfl_xor(ss, 2);
            if (q4 == 0) atomicAdd(GSS + (size_t)(row0 + r) * 4 + g, ss);
        }
    }
}
__device__ __forceinline__ void phase_ssd_norm(const Frame& F, int l, bool need_ctx) {
    bf16_t* BR = F.wsb(WS_BR); const float* GSS = F.wsf(WS_GSS) + (size_t)l * NROW * 4; const float* ng = F.in[I_SSDG] + l * 1024;
    const int gw = F.bid * 8 + F.wave, nrows = need_ctx ? NROW : NLAT, per = nrows / (GRID * 8), lane = F.lane;
    float gg[16];
#pragma unroll
    for (int i = 0; i < 16; ++i) gg[i] = ng[lane * 16 + i];
#pragma unroll 1
    for (int i0 = 0; i0 < per; i0 += 3) {
        u32x4 ra[3], rb[3]; float gs[3];
#pragma unroll
        for (int j = 0; j < 3; ++j) if (i0 + j < per) { const int row = gw * per + i0 + j; const GAS bf16_t* p = (const GAS bf16_t*)BR + (size_t)row * 3072 + 1024 + lane * 16;
            ra[j] = *(const GAS u32x4*)p; rb[j] = *(const GAS u32x4*)(p + 8); gs[j] = ((const GAS float*)GSS)[(size_t)row * 4 + (lane >> 4)]; }
#pragma unroll
        for (int j = 0; j < 3; ++j) if (i0 + j < per) { const int row = gw * per + i0 + j; bf16_t* p = BR + (size_t)row * 3072 + 1024 + lane * 16;
            const float rs = rsqrtf(gs[j] * (1.0f / 256.0f) + EPS);
            float v[16] = {lo16(ra[j].x), hi16(ra[j].x), lo16(ra[j].y), hi16(ra[j].y), lo16(ra[j].z), hi16(ra[j].z), lo16(ra[j].w), hi16(ra[j].w),
                           lo16(rb[j].x), hi16(rb[j].x), lo16(rb[j].y), hi16(rb[j].y), lo16(rb[j].z), hi16(rb[j].z), lo16(rb[j].w), hi16(rb[j].w)};
#pragma unroll
            for (int e = 0; e < 16; ++e) v[e] = v[e] * rs * gg[e];
            st16(p, v); }
    }
}

constexpr int NSTEPS = 2 + 4 * 16;
__global__ void __launch_bounds__(512, 2) fwd_kernel(Args args) {
    extern __shared__ __attribute__((aligned(16))) unsigned char lds_raw[];
    asm volatile("s_nop 0\n\ts_nop 0");
    Frame F; F.lds = (LAS unsigned char*)lds_raw; F.tid = threadIdx.x; F.lane = F.tid & 63; F.wave = __builtin_amdgcn_readfirstlane(F.tid >> 6); F.bid = blockIdx.x;
    F.in = args.in; F.out = args.out; F.ws = args.ws;
    volatile LAS unsigned* MISC = (volatile LAS unsigned*)(F.lds + MISC_OFF);
    for (int u = F.tid; u < (LDS_BYTES - MISC_OFF) / 4; u += 512) MISC[u] = 0u;
    __syncthreads();
    unsigned* ctl = (unsigned*)(F.ws + WS_CTL);
#if !MK_PER_STEP
    XcdBarrier bar = xcd_barrier_post(ctl + CW_BAR, MISC + 8);
#endif
    const int lo = args.st_lo, hi = args.st_hi;
#ifndef MK_PHASES
#define MK_PHASES 0xFFFFFFFFu
#endif
#define EN(k) (((MK_PHASES) >> (k)) & 1u)
#ifndef MK_DUPGU
#define MK_DUPGU 0
#endif
#ifndef MK_DUP
#define MK_DUP 0u
#endif
#define REP(k) for (int rep_ = 0; rep_ <= (int)(((MK_DUP) >> (k)) & 1u); ++rep_)
#define RUN(s) (lo <= (s) && (s) < hi)
#if MK_PER_STEP
#define SEAM() do { } while (0)
#else
#define SEAM() xcd_barrier(bar)
#endif
#define PH Frame Fp = F; { int t_; asm volatile("v_mbcnt_lo_u32_b32 %0, -1, 0\n\tv_mbcnt_hi_u32_b32 %0, -1, %0" : "=v"(t_)); t_ += F.wave << 6;     Fp.tid = t_; Fp.lane = t_ & 63; Fp.wave = __builtin_amdgcn_readfirstlane(t_ >> 6); \
    unsigned char* w_ = args.ws; asm volatile("" : "+s"(w_)); Fp.ws = w_; int b_ = blockIdx.x; asm volatile("" : "+s"(b_)); Fp.bid = b_; float* o_ = args.out; asm volatile("" : "+s"(o_)); Fp.out = o_; } \
    float* HC = Fp.wsf(WS_HC); bf16_t* U = Fp.wsb(WS_U); bf16_t* P = Fp.wsb(WS_P); bf16_t* HID = Fp.wsb(WS_P); const float* mod = Fp.wsf(WS_MOD) + (size_t)l * 9 * (NMOD * DM); \
    (void)HC; (void)U; (void)P; (void)HID; (void)mod;

    if (EN(0) && RUN(0)) { const int l = 0; PH; phase_adaln(Fp); }

#pragma unroll 1
    for (int hl = 0; hl < 4; ++hl) {
        const int l = hl >> 1, second = hl & 1, sb = 2 + 16 * hl;
        const bool need_ctx = (l == 0);
        const float* normg = F.in[I_NORMG] + (size_t)l * 3 * DM;
        if (!second) {
            if (EN(1) && RUN(sb + 0)) { PH; phase_convert(Fp, l); if (l == 0) SEAM(); }
        } else {
            const int mrows = need_ctx ? NROW : NLAT;
            if (EN(2) && RUN(sb + 0)) { PH; phase_norm(Fp, Fp.out, HC, normg + DM, mod, 3, U, NROW, HC, Fp.wsf(WS_SST), MK_I8GATE ? Fp.ws + WS_U8M : nullptr, Fp.wsf(WS_RSC)); SEAM(); }
            if (EN(3) && RUN(sb + 1)) { PH; pg8::ProbWin57 S{U, Fp.wsb(WS_U8M), Fp.wsb(WS_WIN), DM, DM, DM, need_ctx ? 1 : 0, Fp.G, Fp.bid};
                pg8::EpiP57 E{P, DINP, Fp.wsb(WS_GATE), Fp.wsf(WS_RSC), (const float*)(Fp.ws + WS_CMAX) + (size_t)l * NQCOL + 22528};
                pg8::gemm_phase<pg8::EpiP57, pg8::ProbWin57, MK_I8GATE ? 2 : 0>(Fp.lds, S, E, Fp.tid); SEAM(); }
            if (EN(4) && RUN(sb + 2)) { PH; phase_prep(Fp, l, need_ctx); SEAM(); }
            if (EN(5) && RUN(sb + 3)) { PH; pg8::ProbStd S{P + PC_CKV, Fp.wsb(WS_WUKV), DINP, 512, 512, NROW / 256, 8, Fp.G, Fp.bid}; pg8::EpiKV E{Fp.wsb(WS_K), Fp.wsb(WS_V)};
                pg8::gemm_phase(Fp.lds, S, E, Fp.tid); SEAM(); }
            if (EN(6) && RUN(sb + 4)) { PH; phase_knorm(Fp, l); REP(6) phase_ssd_states(Fp, l); SEAM(); }
            if (EN(7) && RUN(sb + 5)) { PH; phase_ssd_scan(Fp); }
            if (EN(9) && RUN(sb + 5)) { PH; REP(9) phase_na(Fp, l, need_ctx); SEAM(); }
            if (EN(8) && RUN(sb + 6)) { PH; REP(8) phase_mla(Fp, need_ctx); }
            if (EN(10) && RUN(sb + 6)) { PH; REP(10) phase_ssd_out(Fp, l, need_ctx); SEAM(); }
            if (EN(10) && RUN(sb + 7)) { PH; phase_ssd_norm(Fp, l, need_ctx); SEAM(); }
            if (EN(11) && RUN(sb + 9)) { PH; pg8::ProbMerge S{Fp.wsb(WS_BR), Fp.wsb(WS_WBR), 3072, 1024, 1024, mrows / 256, 8, Fp.G, Fp.bid}; pg8::EpiMerge E{Fp.wsb(WS_GATE), U};
                REP(11) pg8::gemm_phase(Fp.lds, S, E, Fp.tid); SEAM(); }
            if (EN(12) && RUN(sb + 10)) { PH; pg8::ProbSplit S{U, Fp.wsb(WS_WOUT), DM, DM, DM, mrows / 256, Fp.G, Fp.bid};
                pg8::EpiResid E{{Fp.out, HC}, {Fp.out, HC}, mod, 5, 1.0f, Fp.wsf(WS_SST)};
                pg8::gemm_phase(Fp.lds, S, E, Fp.tid); SEAM(); }
        }
        {
            const int frows = (second && !need_ctx) ? NLAT : NROW;
            const int nbase = second ? 6 : 0;
            if (EN(13) && RUN(sb + 11)) { PH; const float* inl = (hl == 0) ? F.in[I_X] : Fp.out; const float* inc = (hl == 0) ? F.in[I_CTX] : HC; phase_norm(Fp, inl, inc, normg + (second ? 2 : 0) * DM, mod, nbase, MK_I8GU ? nullptr : U, frows, HC, hl == 0 ? nullptr : Fp.wsf(WS_SST), MK_I8GU ? (unsigned char*)U : nullptr, Fp.wsf(WS_RSC)); SEAM(); }
            if (EN(14) && RUN(sb + 12)) { PH; pg8::ProbStd S{U, Fp.wsb(second ? WS_WGU2 : WS_WGU1), DM, DM, MK_I8GU ? DM / 2 : DM, frows / 256, 44, Fp.G, Fp.bid};
                pg8::EpiSwiglu<MK_I8GU != 0> E{HID, Fp.wsf(WS_RSC), (const float*)(Fp.ws + WS_CMAX) + (size_t)l * NQCOL + (second ? 11264 : 0), Fp.lds};
                pg8::gemm_phase<pg8::EpiSwiglu<MK_I8GU != 0>, pg8::ProbStd, MK_I8GU ? 1 : 0>(Fp.lds, S, E, Fp.tid); SEAM(); }
            if (EN(15) && RUN(sb + 13)) { PH; const float* inl = (hl == 0) ? F.in[I_X] : Fp.out; const float* inc = (hl == 0) ? F.in[I_CTX] : HC; pg8::ProbSplit S{HID, Fp.wsb(second ? WS_WDN2 : WS_WDN1), DFF, DFF, DFF, frows / 256, Fp.G, Fp.bid};
                pg8::EpiResid E{{(float*)inl, (float*)inc}, {Fp.out, HC}, mod, nbase + 2, 0.5f, Fp.wsf(WS_SST)};
                pg8::gemm_phase(Fp.lds, S, E, Fp.tid); if (hl != 3) SEAM(); }
        }
    }
#undef RUN
#undef SEAM
}

extern "C" void kernel_launch(void* const* d_in, const int* in_sizes, int n_in, void* d_out, int out_size, void* d_ws, size_t ws_size, hipStream_t stream) {
    static int grid = 0;
    if (grid == 0) {
        if (n_in != 30 || in_sizes[0] != NLAT * DM || out_size != NLAT * DM || ws_size < WS_END) {
            fprintf(stderr, "kernel_launch: unexpected shapes (n_in %d in0 %d out %d ws %zu, need ws >= %zu); nothing launched\n", n_in, n_in > 0 ? in_sizes[0] : -1, out_size, ws_size, (size_t)WS_END); grid = -1; return; }
        int dev = 0, cus = 0, per_cu = 0;
        if (hipGetDevice(&dev) != hipSuccess || hipDeviceGetAttribute(&cus, hipDeviceAttributeMultiprocessorCount, dev) != hipSuccess) { grid = -1; return; }
        if (hipFuncSetAttribute((const void*)fwd_kernel, hipFuncAttributeMaxDynamicSharedMemorySize, LDS_BYTES) != hipSuccess) { fprintf(stderr, "kernel_launch: hipFuncSetAttribute failed\n"); grid = -1; return; }
        if (hipOccupancyMaxActiveBlocksPerMultiprocessor(&per_cu, (const void*)fwd_kernel, 512, LDS_BYTES) != hipSuccess || per_cu < 1) fprintf(stderr, "kernel_launch: occupancy query reports %d\n", per_cu);
        (void)hipGetLastError();
        if (cus < GRID) { fprintf(stderr, "kernel_launch: %d CUs < %d: the persistent grid would not be resident; nothing launched\n", cus, GRID); grid = -1; return; }
        grid = GRID;
    }
    if (grid < 0) return;
    if (hipMemsetAsync((char*)d_ws + WS_CTL, 0, CTL_ZERO_BYTES, stream) != hipSuccess) { fprintf(stderr, "kernel_launch: memset failed\n"); return; }
    Args a{};
    for (int i = 0; i < 30; ++i) a.in[i] = (const float*)d_in[i];
    a.out = (float*)d_out; a.ws = (unsigned char*)d_ws;
#if MK_PER_STEP
    for (int s = 0; s < NSTEPS; ++s) {
        if (s == 1) continue;
        const int hl = (s - 2) / 16, k = (s - 2) % 16;
        if (s >= 2) { if ((hl & 1) == 0 && k >= 1 && k <= 10) continue; if ((hl & 1) == 1 && k > 10 && false) continue; if (k > 13) continue; }
        a.st_lo = s; a.st_hi = s + 1;
        hipLaunchKernelGGL(fwd_kernel, dim3(grid), dim3(512), LDS_BYTES, stream, a);
    }
#else
    a.st_lo = 0; a.st_hi = NSTEPS;
    hipLaunchKernelGGL(fwd_kernel, dim3(grid), dim3(512), LDS_BYTES, stream, a);
#endif
    const hipError_t le = hipPeekAtLastError();
    if (le != hipSuccess) fprintf(stderr, "kernel_launch: launch failed: %s\n", hipGetErrorName(le));
}
```
